# Optimizing an MI355X kernel written in HIP

```python
import jax
import jax.numpy as jnp
from jax import lax
import numpy as np

D_MODEL = 4096
BATCH = 2
SEQ = 4096
DEPTH = 2
DEC_BATCH = 8
DEC_SEQ = 16
PAST_LEN = 1024

CHUNK = 64
N_AB = (DEPTH + 1) // 2
N_C = DEPTH // 2
D_A = D_MODEL // 2
A_GROUPS = 8
A_GROUP_DIM = D_A // A_GROUPS
GMLP_CHUNK = 128
D_B = D_MODEL // 2
H_B = 16
DH_B = D_B // H_B
Q_BLOCK = 128
AB_IN = 2 * D_A + 3 * D_B + H_B
H_C = 8
DK_C = D_MODEL // (2 * H_C)
DV_C = D_MODEL // H_C
C_IN = 2 * H_C * DK_C + 2 * H_C * DV_C + 2 * H_C
D_FF = -(-8 * D_MODEL // (3 * 256)) * 256
EPS = 1e-6
FOX_FORGET_BIAS = 3.0
MLSTM_FORGET_BIAS = 3.0

kernel_name = 'streaming_gmlp_fox_mlstm_hybrid'


def rmsnorm(x, g):
    x32 = x.astype(jnp.float32)
    y = x32 * lax.rsqrt(jnp.mean(x32 * x32, axis=-1, keepdims=True) + EPS)
    return (y * g.astype(jnp.float32)).astype(x.dtype)


def swiglu(h, w_gate, w_up, w_down):
    return (jax.nn.silu(h @ w_gate) * (h @ w_up)) @ w_down


def gmlp_spatial_gate(u, v, w_s, b):
    B, T, _ = u.shape
    L = min(T, GMLP_CHUNK)
    nc = T // L
    w = jnp.tril(w_s[:, :L, :L])
    vc = v.reshape(B, nc, L, A_GROUPS, A_GROUP_DIM)
    gate = jnp.einsum('grs,bcsgd->bcrgd', w, vc) + b[:, :L].T[None, None, :, :, None]
    return (u.reshape(B, nc, L, A_GROUPS, A_GROUP_DIM) * gate).reshape(B, T, D_A)


def fox_block(qb, cq, k, v, ck, qpos):
    s = jnp.einsum('bqhd,bkhd->bhqk', qb, k, preferred_element_type=jnp.float32) * (DH_B ** -0.5)
    s = s + cq[..., :, None] - ck[..., None, :]
    kpos = jnp.arange(k.shape[1])
    s = jnp.where(kpos[None, :] <= qpos[:, None], s, -jnp.inf)
    p = jax.nn.softmax(s, axis=-1)
    return jnp.einsum('bhqk,bkhd->bqhd', p.astype(v.dtype), v)


def ab_project(h, w_in, b_f):
    B, T, _ = h.shape
    cuts = [D_A, 2 * D_A, 2 * D_A + D_B, 2 * D_A + 2 * D_B, 2 * D_A + 3 * D_B]
    u, va, q, k, vb, f_pre = jnp.split(h @ w_in, cuts, axis=-1)
    logf = jax.nn.log_sigmoid(f_pre.astype(jnp.float32) + b_f.astype(jnp.float32))
    q = q.reshape(B, T, H_B, DH_B)
    k = k.reshape(B, T, H_B, DH_B)
    vb = vb.reshape(B, T, H_B, DH_B)
    return u, va, q, k, vb, logf


def ab_merge(a, o, w_out):
    B, T, _ = a.shape
    return jnp.concatenate([a.astype(o.dtype), o.reshape(B, T, D_B)], axis=-1) @ w_out


def ab_prompt(h, w_in, w_s, b_gm, b_f, w_out):
    B, T, _ = h.shape
    u, va, q, k, v, logf = ab_project(h, w_in, b_f)
    a = gmlp_spatial_gate(u, va, w_s, b_gm)
    ck = jnp.cumsum(logf, axis=1).transpose(0, 2, 1)

    def query_block(i):
        start = i * Q_BLOCK
        qb = lax.dynamic_slice_in_dim(q, start, Q_BLOCK, axis=1)
        cq = lax.dynamic_slice_in_dim(ck, start, Q_BLOCK, axis=2)
        return fox_block(qb, cq, k, v, ck, start + jnp.arange(Q_BLOCK))

    o = lax.map(query_block, jnp.arange(T // Q_BLOCK))
    o = jnp.moveaxis(o, 0, 1).reshape(B, T, H_B, DH_B)
    y = ab_merge(a, o, w_out).astype(h.dtype)
    return y, k, v, logf


def ab_sample(h, cache_k, cache_v, cache_logf, w_in, w_s, b_gm, b_f, w_out):
    B, S, _ = h.shape
    P = cache_k.shape[1]
    u, va, q, k, v, logf = ab_project(h, w_in, b_f)
    a = gmlp_spatial_gate(u, va, w_s, b_gm)
    k_all = jnp.concatenate([cache_k.astype(k.dtype), k], axis=1)
    v_all = jnp.concatenate([cache_v.astype(v.dtype), v], axis=1)
    lf_all = jnp.concatenate([cache_logf.astype(jnp.float32), logf], axis=1)
    ck = jnp.cumsum(lf_all, axis=1).transpose(0, 2, 1)
    o = fox_block(q, ck[:, :, P:], k_all, v_all, ck, P + jnp.arange(S))
    y = ab_merge(a, o, w_out).astype(h.dtype)
    return y, k, v, logf, va


def mlstm_chunk(carry, inp):
    c, n, m = carry
    q, k, v, ig, lf = inp
    L = q.shape[2]
    causal = jnp.tril(jnp.ones((L, L), dtype=bool))
    b = jnp.cumsum(lf, axis=-1)
    dlog = jnp.where(causal, b[..., :, None] - b[..., None, :] + ig[..., None, :], -jnp.inf)
    g = b + m[..., None]
    m_t = jnp.maximum(g, jnp.max(dlog, axis=-1))
    w_intra = jnp.exp(dlog - m_t[..., None])
    w_inter = jnp.exp(g - m_t)
    s = jnp.einsum('bhtd,bhsd->bhts', q, k) * w_intra
    num = jnp.einsum('bhts,bhsv->bhtv', s, v) + w_inter[..., None] * jnp.einsum('bhtd,bhdv->bhtv', q, c)
    den = jnp.sum(s, axis=-1) + w_inter * jnp.einsum('bhtd,bhd->bht', q, n)
    h = num / jnp.maximum(jnp.abs(den), jnp.exp(-m_t))[..., None]
    b_end = b[..., -1]
    to_end = b_end[..., None] - b + ig
    m_new = jnp.maximum(b_end + m, jnp.max(to_end, axis=-1))
    w_s = jnp.exp(to_end - m_new[..., None])
    w_c = jnp.exp(b_end + m - m_new)
    c_new = w_c[..., None, None] * c + jnp.einsum('bhsd,bhsv->bhdv', k * w_s[..., None], v)
    n_new = w_c[..., None] * n + jnp.einsum('bhs,bhsd->bhd', w_s, k)
    return (c_new, n_new, m_new), h


def mlstm_mixer(h, c0, n0, m0, w_in, b_i, b_f, g_norm, w_out):
    B, T, _ = h.shape
    cuts = [H_C * DK_C, 2 * H_C * DK_C, 2 * H_C * DK_C + H_C * DV_C,
            2 * H_C * DK_C + 2 * H_C * DV_C, 2 * H_C * DK_C + 2 * H_C * DV_C + H_C]
    q, k, v, o_pre, i_pre, f_pre = jnp.split(h @ w_in, cuts, axis=-1)
    q = q.reshape(B, T, H_C, DK_C).transpose(0, 2, 1, 3).astype(jnp.float32)
    k = k.reshape(B, T, H_C, DK_C).transpose(0, 2, 1, 3).astype(jnp.float32) * (DK_C ** -0.5)
    v = v.reshape(B, T, H_C, DV_C).transpose(0, 2, 1, 3).astype(jnp.float32)
    ig = (i_pre.astype(jnp.float32) + b_i.astype(jnp.float32)).transpose(0, 2, 1)
    lf = jax.nn.log_sigmoid(f_pre.astype(jnp.float32) + b_f.astype(jnp.float32)).transpose(0, 2, 1)
    L = min(T, CHUNK)
    nc = T // L

    def blocks(t):
        return jnp.moveaxis(t.reshape((B, H_C, nc, L) + t.shape[3:]), 2, 0)

    init = (c0.astype(jnp.float32), n0.astype(jnp.float32), m0.astype(jnp.float32))
    (c, n, m), hs = lax.scan(mlstm_chunk, init, (blocks(q), blocks(k), blocks(v), blocks(ig), blocks(lf)))
    hs = jnp.moveaxis(hs, 0, 2).reshape(B, H_C, T, DV_C).transpose(0, 2, 1, 3)
    hn = hs * lax.rsqrt(jnp.mean(hs * hs, axis=-1, keepdims=True) + EPS) * g_norm.astype(jnp.float32).reshape(H_C, DV_C)
    out = jax.nn.sigmoid(o_pre.astype(jnp.float32)) * hn.reshape(B, T, H_C * DV_C)
    y = out.astype(h.dtype) @ w_out
    return y, c, n, m


def setup_inputs(seed: int = 0) -> dict:
    key = jax.random.key(seed)
    ks = jax.random.split(key, 24)

    def nrm(k, shape, scale):
        return jax.random.normal(k, shape, jnp.float32) * scale

    return {
        'x_prompt': nrm(ks[0], (BATCH, SEQ, D_MODEL), 1.0),
        'x_sample': nrm(ks[1], (DEC_BATCH, DEC_SEQ, D_MODEL), 1.0),
        'cache_fox_k': nrm(ks[2], (N_AB, DEC_BATCH, PAST_LEN, H_B, DH_B), 1.0),
        'cache_fox_v': nrm(ks[3], (N_AB, DEC_BATCH, PAST_LEN, H_B, DH_B), 1.0),
        'cache_fox_logf': jax.nn.log_sigmoid(FOX_FORGET_BIAS + nrm(ks[4], (N_AB, DEC_BATCH, PAST_LEN, H_B), 1.0)),
        'state_mlstm_c': nrm(ks[5], (N_C, DEC_BATCH, H_C, DK_C, DV_C), 0.1),
        'state_mlstm_n': nrm(ks[6], (N_C, DEC_BATCH, H_C, DK_C), 0.1),
        'state_mlstm_m': nrm(ks[7], (N_C, DEC_BATCH, H_C), 1.0),
        'norm_mix': 1.0 + nrm(ks[8], (DEPTH, D_MODEL), 0.02),
        'norm_ffn': 1.0 + nrm(ks[9], (DEPTH, D_MODEL), 0.02),
        'norm_final': 1.0 + nrm(ks[10], (D_MODEL,), 0.02),
        'ab_w_in': nrm(ks[11], (N_AB, D_MODEL, AB_IN), D_MODEL ** -0.5),
        'ab_w_out': nrm(ks[12], (N_AB, D_A + D_B, D_MODEL), (D_A + D_B) ** -0.5),
        'gmlp_w_s': nrm(ks[13], (N_AB, A_GROUPS, GMLP_CHUNK, GMLP_CHUNK), GMLP_CHUNK ** -0.5),
        'gmlp_b': 1.0 + nrm(ks[14], (N_AB, A_GROUPS, GMLP_CHUNK), 0.02),
        'fox_b_f': FOX_FORGET_BIAS + nrm(ks[15], (N_AB, H_B), 0.1),
        'c_w_in': nrm(ks[16], (N_C, D_MODEL, C_IN), D_MODEL ** -0.5),
        'c_b_i': nrm(ks[17], (N_C, H_C), 0.1),
        'c_b_f': MLSTM_FORGET_BIAS + nrm(ks[18], (N_C, H_C), 0.1),
        'c_head_norm': 1.0 + nrm(ks[19], (N_C, H_C * DV_C), 0.02),
        'c_w_out': nrm(ks[20], (N_C, H_C * DV_C, D_MODEL), (H_C * DV_C) ** -0.5),
        'ffn_w_gate': nrm(ks[21], (DEPTH, D_MODEL, D_FF), D_MODEL ** -0.5),
        'ffn_w_up': nrm(ks[22], (DEPTH, D_MODEL, D_FF), D_MODEL ** -0.5),
        'ffn_w_down': nrm(ks[23], (DEPTH, D_FF, D_MODEL), D_FF ** -0.5),
    }


def reference(x_prompt, x_sample, cache_fox_k, cache_fox_v, cache_fox_logf, state_mlstm_c, state_mlstm_n,
              state_mlstm_m, norm_mix, norm_ffn, norm_final, ab_w_in, ab_w_out, gmlp_w_s, gmlp_b, fox_b_f,
              c_w_in, c_b_i, c_b_f, c_head_norm, c_w_out, ffn_w_gate, ffn_w_up, ffn_w_down):
    yp, ys = x_prompt, x_sample
    pk, pv, plf, pc, pn, pm = [], [], [], [], [], []
    sk, sv, slf, sgv, sc, sn, sm = [], [], [], [], [], [], []
    for layer in range(DEPTH):
        j = layer // 2
        hp = rmsnorm(yp, norm_mix[layer])
        hs = rmsnorm(ys, norm_mix[layer])
        if layer % 2 == 0:
            mp, k_p, v_p, lf_p = ab_prompt(hp, ab_w_in[j], gmlp_w_s[j], gmlp_b[j], fox_b_f[j], ab_w_out[j])
            ms, k_s, v_s, lf_s, gv_s = ab_sample(hs, cache_fox_k[j], cache_fox_v[j], cache_fox_logf[j],
                                                 ab_w_in[j], gmlp_w_s[j], gmlp_b[j], fox_b_f[j], ab_w_out[j])
            pk.append(k_p); pv.append(v_p); plf.append(lf_p)
            sk.append(k_s); sv.append(v_s); slf.append(lf_s); sgv.append(gv_s)
        else:
            bp = yp.shape[0]
            c0 = jnp.zeros((bp, H_C, DK_C, DV_C), jnp.float32)
            n0 = jnp.zeros((bp, H_C, DK_C), jnp.float32)
            m0 = jnp.zeros((bp, H_C), jnp.float32)
            mp, c_p, n_p, m_p = mlstm_mixer(hp, c0, n0, m0, c_w_in[j], c_b_i[j], c_b_f[j], c_head_norm[j], c_w_out[j])
            ms, c_s, n_s, m_s = mlstm_mixer(hs, state_mlstm_c[j], state_mlstm_n[j], state_mlstm_m[j],
                                            c_w_in[j], c_b_i[j], c_b_f[j], c_head_norm[j], c_w_out[j])
            pc.append(c_p); pn.append(n_p); pm.append(m_p)
            sc.append(c_s); sn.append(n_s); sm.append(m_s)
        yp = yp + mp
        ys = ys + ms
        yp = yp + swiglu(rmsnorm(yp, norm_ffn[layer]), ffn_w_gate[layer], ffn_w_up[layer], ffn_w_down[layer])
        ys = ys + swiglu(rmsnorm(ys, norm_ffn[layer]), ffn_w_gate[layer], ffn_w_up[layer], ffn_w_down[layer])
    yp = rmsnorm(yp, norm_final)
    ys = rmsnorm(ys, norm_final)
    return (yp, ys, jnp.stack(pk), jnp.stack(pv), jnp.stack(plf), jnp.stack(pc), jnp.stack(pn), jnp.stack(pm),
            jnp.stack(sk), jnp.stack(sv), jnp.stack(slf), jnp.stack(sgv), jnp.stack(sc), jnp.stack(sn), jnp.stack(sm))
```

```cpp
#include <hip/hip_runtime.h>
#include <cstdio>
#include <cstdint>
namespace pg8 {
#define PG8_LAS __attribute__((address_space(3)))
typedef unsigned short bf16_t;
typedef short bf16x8 __attribute__((ext_vector_type(8)));
typedef float f32x4 __attribute__((ext_vector_type(4)));
typedef unsigned u32x4 __attribute__((ext_vector_type(4)));
constexpr int BM = 256, BK = 64, HALF = 128, HTB = HALF * BK * 2  , STAGE_BYTES = 8 * HTB, NXCD = 8, WGM = 8;

__host__ __device__ __forceinline__ int lds_byte(int r, int c) { const int st = (r >> 4) * 2 + (c >> 5), rr = r & 15, cc = c & 31, ob = rr * 64 + cc * 2; return st * 1024 + (ob ^ (((ob >> 9) & 1) << 5)); }
__host__ __device__ __forceinline__ void stage_rc(int b, int& R, int& C) { const int st = b / 1024, sb = b % 1024, swz = sb ^ (((sb >> 9) & 1) << 5); R = (st >> 1) * 16 + swz / 64; C = (st & 1) * 32 + (swz % 64) / 2; }
__host__ __device__ __forceinline__ int perm32(int rho) { const int n = rho >> 4, i = rho & 15; return 8 * (i >> 2) + 4 * n + (i & 3); }

struct Unit { int pm, pn, kt0, nkt, slab; };
struct Gemm { const bf16_t* A; const bf16_t* Bt; int M, N, K; };

struct StaticOrder {
    int nM, nN, nwg, G, c, ktiles;
    __host__ __device__ void init(int M, int N, int K, int G_, int c_) { nM = M / BM; nN = N / BM; nwg = nM * nN; G = G_; c = c_; ktiles = K / BK; }
    __host__ __device__ bool next(int i, Unit& u) const {
        const long L = (long)i * G + c; if (L >= nwg) return false;
        int wgid = (int)L; { const int q = nwg / NXCD, r = nwg % NXCD, xcd = wgid % NXCD, off = wgid / NXCD; wgid = (xcd < r ? xcd * (q + 1) : r * (q + 1) + (xcd - r) * q) + off; }
        const int nig = WGM * nN, gid = wgid / nig, fm = gid * WGM, gsz = (nM - fm) < WGM ? (nM - fm) : WGM;
        u.pm = fm + ((wgid % nig) % gsz); u.pn = (wgid % nig) / gsz; u.kt0 = 0; u.nkt = ktiles; u.slab = -1; return true;
    }
    __device__ __forceinline__ void a_ready(const Unit&) const {}
    __device__ __forceinline__ void done(const Unit&) const {}
};

__device__ __forceinline__ unsigned cvt_pk_bf16(float lo, float hi) { unsigned r; asm volatile("v_cvt_pk_bf16_f32 %0, %1, %2" : "=v"(r) : "v"(lo), "v"(hi)); return r; }
typedef float f32x2 __attribute__((ext_vector_type(2)));
template <class Epi, class Sched, bool ALIGN_EPI = false, bool SP2 = false>
__device__ __forceinline__ void gemm_phase(PG8_LAS unsigned char* lds, const Gemm g, const Sched& S, const Epi& E) {
    int tid_ = threadIdx.x; asm volatile("" : "+v"(tid_));
    const int tid = tid_, wid = __builtin_amdgcn_readfirstlane(tid >> 6), lane = tid & 63, wr = wid >> 2, wc = wid & 3, fr = lane & 15, fq = lane >> 4;
    const int K = g.K;
    unsigned voffA[2], voffB[2];
#pragma unroll
    for (int i = 0; i < 2; ++i) { int R, C; stage_rc(tid * 16 + i * 8192, R, C); voffA[i] = (unsigned)(R * K + C) * 2u;
        const int Rl = (wid & 1) * 64 + lane, Rb = Epi::PERM ? ((Rl & ~31) + perm32(Rl & 31)) : Rl; voffB[i] = (unsigned)(((wid >> 1) + 4 * i) * 256 + Rb) * 16u; }
    const size_t kstep = (size_t)(BK * 2);
    const size_t hstep = (size_t)HALF * K * 2;
    const size_t tstep = 2 * hstep;
    const size_t kstepB = 32768, hstepB = 2048, tstepB = (size_t)K * 512;
    const unsigned ldsw = (unsigned)wid * 1024u;
    const int aoff = lds_byte(wr * 64 + fr, fq * 8), boff = fq * 2048 + wc * 512 + fr * 16;
#define PG8_SA(b, h) (((b) * 2 + (h)) * HTB)
#define PG8_SB(b, h) ((4 + (b) * 2 + (h)) * HTB)
#define PG8_STAGE(bufoff, gbase, voff) do { _Pragma("unroll") for (int _i = 0; _i < 2; ++_i) \
        __builtin_amdgcn_global_load_lds((const unsigned*)((const char*)(gbase) + (voff)[_i]), (PG8_LAS unsigned*)(lds + (bufoff) + ldsw + _i * 8192), 16, 0, 0); } while (0)
#define PG8_LDA(dst, b, h) do { _Pragma("unroll") for (int m = 0; m < 4; ++m) _Pragma("unroll") for (int k = 0; k < 2; ++k) dst[m][k] = *(const PG8_LAS bf16x8*)(lds + PG8_SA(b, h) + aoff + m * 2048 + k * 1024); } while (0)
#define PG8_LDB(dst, b, h) do { _Pragma("unroll") for (int n = 0; n < 2; ++n) _Pragma("unroll") for (int k = 0; k < 2; ++k) dst[n][k] = *(const PG8_LAS bf16x8*)(lds + PG8_SB(b, h) + boff + n * 256 + k * 8192); } while (0)
#define PG8_MMA(ai, bj, At, Bt) do { __builtin_amdgcn_s_setprio(1); _Pragma("unroll") for (int m = 0; m < 4; ++m) _Pragma("unroll") for (int n = 0; n < 2; ++n) _Pragma("unroll") for (int k = 0; k < 2; ++k) \
        acc[ai][bj][m][n] = __builtin_amdgcn_mfma_f32_16x16x32_bf16(Bt[n][k], At[m][k], acc[ai][bj][m][n], 0, 0, 0); __builtin_amdgcn_s_setprio(0); } while (0)
#define PG8_WAIT_V(n) asm volatile("s_waitcnt vmcnt(" #n ")" ::: "memory")
#define PG8_WAIT_L(n) asm volatile("s_waitcnt lgkmcnt(" #n ")" ::: "memory")
#define PG8_BAR __builtin_amdgcn_s_barrier()
#define PG8_SCHED __builtin_amdgcn_sched_barrier(0)
    Unit cur, nxt; int ui = 0;
    if (!S.next(0, cur)) return;
    f32x4 acc[2][2][4][2];
#pragma unroll
    for (int a = 0; a < 2; ++a)
#pragma unroll
        for (int b = 0; b < 2; ++b)
#pragma unroll
            for (int m = 0; m < 4; ++m)
#pragma unroll
                for (int n = 0; n < 2; ++n) acc[a][b][m][n] = (f32x4){0.f, 0.f, 0.f, 0.f};
    bf16x8 At[4][2], B0[2][2], B1[2][2];
    const char* cA = (const char*)g.A + (size_t)cur.pm * tstep + (size_t)cur.kt0 * kstep; const char* cB = (const char*)g.Bt + (size_t)cur.pn * tstepB + (size_t)cur.kt0 * kstepB; int nt = cur.nkt;
    S.a_ready(cur);
    if constexpr (SP2) {
        PG8_STAGE(PG8_SB(0, 0), cB, voffB); PG8_STAGE(PG8_SB(0, 1), cB + hstepB, voffB); PG8_STAGE(PG8_SA(0, 0), cA, voffA); PG8_STAGE(PG8_SA(0, 1), cA + hstep, voffA);
        if (wr == 1) PG8_BAR;
        PG8_WAIT_V(2); PG8_BAR;
        PG8_STAGE(PG8_SB(1, 0), cB + kstepB, voffB); PG8_STAGE(PG8_SA(1, 0), cA + kstep, voffA); PG8_STAGE(PG8_SB(1, 1), cB + hstepB + kstepB, voffB);
        PG8_WAIT_V(6); PG8_BAR;
    } else {
        PG8_STAGE(PG8_SB(0, 0), cB, voffB); PG8_STAGE(PG8_SA(0, 0), cA, voffA); PG8_STAGE(PG8_SB(0, 1), cB + hstepB, voffB); PG8_STAGE(PG8_SA(0, 1), cA + hstep, voffA);
        if (wr == 1) PG8_BAR;
        PG8_WAIT_V(4); PG8_BAR;
        PG8_STAGE(PG8_SB(1, 0), cB + kstepB, voffB); PG8_STAGE(PG8_SA(1, 0), cA + kstep, voffA); PG8_STAGE(PG8_SB(1, 1), cB + hstepB + kstepB, voffB);
        PG8_WAIT_V(6); PG8_BAR;
    }
    for (;;) {
        const bool has_next = S.next(ui + 1, nxt);
        const char* nA = has_next ? (const char*)g.A + (size_t)nxt.pm * tstep + (size_t)nxt.kt0 * kstep : cA; const char* nB = has_next ? (const char*)g.Bt + (size_t)nxt.pn * tstepB + (size_t)nxt.kt0 * kstepB : cB;
        if constexpr (SP2) {
        if (cur.slab >= 0) {
        for (int t = 0; t < nt; t += 2) {
            const bool last = (t == nt - 2);
            const char* a1 = cA + (size_t)(t + 1) * kstep;
            const char* a2 = last ? nA : cA + (size_t)(t + 2) * kstep; const char* b2 = last ? nB : cB + (size_t)(t + 2) * kstepB;
            const char* a3 = a2 + kstep; const char* b3 = b2 + kstepB;
            if (last && has_next) S.a_ready(nxt);
            PG8_LDB(B0, 0, 0); PG8_LDB(B1, 0, 1); PG8_SCHED; PG8_LDA(At, 0, 0); PG8_STAGE(PG8_SA(1, 1), a1 + hstep, voffA);
            PG8_WAIT_V(8); PG8_WAIT_L(0); PG8_BAR; PG8_MMA(0, 0, At, B0); PG8_MMA(0, 1, At, B1); PG8_BAR; PG8_SCHED;
            PG8_STAGE(PG8_SB(0, 0), b2, voffB); PG8_STAGE(PG8_SB(0, 1), b2 + hstepB, voffB); PG8_STAGE(PG8_SA(0, 0), a2, voffA);
            PG8_WAIT_V(8); PG8_WAIT_L(0); PG8_BAR; PG8_BAR; PG8_SCHED;
            PG8_LDB(B0, 1, 0); PG8_LDB(B1, 1, 1); PG8_SCHED; PG8_LDA(At, 1, 0); PG8_STAGE(PG8_SA(0, 1), a2 + hstep, voffA);
            PG8_WAIT_V(8); PG8_WAIT_L(0); PG8_BAR; PG8_MMA(0, 0, At, B0); PG8_MMA(0, 1, At, B1); PG8_BAR; PG8_SCHED;
            PG8_STAGE(PG8_SB(1, 0), b3, voffB); PG8_STAGE(PG8_SB(1, 1), b3 + hstepB, voffB); PG8_STAGE(PG8_SA(1, 0), a3, voffA);
            PG8_WAIT_V(8); PG8_WAIT_L(0); PG8_BAR; PG8_BAR; PG8_SCHED;
        }
        } else {
        for (int t = 0; t < nt; t += 2) {
            const bool last = (t == nt - 2);
            const char* a1 = cA + (size_t)(t + 1) * kstep;
            const char* a2 = last ? nA : cA + (size_t)(t + 2) * kstep; const char* b2 = last ? nB : cB + (size_t)(t + 2) * kstepB;
            const char* a3 = a2 + kstep; const char* b3 = b2 + kstepB;
            if (last && has_next) S.a_ready(nxt);
            PG8_LDB(B0, 0, 0); PG8_LDB(B1, 0, 1); PG8_SCHED; PG8_LDA(At, 0, 0); PG8_STAGE(PG8_SA(1, 1), a1 + hstep, voffA);
            PG8_WAIT_V(8); PG8_WAIT_L(0); PG8_BAR; PG8_MMA(0, 0, At, B0); PG8_MMA(0, 1, At, B1); PG8_BAR; PG8_SCHED;
            PG8_LDA(At, 0, 1); PG8_STAGE(PG8_SB(0, 0), b2, voffB); PG8_STAGE(PG8_SB(0, 1), b2 + hstepB, voffB); PG8_STAGE(PG8_SA(0, 0), a2, voffA);
            PG8_WAIT_V(8); PG8_WAIT_L(0); PG8_BAR; PG8_MMA(1, 0, At, B0); PG8_MMA(1, 1, At, B1); PG8_BAR; PG8_SCHED;
            PG8_LDB(B0, 1, 0); PG8_LDB(B1, 1, 1); PG8_SCHED; PG8_LDA(At, 1, 0); PG8_STAGE(PG8_SA(0, 1), a2 + hstep, voffA);
            PG8_WAIT_V(8); PG8_WAIT_L(0); PG8_BAR; PG8_MMA(0, 0, At, B0); PG8_MMA(0, 1, At, B1); PG8_BAR; PG8_SCHED;
            PG8_LDA(At, 1, 1); PG8_STAGE(PG8_SB(1, 0), b3, voffB); PG8_STAGE(PG8_SB(1, 1), b3 + hstepB, voffB); PG8_STAGE(PG8_SA(1, 0), a3, voffA);
            PG8_WAIT_V(8); PG8_WAIT_L(0); PG8_BAR; PG8_MMA(1, 0, At, B0); PG8_MMA(1, 1, At, B1); PG8_BAR; PG8_SCHED;
        }
        }
        } else {
        for (int t = 0; t < nt; t += 2) {
            const bool last = (t == nt - 2);
            const char* a1 = cA + (size_t)(t + 1) * kstep;
            const char* a2 = last ? nA : cA + (size_t)(t + 2) * kstep; const char* b2 = last ? nB : cB + (size_t)(t + 2) * kstepB;
            const char* a3 = a2 + kstep; const char* b3 = b2 + kstepB;
            if (last && has_next) S.a_ready(nxt);
            PG8_LDB(B0, 0, 0); PG8_SCHED; PG8_LDA(At, 0, 0); PG8_STAGE(PG8_SA(1, 1), a1 + hstep, voffA);
            PG8_WAIT_L(8); PG8_BAR; PG8_WAIT_L(0); PG8_MMA(0, 0, At, B0); PG8_BAR; PG8_SCHED;
            PG8_LDB(B1, 0, 1); PG8_STAGE(PG8_SB(0, 0), b2, voffB);
            PG8_BAR; PG8_WAIT_L(0); PG8_MMA(0, 1, At, B1); PG8_BAR;
            PG8_LDA(At, 0, 1); PG8_STAGE(PG8_SA(0, 0), a2, voffA);
            PG8_BAR; PG8_WAIT_L(0); PG8_MMA(1, 0, At, B0); PG8_BAR; PG8_SCHED;
            PG8_STAGE(PG8_SB(0, 1), b2 + hstepB, voffB);
            PG8_WAIT_V(6); PG8_BAR; PG8_MMA(1, 1, At, B1); PG8_BAR;
            PG8_LDB(B0, 1, 0); PG8_SCHED; PG8_LDA(At, 1, 0); PG8_STAGE(PG8_SA(0, 1), a2 + hstep, voffA);
            PG8_WAIT_L(8); PG8_BAR; PG8_WAIT_L(0); PG8_MMA(0, 0, At, B0); PG8_BAR; PG8_SCHED;
            PG8_LDB(B1, 1, 1); PG8_STAGE(PG8_SB(1, 0), b3, voffB);
            PG8_BAR; PG8_WAIT_L(0); PG8_MMA(0, 1, At, B1); PG8_BAR;
            PG8_LDA(At, 1, 1); PG8_STAGE(PG8_SA(1, 0), a3, voffA);
            PG8_BAR; PG8_WAIT_L(0); PG8_MMA(1, 0, At, B0); PG8_BAR; PG8_SCHED;
            PG8_STAGE(PG8_SB(1, 1), b3 + hstepB, voffB);
            PG8_WAIT_V(6); PG8_BAR; PG8_MMA(1, 1, At, B1); PG8_BAR;
        }
        }
        if constexpr (ALIGN_EPI) { if (wr == 0) PG8_BAR; }
        if constexpr (!Epi::AFTER_DRAIN) { E(acc, cur, wr, wc, fr, fq); S.done(cur); }
        if (!has_next) break;
#pragma unroll
        for (int a = 0; a < 2; ++a)
#pragma unroll
            for (int b = 0; b < 2; ++b)
#pragma unroll
                for (int m = 0; m < 4; ++m)
#pragma unroll
                    for (int n = 0; n < 2; ++n) acc[a][b][m][n] = (f32x4){0.f, 0.f, 0.f, 0.f};
        cur = nxt; cA = nA; cB = nB; nt = cur.nkt; ++ui;
        if constexpr (ALIGN_EPI) { if (wr == 1) PG8_BAR; }
    }
    PG8_WAIT_V(0);
    if constexpr (!ALIGN_EPI) { if (wr == 0) PG8_BAR; }
    PG8_BAR;
    if constexpr (Epi::AFTER_DRAIN) { E.fused(acc, cur, wr, wc, fr, fq, lds, wid, lane); S.done(cur); }
#undef PG8_SA
#undef PG8_SB
#undef PG8_STAGE
#undef PG8_LDA
#undef PG8_LDB
#undef PG8_MMA
#undef PG8_WAIT_V
#undef PG8_WAIT_L
#undef PG8_BAR
#undef PG8_SCHED
}
}
#define LAS __attribute__((address_space(3)))
#define XB_TMO      128
#define XB_XCNT(j)  (256  + 64 * (j))
#define XB_XSUB(j)  (1280 + 64 * (j))
#define XB_XGEN(j)  (2304 + 64 * (j))
#define XB_TOP      3328
#define XB_TOPGEN   3392
#define XCD_BAR_WORDS 3456
#define XB_SPIN_CAP (1u << 21)

__device__ __forceinline__ unsigned xb_ld(unsigned* p)              { return __hip_atomic_load(p, __ATOMIC_RELAXED, __HIP_MEMORY_SCOPE_AGENT); }
__device__ __forceinline__ unsigned xb_add(unsigned* p, unsigned v) { return __hip_atomic_fetch_add(p, v, __ATOMIC_RELAXED, __HIP_MEMORY_SCOPE_AGENT); }
__device__ __forceinline__ unsigned xb_xcc_id() { return (unsigned)__builtin_amdgcn_s_getreg((3 << 11) | 20) & 0xFu; }
#define XB_SPIN(cond, bar) do { unsigned _sp = 0; while (cond) { __builtin_amdgcn_s_sleep(1); \
    if ((++_sp & 255u) == 0u) { if (xb_ld(&(bar)[XB_TMO])) break; if (_sp > XB_SPIN_CAP) { atomicAdd(&(bar)[XB_TMO], 1u); break; } } } } while (0)

struct XcdBarrier {
    unsigned* bar; unsigned x;
    volatile LAS unsigned* st;
};

__device__ __forceinline__ XcdBarrier xcd_barrier_post(unsigned* bar, volatile LAS unsigned* st) {
    XcdBarrier b; b.bar = bar; b.x = xb_xcc_id(); b.st = st;
    if (threadIdx.x == 0) (void)xb_add(&bar[XB_XCNT(b.x)], 1u);
    return b;
}
__device__ __forceinline__ void xcd_barrier_complete(unsigned* bar, unsigned x, unsigned& nloc, unsigned& nx) {
    const unsigned G = gridDim.x * gridDim.y * gridDim.z;
    unsigned sum, cnt, mine, sp = 0u;
    for (;;) {
        sum = 0u; cnt = 0u; mine = 0u;
#pragma unroll
        for (unsigned j = 0; j < 16; ++j) { const unsigned c = xb_ld(&bar[XB_XCNT(j)]); sum += c; cnt += (c > 0u) ? 1u : 0u; mine = (j == x) ? c : mine; }
        if (sum == G) break;
        __builtin_amdgcn_s_sleep(1);
        if ((++sp & 255u) == 0u) { if (xb_ld(&bar[XB_TMO])) break; if (sp > XB_SPIN_CAP) { atomicAdd(&bar[XB_TMO], 1u); break; } }
    }
    nloc = mine > 0u ? mine : 1u; nx = cnt > 0u ? cnt : 1u;
}

__device__ __forceinline__ void xcd_barrier(const XcdBarrier& b) {
    asm volatile("s_waitcnt vmcnt(0)" ::: "memory");
    __syncthreads();
    if (threadIdx.x == 0) {
        unsigned* bar = b.bar;
        __builtin_amdgcn_s_waitcnt(0);
        unsigned nloc = b.st[0], nx = b.st[1];
        if (nloc == 0u) { xcd_barrier_complete(bar, b.x, nloc, nx); b.st[0] = nloc; b.st[1] = nx; }
        const unsigned old = xb_add(&bar[XB_XSUB(b.x)], 1u);
        const unsigned gen = old / nloc;
        if (old + 1u == (gen + 1u) * nloc) {
            __builtin_amdgcn_fence(__ATOMIC_RELEASE, "agent");
            asm volatile("s_waitcnt vmcnt(0)" ::: "memory");
            const unsigned og = xb_add(&bar[XB_TOP], 1u);
            const unsigned tg = og / nx;
            if (og + 1u == (tg + 1u) * nx) xb_add(&bar[XB_TOPGEN], 1u);
            else XB_SPIN(xb_ld(&bar[XB_TOPGEN]) == tg, bar);
            __builtin_amdgcn_fence(__ATOMIC_ACQUIRE, "agent");
            xb_add(&bar[XB_XGEN(b.x)], 1u);
            asm volatile("s_waitcnt vmcnt(0)" ::: "memory");
        } else {
            XB_SPIN(xb_ld(&bar[XB_XGEN(b.x)]) == gen, bar);
            __builtin_amdgcn_fence(__ATOMIC_ACQUIRE, "agent");
            asm volatile("s_waitcnt vmcnt(0)" ::: "memory");
        }
    }
    __syncthreads();
}

namespace P {
constexpr int D = 4096, SEQ = 4096, BATCH = 2, DEC_B = 8, DEC_S = 16, PAST = 1024;
constexpr int NP = BATCH * SEQ;
constexpr int NS = DEC_B * DEC_S;
constexpr int M = NP + NS;
constexpr int MP = 8448;
constexpr int DA = 2048, DB = 2048, HB = 16, DHB = 128;
constexpr int AB_LD = 10256, AB_N = 10240;
constexpr int HC = 8, DKC = 256, DVC = 512;
constexpr int C_LD = 12304, C_N = 12288;
constexpr int DFF = 11008;
constexpr float EPS = 1e-6f;
constexpr size_t O_YP = 0;
constexpr size_t O_YS = O_YP + (size_t)NP * D;
constexpr size_t O_PK = O_YS + (size_t)NS * D;
constexpr size_t O_PV = O_PK + (size_t)NP * DB;
constexpr size_t O_PLF = O_PV + (size_t)NP * DB;
constexpr size_t O_PC = O_PLF + (size_t)NP * HB;
constexpr size_t O_PN = O_PC + (size_t)BATCH * HC * DKC * DVC;
constexpr size_t O_PM = O_PN + (size_t)BATCH * HC * DKC;
constexpr size_t O_SK = O_PM + (size_t)BATCH * HC;
constexpr size_t O_SV = O_SK + (size_t)NS * DB;
constexpr size_t O_SLF = O_SV + (size_t)NS * DB;
constexpr size_t O_SGV = O_SLF + (size_t)NS * HB;
constexpr size_t O_SC = O_SGV + (size_t)NS * DA;
constexpr size_t O_SN = O_SC + (size_t)DEC_B * HC * DKC * DVC;
constexpr size_t O_SM = O_SN + (size_t)DEC_B * HC * DKC;
constexpr size_t O_END = O_SM + (size_t)DEC_B * HC;
enum { I_XP = 0, I_XS, I_CK, I_CV, I_CLF, I_SC, I_SN, I_SM, I_NMIX, I_NFFN, I_NFIN, I_ABWIN, I_ABWOUT, I_GWS, I_GB, I_FBF, I_CWIN, I_CBI, I_CBF, I_CHN, I_CWOUT, I_FG, I_FU, I_FD, N_IN };
constexpr size_t MiB = 1u << 20;
constexpr size_t WS_CTL = 0, CTL_ZERO_BYTES = 1 * MiB;
constexpr size_t WS_WABIN = 1 * MiB;
constexpr size_t WS_WABF = 81 * MiB;
constexpr size_t WS_WABOUT = 82 * MiB;
constexpr size_t WS_WCIN = 114 * MiB;
constexpr size_t WS_WCIF = 210 * MiB;
constexpr size_t WS_WCOUT = 211 * MiB;
constexpr size_t WS_WGU0 = 243 * MiB;
constexpr size_t WS_WGU1 = 415 * MiB;
constexpr size_t WS_WDN0 = 587 * MiB;
constexpr size_t WS_WDN1 = 673 * MiB;
constexpr size_t WS_H = 759 * MiB;
constexpr size_t WS_Y = 825 * MiB;
constexpr size_t WS_PROJ = 957 * MiB;
constexpr size_t WS_MIX = 1155 * MiB;
constexpr size_t WS_G = 1221 * MiB;
constexpr size_t WS_GATES = 1400 * MiB;
constexpr size_t WS_SLAB = 1401 * MiB;
constexpr size_t WS_GS = 1435 * MiB;
constexpr size_t WS_PB = 1436 * MiB;
constexpr size_t WS_END = 1444 * MiB;
static_assert(WS_WABIN + (size_t)AB_N * D * 2 <= WS_WABF && WS_WCIN + (size_t)C_N * D * 2 <= WS_WCIF && WS_WGU0 + (size_t)2 * DFF * D * 2 <= WS_WGU1 && WS_WGU1 + (size_t)2 * DFF * D * 2 <= WS_WDN0, "ws map 1");
static_assert(WS_WDN0 + (size_t)DFF * D * 2 <= WS_WDN1 && WS_WDN1 + (size_t)DFF * D * 2 <= WS_H && WS_H + (size_t)MP * D * 2 <= WS_Y && WS_Y + (size_t)MP * D * 4 <= WS_PROJ, "ws map 2");
static_assert(WS_PROJ + (size_t)MP * C_N * 2 <= WS_MIX && WS_MIX + (size_t)MP * D * 2 <= WS_G && WS_G + (size_t)MP * DFF * 2 <= WS_END, "ws map 3");
constexpr int CW_BAR = 4096;
constexpr size_t CTL_SSQ = 524288;
constexpr int RING_BYTES = 131072, MISC_OFF = RING_BYTES, LDS_BYTES = 147456;
}

typedef unsigned short bf16_t;
typedef float f32x4 __attribute__((ext_vector_type(4)));
typedef short bf16x8 __attribute__((ext_vector_type(8)));
typedef unsigned u32x4 __attribute__((ext_vector_type(4)));
typedef unsigned u32x2 __attribute__((ext_vector_type(2)));
#define LDS_WAIT() asm volatile("s_waitcnt lgkmcnt(0)" ::: "memory")
#define VM_WAIT() asm volatile("s_waitcnt vmcnt(0)" ::: "memory")
using pg8::cvt_pk_bf16;

__device__ __forceinline__ float wave_sum(float v) {
#pragma unroll
    for (int o = 1; o < 64; o <<= 1) v += __shfl_xor(v, o);
    return v;
}
__device__ __forceinline__ float log_sigmoid_f(float z) { return fminf(z, 0.f) - log1pf(__expf(-fabsf(z))); }

__device__ __forceinline__ void transpose_item(const float* __restrict__ W, int ld, int K, int k0, int n0, int nvalid, bf16_t* __restrict__ WT, int drow0, LAS float* scr, int lane, const float* __restrict__ gain = nullptr) {
    const int nn = lane & 31, ncl = nn < nvalid ? nn : nvalid - 1;
    float wv[32];
#pragma unroll
    for (int i = 0; i < 32; ++i) wv[i] = W[(size_t)(k0 + 2 * i + (lane >> 5)) * ld + n0 + ncl];
#pragma unroll
    for (int i = 0; i < 32; ++i) scr[(2 * i + (lane >> 5)) * 33 + nn] = wv[i];
    LDS_WAIT();
    const int c = lane & 7;
    f32x4 g0 = {1.f, 1.f, 1.f, 1.f}, g1 = {1.f, 1.f, 1.f, 1.f};
    if (gain) { g0 = *(const f32x4*)(gain + k0 + 8 * c); g1 = *(const f32x4*)(gain + k0 + 8 * c + 4); }
#pragma unroll
    for (int j = 0; j < 4; ++j) { const int n = (lane >> 3) + 8 * j; const LAS float* s = scr + (8 * c) * 33 + n;
        u32x4 o; o.x = cvt_pk_bf16(s[0 * 33] * g0[0], s[1 * 33] * g0[1]); o.y = cvt_pk_bf16(s[2 * 33] * g0[2], s[3 * 33] * g0[3]); o.z = cvt_pk_bf16(s[4 * 33] * g1[0], s[5 * 33] * g1[1]); o.w = cvt_pk_bf16(s[6 * 33] * g1[2], s[7 * 33] * g1[3]);
        if (n < nvalid) *(u32x4*)(WT + (size_t)(drow0 + n) * K + k0 + 8 * c) = o; }
    LDS_WAIT();
}

struct Ctx {
    const float* const* in; float* out; unsigned char* ws;
    int tid, lane, wave, gw, ngw, G;
};


struct SplitOrder {
    pg8::StaticOrder Pm; int nfull, nmini, S, G, c, b, e;
    __device__ void init(int N, int K, int S_, int G_, int c_) { Pm.init(P::NP, N, K, G_, c_); nfull = Pm.nwg; S = S_; nmini = (N / 256) * S_; G = G_; c = c_;
        const int kt = K / 64; b = (kt / S_) & ~1; e = (kt - S_ * b) / 2; }
    __device__ bool next(int i, pg8::Unit& u) const {
        const int L = i * G + c;
        if (L < nfull) return Pm.next(i, u);
        const int j = L - nfull; if (j >= nmini) return false;
        const int pn = j / S, s = j - pn * S;
        u.pm = P::NP / 256; u.pn = pn; u.kt0 = s * b + 2 * (s < e ? s : e); u.nkt = b + (s < e ? 2 : 0); u.slab = j; return true;
    }
    __device__ __forceinline__ void a_ready(const pg8::Unit&) const {}
    __device__ __forceinline__ void done(const pg8::Unit&) const {}
};

template <int CW> struct CvVec;
template <> struct CvVec<4> { typedef f32x4 T; };
template <> struct CvVec<2> { typedef float T __attribute__((ext_vector_type(2))); };
template <> struct CvVec<1> { typedef float T; };
__device__ __forceinline__ float cv_el(const f32x4& v, int e) { return v[e]; }
__device__ __forceinline__ float cv_el(const CvVec<2>::T& v, int e) { return v[e]; }
__device__ __forceinline__ float cv_el(const float& v, int) { return v; }
template <int CW, int NBLK, int LD>
__device__ __forceinline__ void cv_load(const float* __restrict__ src, int r, int lane, typename CvVec<CW>::T (&v)[8]) {
    const int o = r / NBLK, nb = r - o * NBLK;
    const float* p = src + (size_t)(8 * o) * LD + 64 * CW * nb + CW * lane;
#pragma unroll
    for (int j = 0; j < 8; ++j) v[j] = *(const typename CvVec<CW>::T*)(p + (size_t)j * LD);
}
template <int CW, int NBLK, int KOCT, int MODE>
__device__ __forceinline__ void cv_store(bf16_t* __restrict__ dst, const float* __restrict__ gain, int r, int lane, const typename CvVec<CW>::T (&v)[8]) {
    const int o = r / NBLK, nb = r - o * NBLK;
    float g[8];
#pragma unroll
    for (int j = 0; j < 8; ++j) g[j] = gain ? gain[8 * o + j] : 1.0f;
    const int n = 64 * CW * nb + CW * lane, np = MODE == 0 ? n : 256 * (n >> 7) + (n & 127) + (MODE == 2 ? 128 : 0);
    u32x4* q = (u32x4*)(dst + (((size_t)(np >> 8) * KOCT + o) * 256 + (np & 255)) * 8);
#pragma unroll
    for (int e = 0; e < CW; ++e) { u32x4 w; w.x = cvt_pk_bf16(cv_el(v[0], e) * g[0], cv_el(v[1], e) * g[1]); w.y = cvt_pk_bf16(cv_el(v[2], e) * g[2], cv_el(v[3], e) * g[3]); w.z = cvt_pk_bf16(cv_el(v[4], e) * g[4], cv_el(v[5], e) * g[5]); w.w = cvt_pk_bf16(cv_el(v[6], e) * g[6], cv_el(v[7], e) * g[7]); q[e] = w; }
}
template <int CW, int JOB> struct CvJob {
    static constexpr int CB = 64 * CW;
    static constexpr int COUNT = JOB == 0 ? (P::D / 8) * (P::AB_N / CB) : JOB == 1 ? (P::D / 8) * (P::C_N / CB) : (JOB == 2 || JOB == 6) ? (P::D / 8) * (P::D / CB) : (JOB == 5 || JOB == 9) ? (P::DFF / 8) * (P::D / CB) : (P::D / 8) * (P::DFF / CB);
    static __device__ __forceinline__ void load(const Ctx& C, int r, typename CvVec<CW>::T (&v)[8]) {
        using namespace P;
        if (JOB == 0) cv_load<CW, AB_N / CB, AB_LD>(C.in[I_ABWIN], r, C.lane, v);
        else if (JOB == 1) cv_load<CW, C_N / CB, C_LD>(C.in[I_CWIN], r, C.lane, v);
        else if (JOB == 2) cv_load<CW, D / CB, D>(C.in[I_ABWOUT], r, C.lane, v);
        else if (JOB == 6) cv_load<CW, D / CB, D>(C.in[I_CWOUT], r, C.lane, v);
        else if (JOB == 3 || JOB == 7) cv_load<CW, DFF / CB, DFF>(C.in[I_FG] + (size_t)(JOB == 7) * D * DFF, r, C.lane, v);
        else if (JOB == 4 || JOB == 8) cv_load<CW, DFF / CB, DFF>(C.in[I_FU] + (size_t)(JOB == 8) * D * DFF, r, C.lane, v);
        else cv_load<CW, D / CB, D>(C.in[I_FD] + (size_t)(JOB == 9) * DFF * D, r, C.lane, v);
    }
    static __device__ __forceinline__ void store(const Ctx& C, int r, const typename CvVec<CW>::T (&v)[8]) {
        using namespace P; unsigned char* ws = C.ws;
        if (JOB == 0) cv_store<CW, AB_N / CB, D / 8, 0>((bf16_t*)(ws + WS_WABIN), C.in[I_NMIX], r, C.lane, v);
        else if (JOB == 1) cv_store<CW, C_N / CB, D / 8, 0>((bf16_t*)(ws + WS_WCIN), C.in[I_NMIX] + D, r, C.lane, v);
        else if (JOB == 2) cv_store<CW, D / CB, D / 8, 0>((bf16_t*)(ws + WS_WABOUT), nullptr, r, C.lane, v);
        else if (JOB == 6) cv_store<CW, D / CB, D / 8, 0>((bf16_t*)(ws + WS_WCOUT), nullptr, r, C.lane, v);
        else if (JOB == 3 || JOB == 7) cv_store<CW, DFF / CB, D / 8, 1>((bf16_t*)(ws + (JOB == 7 ? WS_WGU1 : WS_WGU0)), C.in[I_NFFN] + (size_t)(JOB == 7) * D, r, C.lane, v);
        else if (JOB == 4 || JOB == 8) cv_store<CW, DFF / CB, D / 8, 2>((bf16_t*)(ws + (JOB == 8 ? WS_WGU1 : WS_WGU0)), C.in[I_NFFN] + (size_t)(JOB == 8) * D, r, C.lane, v);
        else cv_store<CW, D / CB, DFF / 8, 0>((bf16_t*)(ws + (JOB == 9 ? WS_WDN1 : WS_WDN0)), nullptr, r, C.lane, v);
    }
};
template <int CW_, int... JOBS> struct CvList;
template <int CW_> struct CvList<CW_> { static constexpr int CW = CW_, COUNT = 0;
    static __device__ __forceinline__ void load(const Ctx&, int, typename CvVec<CW_>::T (&)[8]) {}
    static __device__ __forceinline__ void store(const Ctx&, int, const typename CvVec<CW_>::T (&)[8]) {} };
template <int CW_, int J, int... REST> struct CvList<CW_, J, REST...> { static constexpr int CW = CW_, COUNT = CvJob<CW_, J>::COUNT + CvList<CW_, REST...>::COUNT;
    static __device__ __forceinline__ void load(const Ctx& C, int r, typename CvVec<CW_>::T (&v)[8]) { if (r < CvJob<CW_, J>::COUNT) CvJob<CW_, J>::load(C, r, v); else CvList<CW_, REST...>::load(C, r - CvJob<CW_, J>::COUNT, v); }
    static __device__ __forceinline__ void store(const Ctx& C, int r, const typename CvVec<CW_>::T (&v)[8]) { if (r < CvJob<CW_, J>::COUNT) CvJob<CW_, J>::store(C, r, v); else CvList<CW_, REST...>::store(C, r - CvJob<CW_, J>::COUNT, v); } };
template <class L> struct Bg { int next, cur; typename CvVec<L::CW>::T v[8]; };
template <class L> __device__ __forceinline__ void bg_issue(const Ctx& C, Bg<L>& b) { if (b.cur < 0 && b.next < L::COUNT) { L::load(C, b.next, b.v); b.cur = b.next; b.next += C.ngw; } }
template <class L> __device__ __forceinline__ void bg_commit(const Ctx& C, Bg<L>& b) { if (b.cur >= 0) { L::store(C, b.cur, b.v); b.cur = -1; } }
template <class L> __device__ __forceinline__ void bg_drain(const Ctx& C, Bg<L>& b) { bg_commit(C, b); while (b.next < L::COUNT) { bg_issue(C, b); bg_commit(C, b); } }
typedef CvList<4, 0, 1, 2, 3, 4, 5, 6, 7, 8, 9> CvL0;

__device__ __forceinline__ float rstd_of(float ssq) { return 1.0f / sqrtf(ssq * (1.0f / P::D) + P::EPS); }
__device__ __forceinline__ void xrow_to_bf16(const float* __restrict__ xrow, bf16_t* __restrict__ yrow, float* __restrict__ ssq, int lane) {
    const f32x4* xr = (const f32x4*)xrow + lane; u32x2* o = (u32x2*)yrow + lane; float s = 0.f;
#pragma unroll
    for (int j = 0; j < 16; ++j) { const f32x4 v = xr[64 * j]; s += (v.x * v.x + v.y * v.y) + (v.z * v.z + v.w * v.w); u32x2 w; w.x = cvt_pk_bf16(v.x, v.y); w.y = cvt_pk_bf16(v.z, v.w); o[64 * j] = w; }
    s = wave_sum(s); if (lane == 0) *ssq = s;
}
__device__ __forceinline__ void final_row(const bf16_t* __restrict__ yrow, float rstd, const float* __restrict__ gain, float* __restrict__ orow, int lane) {
    const u32x2* yr = (const u32x2*)yrow + lane; const f32x4* gr = (const f32x4*)gain + lane; f32x4* o = (f32x4*)orow + lane;
#pragma unroll
    for (int j = 0; j < 16; ++j) { const u32x2 w = yr[64 * j]; const f32x4 g = gr[64 * j];
        f32x4 v; v.x = __uint_as_float(w.x << 16) * rstd * g.x; v.y = __uint_as_float(w.x & 0xffff0000u) * rstd * g.y; v.z = __uint_as_float(w.y << 16) * rstd * g.z; v.w = __uint_as_float(w.y & 0xffff0000u) * rstd * g.w; __builtin_nontemporal_store(v, &o[64 * j]); }
}

__device__ __forceinline__ f32x4 gate_tile_part(const bf16_t* __restrict__ H, const bf16_t* __restrict__ Wg, int row0, int k0, int lane) {
    const bf16x8* a = (const bf16x8*)(H + (size_t)(row0 + (lane & 15)) * P::D + k0 + 8 * (lane >> 4));
    const bf16x8* b = (const bf16x8*)(Wg + (size_t)(lane & 15) * P::D + k0 + 8 * (lane >> 4));
    f32x4 acc = {0.f, 0.f, 0.f, 0.f};
#pragma unroll
    for (int kk = 0; kk < 16; ++kk) acc = __builtin_amdgcn_mfma_f32_16x16x32_bf16(a[4 * kk], b[4 * kk], acc, 0, 0, 0);
    return acc;
}
__device__ __forceinline__ f32x4 gate_tile(const bf16_t* __restrict__ H, const bf16_t* __restrict__ Wg, int row0, int lane) {
    const bf16x8* a = (const bf16x8*)(H + (size_t)(row0 + (lane & 15)) * P::D + 8 * (lane >> 4));
    const bf16x8* b = (const bf16x8*)(Wg + (size_t)(lane & 15) * P::D + 8 * (lane >> 4));
    f32x4 acc = {0.f, 0.f, 0.f, 0.f};
#pragma unroll 8
    for (int kk = 0; kk < P::D / 32; ++kk) acc = __builtin_amdgcn_mfma_f32_16x16x32_bf16(a[4 * kk], b[4 * kk], acc, 0, 0, 0);
    return acc;
}

struct EpiAbIn {
    static constexpr bool PERM = true, AFTER_DRAIN = false;
    bf16_t* proj; float* out; float* slab; const float* ssq;
    __device__ __forceinline__ void operator()(const f32x4 (&acc)[2][2][4][2], const pg8::Unit& u, int wr, int wc, int fr, int fq) const {
        using namespace P;
        if (u.slab >= 0) {
            float* sp = slab + (size_t)u.slab * 32768 + (size_t)(wr * 64 + fr) * 256 + wc * 32 + 8 * fq;
#pragma unroll
            for (int m = 0; m < 4; ++m)
#pragma unroll
                for (int bj = 0; bj < 2; ++bj) { *(f32x4*)(sp + m * 16 * 256 + bj * 128) = acc[0][bj][m][0]; *(f32x4*)(sp + m * 16 * 256 + bj * 128 + 4) = acc[0][bj][m][1]; }
            return;
        }
        const int seg = u.pn >> 3;
        const int row0 = u.pm * 256 + wr * 64 + fr, col0 = u.pn * 256 + wc * 32 + 8 * fq, cseg = col0 - seg * 2048;
#pragma unroll
        for (int ai = 0; ai < 2; ++ai)
#pragma unroll
            for (int m = 0; m < 4; ++m) { const int row = row0 + ai * 128 + m * 16; bf16_t* rp = proj + (size_t)row * AB_N + col0;
                float* fo = nullptr;
                if (seg == 3) fo = out + O_PK + (size_t)row * DB + cseg; else if (seg == 4) fo = out + O_PV + (size_t)row * DB + cseg;
                const float rs = rstd_of(ssq[row]);
#pragma unroll
                for (int bj = 0; bj < 2; ++bj) { const f32x4 v0 = acc[ai][bj][m][0] * rs, v1 = acc[ai][bj][m][1] * rs;
                    u32x4 w; w.x = cvt_pk_bf16(v0[0], v0[1]); w.y = cvt_pk_bf16(v0[2], v0[3]); w.z = cvt_pk_bf16(v1[0], v1[1]); w.w = cvt_pk_bf16(v1[2], v1[3]);
                    *(u32x4*)(rp + bj * 128) = w;
                    if (fo) { __builtin_nontemporal_store(v0, (f32x4*)(fo + bj * 128)); __builtin_nontemporal_store(v1, (f32x4*)(fo + bj * 128 + 4)); } } }
    }
};

struct EpiResid {
    static constexpr bool PERM = true, AFTER_DRAIN = false;
    bf16_t* Yb; float* slab; float* ssq;
    __device__ __forceinline__ void operator()(const f32x4 (&acc)[2][2][4][2], const pg8::Unit& u, int wr, int wc, int fr, int fq) const {
        using namespace P;
        if (u.slab >= 0) {
            float* sp = slab + (size_t)u.slab * 32768 + (size_t)(wr * 64 + fr) * 256 + wc * 32 + 8 * fq;
#pragma unroll
            for (int m = 0; m < 4; ++m)
#pragma unroll
                for (int bj = 0; bj < 2; ++bj) { *(f32x4*)(sp + m * 16 * 256 + bj * 128) = acc[0][bj][m][0]; *(f32x4*)(sp + m * 16 * 256 + bj * 128 + 4) = acc[0][bj][m][1]; }
            return;
        }
        const int row0 = u.pm * 256 + wr * 64 + fr, col0 = u.pn * 256 + wc * 32 + 8 * fq;
#pragma unroll
        for (int ai = 0; ai < 2; ++ai)
#pragma unroll
            for (int m = 0; m < 4; ++m) { const int row = row0 + ai * 128 + m * 16; bf16_t* __restrict__ yp = Yb + (size_t)row * D + col0;
                u32x4 b[2];
#pragma unroll
                for (int bj = 0; bj < 2; ++bj) b[bj] = *(const u32x4*)(yp + bj * 128);
                float ss = 0.f;
#pragma unroll
                for (int bj = 0; bj < 2; ++bj) { f32x4 y0 = acc[ai][bj][m][0], y1 = acc[ai][bj][m][1];
                    y0[0] += __uint_as_float(b[bj].x << 16); y0[1] += __uint_as_float(b[bj].x & 0xffff0000u); y0[2] += __uint_as_float(b[bj].y << 16); y0[3] += __uint_as_float(b[bj].y & 0xffff0000u);
                    y1[0] += __uint_as_float(b[bj].z << 16); y1[1] += __uint_as_float(b[bj].z & 0xffff0000u); y1[2] += __uint_as_float(b[bj].w << 16); y1[3] += __uint_as_float(b[bj].w & 0xffff0000u);
                    ss += (y0[0] * y0[0] + y0[1] * y0[1]) + (y0[2] * y0[2] + y0[3] * y0[3]) + (y1[0] * y1[0] + y1[1] * y1[1]) + (y1[2] * y1[2] + y1[3] * y1[3]);
                    u32x4 w; w.x = cvt_pk_bf16(y0[0], y0[1]); w.y = cvt_pk_bf16(y0[2], y0[3]); w.z = cvt_pk_bf16(y1[0], y1[1]); w.w = cvt_pk_bf16(y1[2], y1[3]);
                    *(u32x4*)(yp + bj * 128) = w; }
                ss += __shfl_xor(ss, 16); ss += __shfl_xor(ss, 32);
                if (fq == 0) atomicAdd(ssq + row, ss); }
    }
};
struct EpiSwiGLU {
    static constexpr bool PERM = true, AFTER_DRAIN = false;
    bf16_t* G; float* slab; const float* ssq;
    __device__ __forceinline__ void operator()(const f32x4 (&acc)[2][2][4][2], const pg8::Unit& u, int wr, int wc, int fr, int fq) const {
        using namespace P;
        if (u.slab >= 0) {
            float* sp = slab + (size_t)u.slab * 32768 + (size_t)(wr * 64 + fr) * 256 + wc * 32 + 8 * fq;
#pragma unroll
            for (int m = 0; m < 4; ++m)
#pragma unroll
                for (int bj = 0; bj < 2; ++bj) { *(f32x4*)(sp + m * 16 * 256 + bj * 128) = acc[0][bj][m][0]; *(f32x4*)(sp + m * 16 * 256 + bj * 128 + 4) = acc[0][bj][m][1]; }
            return;
        }
        const int row0 = u.pm * 256 + wr * 64 + fr, col0 = u.pn * 128 + wc * 32 + 8 * fq;
#pragma unroll
        for (int ai = 0; ai < 2; ++ai)
#pragma unroll
            for (int m = 0; m < 4; ++m) { const int row = row0 + ai * 128 + m * 16; float o[8]; const float rs = rstd_of(ssq[row]);
#pragma unroll
                for (int n = 0; n < 2; ++n)
#pragma unroll
                    for (int j = 0; j < 4; ++j) { const float gt = acc[ai][0][m][n][j] * rs, up = acc[ai][1][m][n][j] * rs;
                        o[4 * n + j] = gt * __builtin_amdgcn_rcpf(1.0f + __builtin_amdgcn_exp2f(-1.4426950408889634f * gt)) * up; }
                u32x4 w; w.x = cvt_pk_bf16(o[0], o[1]); w.y = cvt_pk_bf16(o[2], o[3]); w.z = cvt_pk_bf16(o[4], o[5]); w.w = cvt_pk_bf16(o[6], o[7]);
                *(u32x4*)(G + (size_t)row * DFF + col0) = w; }
    }
};
struct EpiBf16Plain {
    static constexpr bool PERM = true, AFTER_DRAIN = false;
    bf16_t* O; int ldc; float* slab; const float* ssq;
    __device__ __forceinline__ void operator()(const f32x4 (&acc)[2][2][4][2], const pg8::Unit& u, int wr, int wc, int fr, int fq) const {
        if (u.slab >= 0) {
            float* sp = slab + (size_t)u.slab * 32768 + (size_t)(wr * 64 + fr) * 256 + wc * 32 + 8 * fq;
#pragma unroll
            for (int m = 0; m < 4; ++m)
#pragma unroll
                for (int bj = 0; bj < 2; ++bj) { *(f32x4*)(sp + m * 16 * 256 + bj * 128) = acc[0][bj][m][0]; *(f32x4*)(sp + m * 16 * 256 + bj * 128 + 4) = acc[0][bj][m][1]; }
            return;
        }
        const int row0 = u.pm * 256 + wr * 64 + fr, col0 = u.pn * 256 + wc * 32 + 8 * fq;
#pragma unroll
        for (int ai = 0; ai < 2; ++ai)
#pragma unroll
            for (int m = 0; m < 4; ++m) { bf16_t* rp = O + (size_t)(row0 + ai * 128 + m * 16) * ldc + col0; const float rs = rstd_of(ssq[row0 + ai * 128 + m * 16]);
#pragma unroll
                for (int bj = 0; bj < 2; ++bj) { const f32x4 v0 = acc[ai][bj][m][0] * rs, v1 = acc[ai][bj][m][1] * rs;
                    u32x4 w; w.x = cvt_pk_bf16(v0[0], v0[1]); w.y = cvt_pk_bf16(v0[2], v0[3]); w.z = cvt_pk_bf16(v1[0], v1[1]); w.w = cvt_pk_bf16(v1[2], v1[3]);
                    *(u32x4*)(rp + bj * 128) = w; } }
    }
};

template <bool FINAL>
__device__ __forceinline__ void sample_row_wg(const Ctx& C, LAS unsigned char* lds, const float* __restrict__ slab, int r, const float* xs, bf16_t* yrow, float* ssq_out, const float* __restrict__ gain, float* orow) {
    f32x4 v[2]; float ss = 0.f; LAS float* red = (LAS float*)lds;
#pragma unroll
    for (int jj = 0; jj < 2; ++jj) { const int j = 2 * C.wave + jj; f32x4 a;
        if (xs) a = ((const f32x4*)xs)[64 * j + C.lane];
        else { const u32x2 w = ((const u32x2*)yrow)[64 * j + C.lane]; a.x = __uint_as_float(w.x << 16); a.y = __uint_as_float(w.x & 0xffff0000u); a.z = __uint_as_float(w.y << 16); a.w = __uint_as_float(w.y & 0xffff0000u); }
        const float* sp = slab + (size_t)(j * 16) * 32768 + (size_t)r * 256 + 4 * C.lane; f32x4 p[16];
#pragma unroll
        for (int s = 0; s < 16; ++s) p[s] = *(const f32x4*)(sp + (size_t)s * 32768);
#pragma unroll
        for (int s = 0; s < 16; ++s) a = a + p[s];
        v[jj] = a; ss += (a.x * a.x + a.y * a.y) + (a.z * a.z + a.w * a.w);
        if (!FINAL) { u32x2 w; w.x = cvt_pk_bf16(a.x, a.y); w.y = cvt_pk_bf16(a.z, a.w); ((u32x2*)yrow)[64 * j + C.lane] = w; } }
    ss = wave_sum(ss);
    __syncthreads();
    if (C.lane == 0) red[C.wave] = ss;
    __syncthreads();
    float tot = 0.f;
#pragma unroll
    for (int w = 0; w < 8; ++w) tot += red[w];
    if (!FINAL) { if (C.tid == 0) *ssq_out = tot; }
    else { const float rr = rstd_of(tot);
#pragma unroll
        for (int jj = 0; jj < 2; ++jj) { const int j = 2 * C.wave + jj; const f32x4 g = ((const f32x4*)gain)[64 * j + C.lane]; ((f32x4*)orow)[64 * j + C.lane] = v[jj] * rr * g; } }
}
template <bool LAYER0>
__device__ __forceinline__ void combine_inproj(const Ctx& C, const float* __restrict__ slab, bf16_t* __restrict__ PROJ, const float* __restrict__ ssq) {
    using namespace P;
    constexpr int NT = LAYER0 ? AB_N / 256 : C_N / 256, S = LAYER0 ? 6 : 5, LD = LAYER0 ? AB_N : C_N;
    for (int it = C.gw; it < 128 * NT; it += C.ngw) { const int r = it / NT, pn = it - r * NT;
        f32x4 a = {0.f, 0.f, 0.f, 0.f};
#pragma unroll
        for (int s = 0; s < S; ++s) a = a + *(const f32x4*)(slab + (size_t)(pn * S + s) * 32768 + (size_t)r * 256 + 4 * C.lane);
        a = a * rstd_of(ssq[NP + r]);
        const int col = pn * 256 + 4 * C.lane; u32x2 w; w.x = cvt_pk_bf16(a[0], a[1]); w.y = cvt_pk_bf16(a[2], a[3]);
        *(u32x2*)(PROJ + (size_t)(NP + r) * LD + col) = w;
        if (LAYER0) { const int seg = pn >> 3, cseg = col - seg * 2048;
            if (seg == 1) *(f32x4*)(C.out + O_SGV + (size_t)r * DA + cseg) = a;
            else if (seg == 3) *(f32x4*)(C.out + O_SK + (size_t)r * DB + cseg) = a;
            else if (seg == 4) *(f32x4*)(C.out + O_SV + (size_t)r * DB + cseg) = a; }
    }
}
__device__ __forceinline__ void combine_swiglu(const Ctx& C, const float* __restrict__ slab, bf16_t* __restrict__ G, const float* __restrict__ ssq) {
    using namespace P;
    typedef float f32x2 __attribute__((ext_vector_type(2)));
    constexpr int NT = DFF / 128, S = 3;
    for (int it = C.gw; it < 128 * NT; it += C.ngw) { const int r = it / NT, pn = it - r * NT;
        f32x2 g = {0.f, 0.f}, u = {0.f, 0.f};
#pragma unroll
        for (int s = 0; s < S; ++s) { const float* sp = slab + (size_t)(pn * S + s) * 32768 + (size_t)r * 256 + 2 * C.lane; g = g + *(const f32x2*)sp; u = u + *(const f32x2*)(sp + 128); }
        { const float rs = rstd_of(ssq[NP + r]); g = g * rs; u = u * rs; }
        const float o0 = g.x * __builtin_amdgcn_rcpf(1.0f + __builtin_amdgcn_exp2f(-1.4426950408889634f * g.x)) * u.x, o1 = g.y * __builtin_amdgcn_rcpf(1.0f + __builtin_amdgcn_exp2f(-1.4426950408889634f * g.y)) * u.y;
        *(unsigned*)(G + (size_t)(NP + r) * DFF + pn * 128 + 2 * C.lane) = cvt_pk_bf16(o0, o1);
    }
}

typedef short v4i16 __attribute__((ext_vector_type(4)));
__device__ __forceinline__ v4i16 tr16(LAS unsigned char* p) { return __builtin_amdgcn_ds_read_tr16_b64_v4i16((LAS v4i16*)p); }
__device__ __forceinline__ bf16x8 cat44(v4i16 lo, v4i16 hi) { bf16x8 r; r[0] = lo[0]; r[1] = lo[1]; r[2] = lo[2]; r[3] = lo[3]; r[4] = hi[0]; r[5] = hi[1]; r[6] = hi[2]; r[7] = hi[3]; return r; }
__device__ __forceinline__ bf16x8 pack8f(f32x4 a, f32x4 b) { u32x4 w; w.x = cvt_pk_bf16(a[0], a[1]); w.y = cvt_pk_bf16(a[2], a[3]); w.z = cvt_pk_bf16(b[0], b[1]); w.w = cvt_pk_bf16(b[2], b[3]); return __builtin_bit_cast(bf16x8, w); }

namespace AT {
constexpr int KT = 0, VT = 17408, TBUF = 34816, CK = 69632, SCAN = 86272, TSTR = 272;
constexpr float C2 = 0.12751743f;
constexpr float LOG2E = 1.4426950408889634f;
}

template <bool SAMPLE>
__device__ __forceinline__ void attn_prepare_ck(const Ctx& C, LAS unsigned char* lds, int b, int h) {
    using namespace P;
    LAS float* ck = (LAS float*)(lds + AT::CK); LAS float* scan = (LAS float*)(lds + AT::SCAN);
    constexpr int n = SAMPLE ? PAST + DEC_S : SEQ;
    float v[8]; const int t0 = 8 * C.tid;
#pragma unroll
    for (int j = 0; j < 8; ++j) { const int t = t0 + j; float x = 0.f;
        if (t < n) { if (!SAMPLE) x = C.out[O_PLF + ((size_t)b * SEQ + t) * HB + h];
                     else x = t < PAST ? C.in[I_CLF][((size_t)b * PAST + t) * HB + h] : C.out[O_SLF + ((size_t)b * DEC_S + (t - PAST)) * HB + h]; }
        v[j] = x; }
#pragma unroll
    for (int j = 1; j < 8; ++j) v[j] += v[j - 1];
    const float tot = v[7]; float x = tot;
#pragma unroll
    for (int o = 1; o < 64; o <<= 1) { const float y = __shfl_up(x, o); if (C.lane >= o) x += y; }
    if (C.lane == 63) scan[C.wave] = x;
    __syncthreads();
    float base = 0.f;
    for (int w = 0; w < C.wave; ++w) base += scan[w];
    const float excl = base + x - tot;
#pragma unroll
    for (int j = 0; j < 8; ++j) if (t0 + j < n + 64) ck[t0 + j] = (excl + v[j]) * AT::LOG2E;
    __syncthreads();
}

template <bool SAMPLE>
__device__ __forceinline__ void attn_load_tile(const Ctx& C, const bf16_t* __restrict__ PROJ, int b, int h, int j, bf16x8 (&kreg)[2], bf16x8 (&vreg)[2]) {
    using namespace P;
#pragma unroll
    for (int i = 0; i < 2; ++i) { const int id = C.tid + 512 * i, r = id >> 4, ch = id & 15;
        if (!SAMPLE) { const bf16_t* p = PROJ + (size_t)(b * SEQ + 64 * j + r) * AB_N + h * DHB + 8 * ch;
            kreg[i] = *(const bf16x8*)(p + 3 * 2048); vreg[i] = *(const bf16x8*)(p + 4 * 2048); }
        else { const int kidx = 64 * j + r;
            if (kidx < PAST) { const size_t o = (((size_t)b * PAST + kidx) * HB + h) * DHB + 8 * ch; const float* kp = C.in[I_CK] + o; const float* vp = C.in[I_CV] + o;
                kreg[i] = pack8f(*(const f32x4*)kp, *(const f32x4*)(kp + 4)); vreg[i] = pack8f(*(const f32x4*)vp, *(const f32x4*)(vp + 4)); }
            else if (kidx < PAST + DEC_S) { const bf16_t* p = PROJ + (size_t)(NP + b * DEC_S + (kidx - PAST)) * AB_N + h * DHB + 8 * ch;
                kreg[i] = *(const bf16x8*)(p + 3 * 2048); vreg[i] = *(const bf16x8*)(p + 4 * 2048); }
            else { kreg[i] = (bf16x8){0, 0, 0, 0, 0, 0, 0, 0}; vreg[i] = (bf16x8){0, 0, 0, 0, 0, 0, 0, 0}; } }
    }
}

template <bool SAMPLE>
__device__ __forceinline__ void attn_qblock(const Ctx& C, LAS unsigned char* lds, const bf16_t* __restrict__ PROJ, bf16_t* __restrict__ MIX, int b, int h, int qb) {
    using namespace P;
    const int fr = C.lane & 15, fq = C.lane >> 4;
    const bool active = SAMPLE ? (C.wave == 0) : true;
    const int qpos0 = SAMPLE ? PAST : 256 * qb + 32 * C.wave;
    const int qrow0 = SAMPLE ? NP + b * DEC_S : b * SEQ + qpos0;
    const int ntiles = SAMPLE ? (PAST + DEC_S + 63) / 64 : 4 * qb + 4;
    LAS float* ck = (LAS float*)(lds + AT::CK);
    bf16x8 qf[2][4]; float cq2[2], mrow[2], lrow[2]; int qpos[2];
    f32x4 oacc[2][8];
#pragma unroll
    for (int qt = 0; qt < 2; ++qt) {
#pragma unroll
        for (int kk = 0; kk < 4; ++kk) qf[qt][kk] = *(const bf16x8*)(PROJ + (size_t)(qrow0 + 16 * qt + fr) * AB_N + 2 * 2048 + h * DHB + 32 * kk + 8 * fq);
        qpos[qt] = qpos0 + 16 * qt + fr; cq2[qt] = ck[qpos[qt]]; mrow[qt] = -1e30f; lrow[qt] = 0.f;
#pragma unroll
        for (int c = 0; c < 8; ++c) oacc[qt][c] = (f32x4){0.f, 0.f, 0.f, 0.f};
    }
    bf16x8 kreg[2], vreg[2];
    attn_load_tile<SAMPLE>(C, PROJ, b, h, ntiles - 1, kreg, vreg);
#define ATTN_STEP(IT, TBOFF) do { const int j = ntiles - 1 - (IT); LAS unsigned char* tb = lds + (TBOFF); \
_Pragma("unroll") \
        for (int i = 0; i < 2; ++i) { const int id = C.tid + 512 * i, r = id >> 4, ch = id & 15; \
            *(LAS bf16x8*)(tb + AT::KT + r * AT::TSTR + ch * 16) = kreg[i]; *(LAS bf16x8*)(tb + AT::VT + r * AT::TSTR + ch * 16) = vreg[i]; } \
        __syncthreads(); \
        if (j > 0) attn_load_tile<SAMPLE>(C, PROJ, b, h, j - 1, kreg, vreg); \
        const int key0 = 64 * j; \
        if (active && key0 <= qpos0 + 31) { \
        const bool need_mask = key0 + 63 > qpos0; \
        f32x4 s[2][4]; \
_Pragma("unroll") \
        for (int qt = 0; qt < 2; ++qt) \
_Pragma("unroll") \
            for (int kt = 0; kt < 4; ++kt) s[qt][kt] = (f32x4){0.f, 0.f, 0.f, 0.f}; \
_Pragma("unroll") \
        for (int kt = 0; kt < 4; ++kt) { \
_Pragma("unroll") \
            for (int kk = 0; kk < 4; ++kk) { const bf16x8 kf = *(const LAS bf16x8*)(tb + AT::KT + (16 * kt + fr) * AT::TSTR + (32 * kk + 8 * fq) * 2); \
_Pragma("unroll") \
                for (int qt = 0; qt < 2; ++qt) s[qt][kt] = __builtin_amdgcn_mfma_f32_16x16x32_bf16(kf, qf[qt][kk], s[qt][kt], 0, 0, 0); } \
            __builtin_amdgcn_sched_barrier(0); } \
_Pragma("unroll") \
        for (int kt = 0; kt < 4; ++kt) { const f32x4 cb = *(const LAS f32x4*)(ck + key0 + 16 * kt + 4 * fq); \
_Pragma("unroll") \
            for (int qt = 0; qt < 2; ++qt) \
_Pragma("unroll") \
                for (int r = 0; r < 4; ++r) s[qt][kt][r] = s[qt][kt][r] * AT::C2 + (cq2[qt] - cb[r]); } \
        if (need_mask) { \
_Pragma("unroll") \
            for (int kt = 0; kt < 4; ++kt) \
_Pragma("unroll") \
                for (int qt = 0; qt < 2; ++qt) \
_Pragma("unroll") \
                    for (int r = 0; r < 4; ++r) if (key0 + 16 * kt + 4 * fq + r > qpos[qt]) s[qt][kt][r] = -__builtin_inff(); } \
        bf16x8 pf[2][2]; \
_Pragma("unroll") \
        for (int qt = 0; qt < 2; ++qt) { \
            float tmax = s[qt][0][0]; \
_Pragma("unroll") \
            for (int kt = 0; kt < 4; ++kt) \
_Pragma("unroll") \
                for (int r = 0; r < 4; ++r) tmax = fmaxf(tmax, s[qt][kt][r]); \
            tmax = fmaxf(tmax, __shfl_xor(tmax, 16)); tmax = fmaxf(tmax, __shfl_xor(tmax, 32)); \
            if (__any(tmax > mrow[qt])) { \
                const float mn = fmaxf(mrow[qt], tmax), alpha = __builtin_amdgcn_exp2f(mrow[qt] - mn); mrow[qt] = mn; lrow[qt] *= alpha; \
_Pragma("unroll") \
                for (int c = 0; c < 8; ++c) oacc[qt][c] = oacc[qt][c] * alpha; } \
            const float mn = mrow[qt]; float psum = 0.f; \
_Pragma("unroll") \
            for (int kt = 0; kt < 4; ++kt) \
_Pragma("unroll") \
                for (int r = 0; r < 4; ++r) { const float p = __builtin_amdgcn_exp2f(s[qt][kt][r] - mn); psum += p; s[qt][kt][r] = p; } \
            lrow[qt] += psum; \
            pf[qt][0] = pack8f(s[qt][0], s[qt][1]); pf[qt][1] = pack8f(s[qt][2], s[qt][3]); \
        } \
_Pragma("unroll") \
        for (int ks = 0; ks < 2; ++ks) \
_Pragma("unroll") \
            for (int c = 0; c < 8; ++c) { LAS unsigned char* vb = tb + AT::VT + (32 * ks + 4 * fq + ((C.lane & 15) >> 2)) * AT::TSTR + (16 * c + 4 * (C.lane & 3)) * 2; \
                const bf16x8 vf = cat44(tr16(vb), tr16(vb + 16 * AT::TSTR)); \
_Pragma("unroll") \
                for (int qt = 0; qt < 2; ++qt) oacc[qt][c] = __builtin_amdgcn_mfma_f32_16x16x32_bf16(vf, pf[qt][ks], oacc[qt][c], 0, 0, 0); \
                if (c & 1) __builtin_amdgcn_sched_barrier(0); } \
            } \
    } while (0)
    for (int it = 0; it < ntiles; it += 2) { ATTN_STEP(it, 0); if (it + 1 < ntiles) ATTN_STEP(it + 1, AT::TBUF); }
#undef ATTN_STEP
    __syncthreads();
    if (active) {
#pragma unroll
        for (int qt = 0; qt < (SAMPLE ? 1 : 2); ++qt) { float lt = lrow[qt]; lt += __shfl_xor(lt, 16); lt += __shfl_xor(lt, 32); const float inv = 1.0f / lt;
            bf16_t* op = MIX + (size_t)(qrow0 + 16 * qt + fr) * D + DA + h * DHB + 4 * fq;
#pragma unroll
            for (int c = 0; c < 8; ++c) { const f32x4 o = oacc[qt][c] * inv; u32x2 w; w.x = cvt_pk_bf16(o[0], o[1]); w.y = cvt_pk_bf16(o[2], o[3]); *(u32x2*)(op + 16 * c) = w; } }
    }
}

namespace GM { constexpr int WT = 0, WSTR = 272, VA = 34816, VSTR = 544; }
__device__ __forceinline__ void gmlp_unit(const Ctx& C, LAS unsigned char* lds, const bf16_t* __restrict__ PROJ, bf16_t* __restrict__ MIX, int rowbase, int nrows, int g) {
    using namespace P;
    __syncthreads();
    { const float* Wg = C.in[I_GWS] + (size_t)g * 128 * 128; const int r = C.tid >> 2, c0 = (C.tid & 3) * 32;
#pragma unroll
        for (int q = 0; q < 4; ++q) { const int c = c0 + 8 * q; f32x4 a = *(const f32x4*)(Wg + r * 128 + c), bb = *(const f32x4*)(Wg + r * 128 + c + 4);
#pragma unroll
            for (int e = 0; e < 4; ++e) { if (c + e > r) a[e] = 0.f; if (c + 4 + e > r) bb[e] = 0.f; }
            *(LAS bf16x8*)(lds + GM::WT + r * GM::WSTR + c * 2) = pack8f(a, bb); } }
#pragma unroll
    for (int i = 0; i < 8; ++i) { const int id = C.tid + 512 * i, s = id >> 5, ch = id & 31; bf16x8 v = (bf16x8){0, 0, 0, 0, 0, 0, 0, 0};
        if (s < nrows) v = *(const bf16x8*)(PROJ + (size_t)(rowbase + s) * AB_N + DA + g * 256 + 8 * ch);
        *(LAS bf16x8*)(lds + GM::VA + s * GM::VSTR + ch * 16) = v; }
    __syncthreads();
    if (16 * C.wave < nrows) {
        const int fr = C.lane & 15, fq = C.lane >> 4, w = C.wave; const int nk = (16 * w + 15) / 32 + 1;
        f32x4 acc[16];
#pragma unroll
        for (int nt = 0; nt < 16; ++nt) acc[nt] = (f32x4){0.f, 0.f, 0.f, 0.f};
        for (int kk = 0; kk < nk; ++kk) { const bf16x8 wf = *(const LAS bf16x8*)(lds + GM::WT + (16 * w + fr) * GM::WSTR + (32 * kk + 8 * fq) * 2);
            LAS unsigned char* vb = lds + GM::VA + (32 * kk + 8 * fq + ((C.lane & 15) >> 2)) * GM::VSTR + 4 * (C.lane & 3) * 2;
#pragma unroll
            for (int nt = 0; nt < 16; ++nt) { const bf16x8 af = cat44(tr16(vb + nt * 32), tr16(vb + nt * 32 + 4 * GM::VSTR)); acc[nt] = __builtin_amdgcn_mfma_f32_16x16x32_bf16(af, wf, acc[nt], 0, 0, 0); } }
        const int row = rowbase + 16 * w + fr; const float bias = C.in[I_GB][g * 128 + 16 * w + fr];
        const bf16_t* up = PROJ + (size_t)row * AB_N + g * 256 + 4 * fq; bf16_t* op = MIX + (size_t)row * D + g * 256 + 4 * fq;
#pragma unroll
        for (int nt = 0; nt < 16; ++nt) { const u32x2 uu = *(const u32x2*)(up + 16 * nt);
            const float u0 = __uint_as_float(uu.x << 16), u1 = __uint_as_float(uu.x & 0xffff0000u), u2 = __uint_as_float(uu.y << 16), u3 = __uint_as_float(uu.y & 0xffff0000u);
            u32x2 wv; wv.x = cvt_pk_bf16(u0 * (acc[nt][0] + bias), u1 * (acc[nt][1] + bias)); wv.y = cvt_pk_bf16(u2 * (acc[nt][2] + bias), u3 * (acc[nt][3] + bias));
            *(u32x2*)(op + 16 * nt) = wv; }
    }
}

__device__ __forceinline__ unsigned cvt_pk_bf16_cv(float lo, float hi) { typedef __bf16 bf2_t __attribute__((ext_vector_type(2))); typedef float f2_t __attribute__((ext_vector_type(2))); const f2_t v = {lo, hi}; return __builtin_bit_cast(unsigned, __builtin_convertvector(v, bf2_t)); }
__device__ __forceinline__ bf16_t f2bf_rne(float f) { const unsigned u = __float_as_uint(f); return (bf16_t)((u + 0x7fffu + ((u >> 16) & 1u)) >> 16); }
#ifndef ML_T
#define ML_T(k)
#endif
namespace ML {
constexpr int QT = 0, QSTR = 528, KT = 33792, VT = 67584, VSTR = 112, VW = 74752, CIT = 81920, GA = 107264;
constexpr float KSCALE = 0.0625f, LOG2E = 1.4426950408889634f;
}
template <bool SAMPLE>
__device__ __forceinline__ void mlstm_unit(const Ctx& C, LAS unsigned char* lds, const bf16_t* __restrict__ PROJ, const float* __restrict__ GATES, bf16_t* __restrict__ HS, int b, int h, int sl, const f32x4* __restrict__ GS, const bf16x8* __restrict__ PB) {
    using namespace P;
    const int fr = C.lane & 15, fq = C.lane >> 4, w = C.wave, tt = w & 3, vt = w >> 2, qsub = (C.lane & 15) >> 2, psub = C.lane & 3;
    constexpr int NCH = SAMPLE ? 1 : SEQ / 64, LV = SAMPLE ? DEC_S : 64;
    const int rowbase = SAMPLE ? NP + b * DEC_S : b * SEQ;
    const int bh = b * HC + h;
    LAS float* ga = (LAS float*)(lds + ML::GA);
    f32x4 Cacc[2][3]; float mprev = 0.f;
#pragma unroll
    for (int dt = 0; dt < 2; ++dt)
#pragma unroll
        for (int v2 = 0; v2 < 3; ++v2) Cacc[dt][v2] = (f32x4){0.f, 0.f, 0.f, 0.f};
    if (SAMPLE) {
        const float* c0 = C.in[I_SC] + (size_t)bh * DKC * DVC; const float* n0 = C.in[I_SN] + (size_t)bh * DKC;
#pragma unroll
        for (int dt = 0; dt < 2; ++dt) {
#pragma unroll
            for (int v2 = 0; v2 < 2; ++v2)
#pragma unroll
                for (int r = 0; r < 4; ++r) Cacc[dt][v2][r] = c0[(size_t)(32 * w + 16 * dt + 4 * fq + r) * DVC + sl * 32 + 16 * v2 + fr];
#pragma unroll
            for (int r = 0; r < 4; ++r) Cacc[dt][2][r] = fr == 0 ? n0[32 * w + 16 * dt + 4 * fq + r] : 0.f; }
        mprev = C.in[I_SM][bh];
    }
    __syncthreads();
#define ML_WRITE_CIT() do { _Pragma("unroll") for (int dt = 0; dt < 2; ++dt) _Pragma("unroll") for (int v2 = 0; v2 < 3; ++v2) { \
        u32x2 w_; w_.x = cvt_pk_bf16_cv(Cacc[dt][v2][0], Cacc[dt][v2][1]); w_.y = cvt_pk_bf16_cv(Cacc[dt][v2][2], Cacc[dt][v2][3]); \
        *(LAS u32x2*)(lds + ML::CIT + (16 * v2 + fr) * ML::QSTR + (32 * w + 16 * dt + 4 * fq) * 2) = w_; } } while (0)
    ML_WRITE_CIT();
    bf16x8 qreg[4], kreg[4], vreg, pSn[2]; float lfv, igv; f32x4 gsn;
#define ML_LOAD_CHUNK(c) do { \
_Pragma("unroll") \
        for (int i = 0; i < 4; ++i) { const int id = C.tid + 512 * i, r = id >> 5, ch = id & 31; \
            if (r < LV) { const bf16_t* p = PROJ + (size_t)(rowbase + 64 * (c) + r) * C_N + h * DKC + 8 * ch; qreg[i] = *(const bf16x8*)p; kreg[i] = *(const bf16x8*)(p + 2048); } \
            else { qreg[i] = (bf16x8){0, 0, 0, 0, 0, 0, 0, 0}; kreg[i] = (bf16x8){0, 0, 0, 0, 0, 0, 0, 0}; } } \
        { const int r = (C.tid & 255) >> 2, ch = C.tid & 3; \
            if (r < LV) vreg = *(const bf16x8*)(PROJ + (size_t)(rowbase + 64 * (c) + r) * C_N + 4096 + h * DVC + sl * 32 + 8 * ch); else vreg = (bf16x8){0, 0, 0, 0, 0, 0, 0, 0}; } \
        if constexpr (SAMPLE) { if (C.lane < LV) { const float* gp = GATES + (size_t)(rowbase + 64 * (c) + C.lane) * 16; igv = gp[h]; lfv = gp[8 + h]; } else { igv = -__builtin_inff(); lfv = 0.f; } } \
        else { gsn = GS[(size_t)bh * SEQ + 64 * (c) + C.lane]; const bf16x8* pp = PB + ((size_t)(bh * 64 + (c)) * 4 + tt) * 128 + C.lane; pSn[0] = pp[0]; pSn[1] = pp[64]; } \
    } while (0)
    ML_LOAD_CHUNK(0);
    for (int c = 0; c < NCH; ++c) {
        ML_T(0);
        float bcs, av, cm; bf16x8 pS0, pS1;
        if constexpr (SAMPLE) {
            bcs = lfv;
#pragma unroll
            for (int o = 1; o < 64; o <<= 1) { const float y = __shfl_up(bcs, o); if (C.lane >= o) bcs += y; }
            av = igv - bcs; cm = av;
#pragma unroll
            for (int o = 1; o < 64; o <<= 1) { const float y = __shfl_up(cm, o); if (C.lane >= o) cm = fmaxf(cm, y); }
        } else { bcs = gsn[0]; av = gsn[1]; cm = gsn[2]; pS0 = pSn[0]; pS1 = pSn[1]; }
        const float Mt = fmaxf(mprev, cm), Mend = __shfl(Mt, 63), bend = __shfl(bcs, 63);
        const float wsv = __builtin_amdgcn_exp2f((av - Mend) * ML::LOG2E), wc = __builtin_amdgcn_exp2f((mprev - Mend) * ML::LOG2E);
#pragma unroll
        for (int i = 0; i < 4; ++i) { const int id = C.tid + 512 * i, r = id >> 5, ch = id & 31;
            *(LAS bf16x8*)(lds + ML::QT + r * ML::QSTR + ch * 16) = qreg[i]; *(LAS bf16x8*)(lds + ML::KT + r * ML::QSTR + ch * 16) = kreg[i]; }
        { const int r = C.tid < 256 ? (C.tid >> 2) : ((C.tid - 256) >> 1) & 63; const float sc = __shfl(wsv, r) * ML::KSCALE;
            if (C.tid < 256) { const int ch = C.tid & 3; *(LAS bf16x8*)(lds + ML::VT + r * ML::VSTR + ch * 16) = vreg;
                const u32x4 vv = __builtin_bit_cast(u32x4, vreg); u32x4 o;
#pragma unroll
                for (int e = 0; e < 4; ++e) o[e] = cvt_pk_bf16(__uint_as_float(vv[e] << 16) * sc, __uint_as_float(vv[e] & 0xffff0000u) * sc);
                *(LAS u32x4*)(lds + ML::VW + r * ML::VSTR + ch * 16) = o; }
            else if (C.tid < 384) { const int hf = C.tid & 1;
                u32x4 o1 = {0u, 0u, 0u, 0u}, o2 = {0u, 0u, 0u, 0u}; if (hf == 0) { o1.x = 0x3F80u; o2.x = cvt_pk_bf16(sc, 0.f); }
                *(LAS u32x4*)(lds + ML::VT + r * ML::VSTR + 64 + hf * 16) = o1; *(LAS u32x4*)(lds + ML::VW + r * ML::VSTR + 64 + hf * 16) = o2; } }
        if (SAMPLE && w == 0) { ga[C.lane] = av; ga[64 + C.lane] = wsv; }
        __syncthreads();
        ML_T(1);
        if (c + 1 < NCH) ML_LOAD_CHUNK(c + 1);
        {
            const float Mrow = __shfl(Mt, 16 * tt + fr), brow = __shfl(bcs, 16 * tt + fr);
            const float winter = __builtin_amdgcn_exp2f((mprev - Mrow) * ML::LOG2E);
            bf16x8 qfr[8];
#pragma unroll
            for (int kk = 0; kk < 8; ++kk) qfr[kk] = *(const LAS bf16x8*)(lds + ML::QT + (16 * tt + fr) * ML::QSTR + (32 * kk + 8 * fq) * 2);
            const int tpos = 16 * tt + fr; float rrow = 1.0f;
            if constexpr (SAMPLE) {
                f32x4 sT[4];
#pragma unroll
                for (int st = 0; st < 4; ++st) { sT[st] = (f32x4){0.f, 0.f, 0.f, 0.f};
#pragma unroll
                    for (int kk = 0; kk < 8; ++kk) { const bf16x8 kf = *(const LAS bf16x8*)(lds + ML::KT + (16 * st + fr) * ML::QSTR + (32 * kk + 8 * fq) * 2);
                        sT[st] = __builtin_amdgcn_mfma_f32_16x16x32_bf16(kf, qfr[kk], sT[st], 0, 0, 0); }
                    __builtin_amdgcn_sched_barrier(0); }
#pragma unroll
                for (int st = 0; st < 4; ++st) { const f32x4 a4 = *(const LAS f32x4*)(ga + 16 * st + 4 * fq);
#pragma unroll
                    for (int r = 0; r < 4; ++r) { const int spos = 16 * st + 4 * fq + r;
                        float wgt = __builtin_amdgcn_exp2f((a4[r] - Mrow) * ML::LOG2E); if (spos > tpos) wgt = 0.f;
                        sT[st][r] = sT[st][r] * ML::KSCALE * wgt; } }
                pS0 = pack8f(sT[0], sT[1]); pS1 = pack8f(sT[2], sT[3]);
            } else rrow = __builtin_amdgcn_exp2f((__shfl(cm, tpos) - Mrow) * ML::LOG2E);
            f32x4 acc = (f32x4){0.f, 0.f, 0.f, 0.f}, acc3 = (f32x4){0.f, 0.f, 0.f, 0.f}, accP = (f32x4){0.f, 0.f, 0.f, 0.f}, acc3P = (f32x4){0.f, 0.f, 0.f, 0.f};
#pragma unroll
            for (int kk = 0; kk < 8; ++kk) { const bf16x8 cf = *(const LAS bf16x8*)(lds + ML::CIT + (16 * vt + fr) * ML::QSTR + (32 * kk + 8 * fq) * 2);
                const bf16x8 nf = *(const LAS bf16x8*)(lds + ML::CIT + (32 + fr) * ML::QSTR + (32 * kk + 8 * fq) * 2);
                acc = __builtin_amdgcn_mfma_f32_16x16x32_bf16(cf, qfr[kk], acc, 0, 0, 0); acc3 = __builtin_amdgcn_mfma_f32_16x16x32_bf16(nf, qfr[kk], acc3, 0, 0, 0); }
            { LAS unsigned char* vb = lds + ML::VT + (4 * fq + qsub) * ML::VSTR + (16 * vt + 4 * psub) * 2; LAS unsigned char* ob = lds + ML::VT + (4 * fq + qsub) * ML::VSTR + (32 + 4 * psub) * 2;
                const bf16x8 vf0 = cat44(tr16(vb), tr16(vb + 16 * ML::VSTR)), of0 = cat44(tr16(ob), tr16(ob + 16 * ML::VSTR));
                accP = __builtin_amdgcn_mfma_f32_16x16x32_bf16(vf0, pS0, accP, 0, 0, 0); acc3P = __builtin_amdgcn_mfma_f32_16x16x32_bf16(of0, pS0, acc3P, 0, 0, 0);
                const bf16x8 vf1 = cat44(tr16(vb + 32 * ML::VSTR), tr16(vb + 48 * ML::VSTR)), of1 = cat44(tr16(ob + 32 * ML::VSTR), tr16(ob + 48 * ML::VSTR));
                accP = __builtin_amdgcn_mfma_f32_16x16x32_bf16(vf1, pS1, accP, 0, 0, 0); acc3P = __builtin_amdgcn_mfma_f32_16x16x32_bf16(of1, pS1, acc3P, 0, 0, 0); }
            acc = acc * winter + accP * rrow; acc3 = acc3 * winter + acc3P * rrow;
            const float den = __shfl(acc3[0], fr);
            const float lim = __builtin_amdgcn_exp2f(-(brow + Mrow) * ML::LOG2E);
            const float inv = 1.0f / fmaxf(fabsf(den), lim);
            if (tpos < LV) { const f32x4 hv = acc * inv; u32x2 hw; hw.x = cvt_pk_bf16(hv[0], hv[1]); hw.y = cvt_pk_bf16(hv[2], hv[3]); *(u32x2*)(HS + (size_t)(rowbase + 64 * c + tpos) * D + h * DVC + sl * 32 + 16 * vt + 4 * fq) = hw; }
        }
        __syncthreads();
        ML_T(2);
        {
#pragma unroll
            for (int dt = 0; dt < 2; ++dt)
#pragma unroll
                for (int v2 = 0; v2 < 3; ++v2) Cacc[dt][v2] = Cacc[dt][v2] * wc;
#pragma unroll
            for (int ks = 0; ks < 2; ++ks) { bf16x8 vw[3];
#pragma unroll
                for (int v2 = 0; v2 < 3; ++v2) { LAS unsigned char* vb = lds + ML::VW + (32 * ks + 8 * fq + qsub) * ML::VSTR + (16 * v2 + 4 * psub) * 2; vw[v2] = cat44(tr16(vb), tr16(vb + 4 * ML::VSTR)); }
#pragma unroll
                for (int dt = 0; dt < 2; ++dt) { LAS unsigned char* kb = lds + ML::KT + (32 * ks + 8 * fq + qsub) * ML::QSTR + (32 * w + 16 * dt + 4 * psub) * 2;
                    const bf16x8 kf = cat44(tr16(kb), tr16(kb + 4 * ML::QSTR));
#pragma unroll
                    for (int v2 = 0; v2 < 3; ++v2) Cacc[dt][v2] = __builtin_amdgcn_mfma_f32_16x16x32_bf16(kf, vw[v2], Cacc[dt][v2], 0, 0, 0); } }
            ML_WRITE_CIT();
            mprev = bend + Mend;
        }
        __syncthreads();
        ML_T(3);
    }
    { float* co = C.out + (SAMPLE ? O_SC : O_PC) + (size_t)bh * DKC * DVC;
#pragma unroll
        for (int dt = 0; dt < 2; ++dt)
#pragma unroll
            for (int v2 = 0; v2 < 2; ++v2)
#pragma unroll
                for (int r = 0; r < 4; ++r) co[(size_t)(32 * w + 16 * dt + 4 * fq + r) * DVC + sl * 32 + 16 * v2 + fr] = Cacc[dt][v2][r];
        if (sl == 0) { float* no = C.out + (SAMPLE ? O_SN : O_PN) + (size_t)bh * DKC;
            if (fr == 0) {
#pragma unroll
                for (int dt = 0; dt < 2; ++dt)
#pragma unroll
                    for (int r = 0; r < 4; ++r) no[32 * w + 16 * dt + 4 * fq + r] = Cacc[dt][2][r]; }
            if (C.tid == 0) C.out[(SAMPLE ? O_SM : O_PM) + bh] = mprev; } }
}
#undef ML_WRITE_CIT
#undef ML_LOAD_CHUNK
__device__ __forceinline__ void mlstm_prepass(const Ctx& C, const bf16_t* __restrict__ PROJ, const float* __restrict__ GATES, f32x4* __restrict__ GS, bf16x8* __restrict__ PB, int bh, int c) {
    using namespace P;
    const int fr = C.lane & 15, fq = C.lane >> 4, w = C.wave, tt = w & 3, sh = w >> 2, b = bh >> 3, h = bh & 7;
    const size_t rowc = (size_t)b * SEQ + 64 * c;
    const float* gp = GATES + (rowc + C.lane) * 16; const float igv = gp[h], lfv = gp[8 + h];
    bf16x8 qfr[8];
#pragma unroll
    for (int kk = 0; kk < 8; ++kk) qfr[kk] = *(const bf16x8*)(PROJ + (rowc + 16 * tt + fr) * C_N + h * DKC + 32 * kk + 8 * fq);
    float bcs = lfv;
#pragma unroll
    for (int o = 1; o < 64; o <<= 1) { const float y = __shfl_up(bcs, o); if (C.lane >= o) bcs += y; }
    const float av = igv - bcs; float cm = av;
#pragma unroll
    for (int o = 1; o < 64; o <<= 1) { const float y = __shfl_up(cm, o); if (C.lane >= o) cm = fmaxf(cm, y); }
    if (w == 0) GS[(size_t)bh * SEQ + 64 * c + C.lane] = (f32x4){bcs, av, cm, 0.f};
    const int tpos = 16 * tt + fr; const float cmrow = __shfl(cm, tpos);
    f32x4 sT[2];
#pragma unroll
    for (int i = 0; i < 2; ++i) { const int st = 2 * sh + i; sT[i] = (f32x4){0.f, 0.f, 0.f, 0.f};
        if (st <= tt) {
#pragma unroll
            for (int kk = 0; kk < 8; ++kk) { const bf16x8 kf = *(const bf16x8*)(PROJ + (rowc + 16 * st + fr) * C_N + 2048 + h * DKC + 32 * kk + 8 * fq);
                sT[i] = __builtin_amdgcn_mfma_f32_16x16x32_bf16(kf, qfr[kk], sT[i], 0, 0, 0); } }
#pragma unroll
        for (int r = 0; r < 4; ++r) { const int spos = 16 * st + 4 * fq + r; const float as = __shfl(av, spos);
            float wgt = __builtin_amdgcn_exp2f((as - cmrow) * ML::LOG2E); if (spos > tpos) wgt = 0.f;
            sT[i][r] = sT[i][r] * ML::KSCALE * wgt; } }
    PB[((size_t)(bh * 64 + c) * 4 + tt) * 128 + sh * 64 + C.lane] = pack8f(sT[0], sT[1]);
}
__device__ __forceinline__ void mlstm_headnorm_row(const bf16_t* __restrict__ hs, const bf16_t* __restrict__ opre, const float* __restrict__ gn, bf16_t* __restrict__ mix, int lane) {
    const u32x4* hr = (const u32x4*)hs + lane; const f32x4* gr = (const f32x4*)gn + 2 * lane; const u32x4* orr = (const u32x4*)opre + lane; u32x4* mo = (u32x4*)mix + lane;
#pragma unroll
    for (int hh = 0; hh < 8; ++hh) { const u32x4 hw = hr[64 * hh], ow = orr[64 * hh]; const f32x4 g0 = gr[128 * hh], g1 = gr[128 * hh + 1];
        float v[8], o[8];
#pragma unroll
        for (int e = 0; e < 4; ++e) { v[2 * e] = __uint_as_float(hw[e] << 16); v[2 * e + 1] = __uint_as_float(hw[e] & 0xffff0000u); o[2 * e] = __uint_as_float(ow[e] << 16); o[2 * e + 1] = __uint_as_float(ow[e] & 0xffff0000u); }
        float ss = 0.f;
#pragma unroll
        for (int e = 0; e < 8; ++e) ss += v[e] * v[e];
        ss = wave_sum(ss);
        const float r = 1.0f / sqrtf(ss * (1.0f / 512.0f) + P::EPS);
        float y[8];
#pragma unroll
        for (int e = 0; e < 8; ++e) { const float sg = __builtin_amdgcn_rcpf(1.0f + __builtin_amdgcn_exp2f(-1.4426950408889634f * o[e])); y[e] = sg * v[e] * r * (e < 4 ? g0[e] : g1[e - 4]); }
        u32x4 w; w.x = cvt_pk_bf16(y[0], y[1]); w.y = cvt_pk_bf16(y[2], y[3]); w.z = cvt_pk_bf16(y[4], y[5]); w.w = cvt_pk_bf16(y[6], y[7]); mo[64 * hh] = w; }
}

struct Args { const float* in[P::N_IN]; float* out; unsigned char* ws; };

__global__ void __launch_bounds__(512, 2) fwd(Args args) {
    using namespace P;
    extern __shared__ __attribute__((aligned(16))) unsigned char lds_raw[];
    LAS unsigned char* lds = (LAS unsigned char*)lds_raw;
    Ctx C;
    C.in = args.in;
    C.out = args.out; C.ws = args.ws;
    C.tid = threadIdx.x; C.lane = C.tid & 63; C.wave = __builtin_amdgcn_readfirstlane(C.tid >> 6);
    C.G = gridDim.x; C.gw = blockIdx.x * 8 + C.wave; C.ngw = C.G * 8;
    volatile LAS unsigned* MISC = (volatile LAS unsigned*)(lds + MISC_OFF);
    for (int u = C.tid; u < (LDS_BYTES - MISC_OFF) / 4; u += 512) ((LAS unsigned*)(lds + MISC_OFF))[u] = 0u;
    __syncthreads();
    unsigned* ctl = (unsigned*)(C.ws + WS_CTL);
    XcdBarrier bar = xcd_barrier_post(ctl + CW_BAR, MISC + 8);

#define Yb ((bf16_t*)(args.ws + P::WS_H))
#define SSQ(i) ((float*)(args.ws + P::WS_CTL + P::CTL_SSQ) + (i) * P::MP)
#define PROJ ((bf16_t*)(args.ws + P::WS_PROJ))
#define MIX ((bf16_t*)(args.ws + P::WS_MIX))
#define Gb ((bf16_t*)(args.ws + P::WS_G))
#define HS ((bf16_t*)(args.ws + P::WS_G))
#define GATES ((float*)(args.ws + P::WS_GATES))
#define SLAB ((float*)(args.ws + P::WS_SLAB))
    const int bid = (int)blockIdx.x;
#define TS(n)
#define PHASE_BEGIN() do { int t_ = threadIdx.x; asm volatile("" : "+v"(t_)); C.tid = t_; C.lane = t_ & 63; } while (0)

    PHASE_BEGIN();
    {
        { Bg<CvL0> bg; bg.next = C.gw; bg.cur = -1; bg_drain(C, bg); }
        LAS float* scr = (LAS float*)(lds + C.wave * 16384);
        if ((C.gw & 15) == 0 && (C.gw >> 4) < 128) { const int it = C.gw >> 4;
            if (it < 64) transpose_item(C.in[I_ABWIN], AB_LD, D, 64 * it, AB_N, 16, (bf16_t*)(C.ws + WS_WABF), 0, scr, C.lane, C.in[I_NMIX]);
            else transpose_item(C.in[I_CWIN], C_LD, D, 64 * (it - 64), C_N, 16, (bf16_t*)(C.ws + WS_WCIF), 0, scr, C.lane, C.in[I_NMIX] + D); }
        for (int m = C.gw; m < M; m += C.ngw) {
            const float* xr = m < NP ? C.in[I_XP] + (size_t)m * D : C.in[I_XS] + (size_t)(m - NP) * D;
            xrow_to_bf16(xr, Yb + (size_t)m * D, SSQ(0) + m, C.lane);
        }
    }
    xcd_barrier(bar);

    PHASE_BEGIN();
    {
        const bf16_t* Wf = (const bf16_t*)(C.ws + WS_WABF);
        for (int t = bid; t < M / 16; t += C.G) {
            const int row0 = 16 * t; const f32x4 part = gate_tile_part(Yb, Wf, row0, 512 * C.wave, C.lane);
            ((LAS f32x4*)lds)[C.wave * 64 + C.lane] = part;
            __syncthreads();
            if (C.wave == 0) { f32x4 acc = ((LAS f32x4*)lds)[C.lane];
#pragma unroll
                for (int w = 1; w < 8; ++w) acc = acc + ((LAS f32x4*)lds)[w * 64 + C.lane];
                const int n = C.lane & 15, g4 = 4 * (C.lane >> 4); const float bf = C.in[I_FBF][n];
#pragma unroll
                for (int r = 0; r < 4; ++r) { const int row = row0 + g4 + r; const float lf = log_sigmoid_f(acc[r] * rstd_of(SSQ(0)[row]) + bf);
                    if (row < NP) C.out[O_PLF + (size_t)row * HB + n] = lf; else C.out[O_SLF + (size_t)(row - NP) * HB + n] = lf; } }
            __syncthreads();
        }
        pg8::Gemm g{Yb, (const bf16_t*)(C.ws + WS_WABIN), MP, AB_N, D}; SplitOrder S; S.init(AB_N, D, 6, C.G, bid);
        EpiAbIn E{PROJ, C.out, SLAB, SSQ(0)};
        pg8::gemm_phase<EpiAbIn, SplitOrder, true, true>(lds, g, S, E);
    }
    xcd_barrier(bar);
    PHASE_BEGIN();
    combine_inproj<true>(C, SLAB, PROJ, SSQ(0));
    xcd_barrier(bar);

    PHASE_BEGIN();
    {
        for (int u = bid; u < 256; u += C.G) {
            const int bh = u >> 3, s = u & 7, b = bh >> 4, h = bh & 15;
            attn_prepare_ck<false>(C, lds, b, h);
            attn_qblock<false>(C, lds, PROJ, MIX, b, h, s);
            attn_qblock<false>(C, lds, PROJ, MIX, b, h, 15 - s);
            __syncthreads();
        }
        TS(21);
        PHASE_BEGIN();
        for (int u = bid; u < DEC_B * HB; u += C.G) {
            const int b = u >> 4, h = u & 15;
            attn_prepare_ck<true>(C, lds, b, h);
            attn_qblock<true>(C, lds, PROJ, MIX, b, h, 0);
            __syncthreads();
        }
        TS(22);
        PHASE_BEGIN();
        if (C.G == 256) {
            if (bid < 128) gmlp_unit(C, lds, PROJ, MIX, (bid >> 3) * 128, 128, bid & 7);
            else { for (int i = 0; i < 3; ++i) { const int u = 128 + 3 * (bid - 128) + i; gmlp_unit(C, lds, PROJ, MIX, (u >> 3) * 128, 128, u & 7); }
                if (bid >= 192) { const int u = bid - 192; gmlp_unit(C, lds, PROJ, MIX, NP + (u >> 3) * DEC_S, DEC_S, u & 7); } }
        } else {
            for (int u = bid; u < 512 + 64; u += C.G) {
                if (u < 512) gmlp_unit(C, lds, PROJ, MIX, (u >> 3) * 128, 128, u & 7);
                else gmlp_unit(C, lds, PROJ, MIX, NP + ((u - 512) >> 3) * DEC_S, DEC_S, (u - 512) & 7);
            }
        }
    }
    xcd_barrier(bar);

    PHASE_BEGIN();
    {
        pg8::Gemm g{MIX, (const bf16_t*)(C.ws + WS_WABOUT), MP, D, D}; SplitOrder S; S.init(D, D, 16, C.G, bid);
        EpiResid E{Yb, SLAB, SSQ(1)};
        pg8::gemm_phase<EpiResid, SplitOrder, true, true>(lds, g, S, E);
    }
    xcd_barrier(bar);
    PHASE_BEGIN();
    for (int r = bid; r < NS; r += C.G) sample_row_wg<false>(C, lds, SLAB, r, C.in[I_XS] + (size_t)r * D, Yb + (size_t)(NP + r) * D, SSQ(1) + NP + r, nullptr, nullptr);
    xcd_barrier(bar);
    PHASE_BEGIN();
    {
        pg8::Gemm g{Yb, (const bf16_t*)(C.ws + WS_WGU0), MP, 2 * DFF, D}; SplitOrder S; S.init(2 * DFF, D, 3, C.G, bid);
        EpiSwiGLU E{Gb, SLAB, SSQ(1)};
        pg8::gemm_phase<EpiSwiGLU, SplitOrder, true, true>(lds, g, S, E);
    }
    xcd_barrier(bar);
    PHASE_BEGIN();
    combine_swiglu(C, SLAB, Gb, SSQ(1));
    xcd_barrier(bar);
    PHASE_BEGIN();
    {
        pg8::Gemm g{Gb, (const bf16_t*)(C.ws + WS_WDN0), MP, D, DFF}; SplitOrder S; S.init(D, DFF, 16, C.G, bid);
        EpiResid E{Yb, SLAB, SSQ(2)};
        pg8::gemm_phase<EpiResid, SplitOrder, true, true>(lds, g, S, E);
    }
    xcd_barrier(bar);
    PHASE_BEGIN();
    for (int r = bid; r < NS; r += C.G) sample_row_wg<false>(C, lds, SLAB, r, nullptr, Yb + (size_t)(NP + r) * D, SSQ(2) + NP + r, nullptr, nullptr);
    xcd_barrier(bar);
    PHASE_BEGIN();
    {
        const bf16_t* Wif = (const bf16_t*)(C.ws + WS_WCIF);
        for (int t = bid; t < M / 16; t += C.G) {
            const int row0 = 16 * t; const f32x4 part = gate_tile_part(Yb, Wif, row0, 512 * C.wave, C.lane);
            ((LAS f32x4*)lds)[C.wave * 64 + C.lane] = part;
            __syncthreads();
            if (C.wave == 0) { f32x4 acc = ((LAS f32x4*)lds)[C.lane];
#pragma unroll
                for (int w = 1; w < 8; ++w) acc = acc + ((LAS f32x4*)lds)[w * 64 + C.lane];
                const int n = C.lane & 15, g4 = 4 * (C.lane >> 4); const float bb = n < 8 ? C.in[I_CBI][n] : C.in[I_CBF][n - 8];
#pragma unroll
                for (int r = 0; r < 4; ++r) { const float z = acc[r] * rstd_of(SSQ(2)[row0 + g4 + r]) + bb; GATES[(size_t)(row0 + g4 + r) * 16 + n] = n < 8 ? z : log_sigmoid_f(z); } }
            __syncthreads();
        }
        pg8::Gemm g{Yb, (const bf16_t*)(C.ws + WS_WCIN), MP, C_N, D}; SplitOrder S; S.init(C_N, D, 5, C.G, bid);
        EpiBf16Plain E{PROJ, C_N, SLAB, SSQ(2)};
        pg8::gemm_phase<EpiBf16Plain, SplitOrder, true, true>(lds, g, S, E);
    }
    xcd_barrier(bar);
    PHASE_BEGIN();
    combine_inproj<false>(C, SLAB, PROJ, SSQ(2));
    for (int u = bid; u < BATCH * HC * 64; u += C.G) mlstm_prepass(C, PROJ, GATES, (f32x4*)(C.ws + WS_GS), (bf16x8*)(C.ws + WS_PB), u >> 6, u & 63);
    xcd_barrier(bar);
    PHASE_BEGIN();
    {
        for (int u = bid; u < BATCH * HC * 16; u += C.G) mlstm_unit<false>(C, lds, PROJ, GATES, HS, u >> 7, (u >> 4) & 7, u & 15, (const f32x4*)(C.ws + WS_GS), (const bf16x8*)(C.ws + WS_PB));
        TS(23);
        PHASE_BEGIN();
        for (int u = bid; u < DEC_B * HC * 16; u += C.G) mlstm_unit<true>(C, lds, PROJ, GATES, HS, u >> 7, (u >> 4) & 7, u & 15, nullptr, nullptr);
    }
    xcd_barrier(bar);
    PHASE_BEGIN();
    for (int m = C.gw; m < M; m += C.ngw) mlstm_headnorm_row(HS + (size_t)m * D, PROJ + (size_t)m * C_N + 8192, C.in[I_CHN], MIX + (size_t)m * D, C.lane);
    xcd_barrier(bar);
    PHASE_BEGIN();
    {
        pg8::Gemm g{MIX, (const bf16_t*)(C.ws + WS_WCOUT), MP, D, D}; SplitOrder S; S.init(D, D, 16, C.G, bid);
        EpiResid E{Yb, SLAB, SSQ(3)};
        pg8::gemm_phase<EpiResid, SplitOrder, true, true>(lds, g, S, E);
    }
    xcd_barrier(bar);
    PHASE_BEGIN();
    for (int r = bid; r < NS; r += C.G) sample_row_wg<false>(C, lds, SLAB, r, nullptr, Yb + (size_t)(NP + r) * D, SSQ(3) + NP + r, nullptr, nullptr);
    xcd_barrier(bar);
    PHASE_BEGIN();
    {
        pg8::Gemm g{Yb, (const bf16_t*)(C.ws + WS_WGU1), MP, 2 * DFF, D}; SplitOrder S; S.init(2 * DFF, D, 3, C.G, bid);
        EpiSwiGLU E{Gb, SLAB, SSQ(3)};
        pg8::gemm_phase<EpiSwiGLU, SplitOrder, true, true>(lds, g, S, E);
    }
    xcd_barrier(bar);
    PHASE_BEGIN();
    combine_swiglu(C, SLAB, Gb, SSQ(3));
    xcd_barrier(bar);
    PHASE_BEGIN();
    {
        pg8::Gemm g{Gb, (const bf16_t*)(C.ws + WS_WDN1), MP, D, DFF}; SplitOrder S; S.init(D, DFF, 16, C.G, bid);
        EpiResid E{Yb, SLAB, SSQ(4)};
        pg8::gemm_phase<EpiResid, SplitOrder, true, true>(lds, g, S, E);
    }
    xcd_barrier(bar);
    PHASE_BEGIN();
    for (int m = C.gw; m < NP; m += C.ngw) final_row(Yb + (size_t)m * D, rstd_of(SSQ(4)[m]), C.in[I_NFIN], C.out + O_YP + (size_t)m * D, C.lane);
    for (int r = bid; r < NS; r += C.G) sample_row_wg<true>(C, lds, SLAB, r, nullptr, Yb + (size_t)(NP + r) * D, nullptr, C.in[I_NFIN], C.out + O_YS + (size_t)r * D);
}

#undef Yb
#undef SSQ
#undef PROJ
#undef MIX
#undef Gb
#undef HS
#undef GATES
#undef SLAB
extern "C" void kernel_launch(void* const* d_in, const int* in_sizes, int n_in, void* d_out, int out_size, void* d_ws, size_t ws_size, hipStream_t stream) {
    static int grid = 0;
    if (grid == 0) {
        if (n_in != P::N_IN || (size_t)out_size != P::O_END || ws_size < P::WS_END) { fprintf(stderr, "kernel_launch: unexpected shapes: n_in %d out %d ws %zu\n", n_in, out_size, ws_size); grid = -1; return; }
        int dev = 0, cus = 0, per_cu = 0;
        if (hipGetDevice(&dev) != hipSuccess || hipDeviceGetAttribute(&cus, hipDeviceAttributeMultiprocessorCount, dev) != hipSuccess) { grid = -1; return; }
        if (hipFuncSetAttribute((const void*)fwd, hipFuncAttributeMaxDynamicSharedMemorySize, P::LDS_BYTES) != hipSuccess) { fprintf(stderr, "kernel_launch: hipFuncSetAttribute failed\n"); grid = -1; return; }
        if (hipOccupancyMaxActiveBlocksPerMultiprocessor(&per_cu, (const void*)fwd, 512, P::LDS_BYTES) != hipSuccess || per_cu < 1) fprintf(stderr, "kernel_launch: occupancy query reports %d per CU\n", per_cu);
        (void)hipGetLastError();
        grid = cus;
    }
    if (grid < 0) return;
    if (hipMemsetAsync((char*)d_ws + P::WS_CTL, 0, P::CTL_ZERO_BYTES, stream) != hipSuccess) return;
    Args a{};
    for (int i = 0; i < P::N_IN; ++i) a.in[i] = (const float*)d_in[i];
    a.out = (float*)d_out; a.ws = (unsigned char*)d_ws;
    hipLaunchKernelGGL(fwd, dim3(grid), dim3(512), P::LDS_BYTES, stream, a);
}
```

```cpp
#include <hip/hip_runtime.h>
#include <cstdio>
#include <cstdint>
namespace pg8 {
#define PG8_LAS __attribute__((address_space(3)))
typedef unsigned short bf16_t;
typedef short bf16x8 __attribute__((ext_vector_type(8)));
typedef float f32x4 __attribute__((ext_vector_type(4)));
typedef unsigned u32x4 __attribute__((ext_vector_type(4)));
constexpr int BM = 256, BK = 64, HALF = 128, HTB = HALF * BK * 2  , STAGE_BYTES = 8 * HTB, NXCD = 8, WGM = 8;

__host__ __device__ __forceinline__ int lds_byte(int r, int c) { const int st = (r >> 4) * 2 + (c >> 5), rr = r & 15, cc = c & 31, ob = rr * 64 + cc * 2; return st * 1024 + (ob ^ (((ob >> 9) & 1) << 5)); }
__host__ __device__ __forceinline__ void stage_rc(int b, int& R, int& C) { const int st = b / 1024, sb = b % 1024, swz = sb ^ (((sb >> 9) & 1) << 5); R = (st >> 1) * 16 + swz / 64; C = (st & 1) * 32 + (swz % 64) / 2; }
__host__ __device__ __forceinline__ int perm32(int rho) { const int n = rho >> 4, i = rho & 15; return 8 * (i >> 2) + 4 * n + (i & 3); }

struct Unit { int pm, pn, kt0, nkt, slab; };
struct Gemm { const bf16_t* A; const bf16_t* Bt; int M, N, K; };

struct StaticOrder {
    int nM, nN, nwg, G, c, ktiles;
    __host__ __device__ void init(int M, int N, int K, int G_, int c_) { nM = M / BM; nN = N / BM; nwg = nM * nN; G = G_; c = c_; ktiles = K / BK; }
    __host__ __device__ bool next(int i, Unit& u) const {
        const long L = (long)i * G + c; if (L >= nwg) return false;
        int wgid = (int)L; { const int q = nwg / NXCD, r = nwg % NXCD, xcd = wgid % NXCD, off = wgid / NXCD; wgid = (xcd < r ? xcd * (q + 1) : r * (q + 1) + (xcd - r) * q) + off; }
        const int nig = WGM * nN, gid = wgid / nig, fm = gid * WGM, gsz = (nM - fm) < WGM ? (nM - fm) : WGM;
        u.pm = fm + ((wgid % nig) % gsz); u.pn = (wgid % nig) / gsz; u.kt0 = 0; u.nkt = ktiles; u.slab = -1; return true;
    }
    __device__ __forceinline__ void a_ready(const Unit&) const {}
    __device__ __forceinline__ void done(const Unit&) const {}
};

__device__ __forceinline__ unsigned cvt_pk_bf16(float lo, float hi) { unsigned r; asm volatile("v_cvt_pk_bf16_f32 %0, %1, %2" : "=v"(r) : "v"(lo), "v"(hi)); return r; }
typedef float f32x2 __attribute__((ext_vector_type(2)));
template <class Epi, class Sched, bool ALIGN_EPI = false, bool SP2 = false>
__device__ __forceinline__ void gemm_phase(PG8_LAS unsigned char* lds, const Gemm g, const Sched& S, const Epi& E) {
    int tid_ = threadIdx.x; asm volatile("" : "+v"(tid_));
    const int tid = tid_, wid = __builtin_amdgcn_readfirstlane(tid >> 6), lane = tid & 63, wr = wid >> 2, wc = wid & 3, fr = lane & 15, fq = lane >> 4;
    const int K = g.K;
    unsigned voffA[2], voffB[2];
#pragma unroll
    for (int i = 0; i < 2; ++i) { int R, C; stage_rc(tid * 16 + i * 8192, R, C); voffA[i] = (unsigned)(R * K + C) * 2u;
        const int Rl = (wid & 1) * 64 + lane, Rb = Epi::PERM ? ((Rl & ~31) + perm32(Rl & 31)) : Rl; voffB[i] = (unsigned)(((wid >> 1) + 4 * i) * 256 + Rb) * 16u; }
    const size_t kstep = (size_t)(BK * 2);
    const size_t hstep = (size_t)HALF * K * 2;
    const size_t tstep = 2 * hstep;
    const size_t kstepB = 32768, hstepB = 2048, tstepB = (size_t)K * 512;
    const unsigned ldsw = (unsigned)wid * 1024u;
    const int aoff = lds_byte(wr * 64 + fr, fq * 8), boff = fq * 2048 + wc * 512 + fr * 16;
#define PG8_SA(b, h) (((b) * 2 + (h)) * HTB)
#define PG8_SB(b, h) ((4 + (b) * 2 + (h)) * HTB)
#define PG8_STAGE(bufoff, gbase, voff) do { _Pragma("unroll") for (int _i = 0; _i < 2; ++_i) \
        __builtin_amdgcn_global_load_lds((const unsigned*)((const char*)(gbase) + (voff)[_i]), (PG8_LAS unsigned*)(lds + (bufoff) + ldsw + _i * 8192), 16, 0, 0); } while (0)
#define PG8_LDA(dst, b, h) do { _Pragma("unroll") for (int m = 0; m < 4; ++m) _Pragma("unroll") for (int k = 0; k < 2; ++k) dst[m][k] = *(const PG8_LAS bf16x8*)(lds + PG8_SA(b, h) + aoff + m * 2048 + k * 1024); } while (0)
#define PG8_LDB(dst, b, h) do { _Pragma("unroll") for (int n = 0; n < 2; ++n) _Pragma("unroll") for (int k = 0; k < 2; ++k) dst[n][k] = *(const PG8_LAS bf16x8*)(lds + PG8_SB(b, h) + boff + n * 256 + k * 8192); } while (0)
#define PG8_MMA(ai, bj, At, Bt) do { __builtin_amdgcn_s_setprio(1); _Pragma("unroll") for (int m = 0; m < 4; ++m) _Pragma("unroll") for (int n = 0; n < 2; ++n) _Pragma("unroll") for (int k = 0; k < 2; ++k) \
        acc[ai][bj][m][n] = __builtin_amdgcn_mfma_f32_16x16x32_bf16(Bt[n][k], At[m][k], acc[ai][bj][m][n], 0, 0, 0); __builtin_amdgcn_s_setprio(0); } while (0)
#define PG8_WAIT_V(n) asm volatile("s_waitcnt vmcnt(" #n ")" ::: "memory")
#define PG8_WAIT_L(n) asm volatile("s_waitcnt lgkmcnt(" #n ")" ::: "memory")
#define PG8_BAR __builtin_amdgcn_s_barrier()
#define PG8_SCHED __builtin_amdgcn_sched_barrier(0)
    Unit cur, nxt; int ui = 0;
    if (!S.next(0, cur)) return;
    f32x4 acc[2][2][4][2];
#pragma unroll
    for (int a = 0; a < 2; ++a)
#pragma unroll
        for (int b = 0; b < 2; ++b)
#pragma unroll
            for (int m = 0; m < 4; ++m)
#pragma unroll
                for (int n = 0; n < 2; ++n) acc[a][b][m][n] = (f32x4){0.f, 0.f, 0.f, 0.f};
    bf16x8 At[4][2], B0[2][2], B1[2][2];
    float rs8[8];
    const char* cA = (const char*)g.A + (size_t)cur.pm * tstep + (size_t)cur.kt0 * kstep; const char* cB = (const char*)g.Bt + (size_t)cur.pn * tstepB + (size_t)cur.kt0 * kstepB; int nt = cur.nkt;
    S.a_ready(cur); E.load_rs(cur, wr, fr, rs8);
    if constexpr (SP2) {
        PG8_STAGE(PG8_SB(0, 0), cB, voffB); PG8_STAGE(PG8_SB(0, 1), cB + hstepB, voffB); PG8_STAGE(PG8_SA(0, 0), cA, voffA); PG8_STAGE(PG8_SA(0, 1), cA + hstep, voffA);
        if (wr == 1) PG8_BAR;
        PG8_WAIT_V(2); PG8_BAR;
        PG8_STAGE(PG8_SB(1, 0), cB + kstepB, voffB); PG8_STAGE(PG8_SA(1, 0), cA + kstep, voffA); PG8_STAGE(PG8_SB(1, 1), cB + hstepB + kstepB, voffB);
        PG8_WAIT_V(6); PG8_BAR;
    } else {
        PG8_STAGE(PG8_SB(0, 0), cB, voffB); PG8_STAGE(PG8_SA(0, 0), cA, voffA); PG8_STAGE(PG8_SB(0, 1), cB + hstepB, voffB); PG8_STAGE(PG8_SA(0, 1), cA + hstep, voffA);
        if (wr == 1) PG8_BAR;
        PG8_WAIT_V(4); PG8_BAR;
        PG8_STAGE(PG8_SB(1, 0), cB + kstepB, voffB); PG8_STAGE(PG8_SA(1, 0), cA + kstep, voffA); PG8_STAGE(PG8_SB(1, 1), cB + hstepB + kstepB, voffB);
        PG8_WAIT_V(6); PG8_BAR;
    }
    for (;;) {
        const bool has_next = S.next(ui + 1, nxt);
        const char* nA = has_next ? (const char*)g.A + (size_t)nxt.pm * tstep + (size_t)nxt.kt0 * kstep : cA; const char* nB = has_next ? (const char*)g.Bt + (size_t)nxt.pn * tstepB + (size_t)nxt.kt0 * kstepB : cB;
        if constexpr (SP2) {
        if (cur.slab >= 0) {
        for (int t = 0; t < nt; t += 2) {
            const bool last = (t == nt - 2);
            const char* a1 = cA + (size_t)(t + 1) * kstep;
            const char* a2 = last ? nA : cA + (size_t)(t + 2) * kstep; const char* b2 = last ? nB : cB + (size_t)(t + 2) * kstepB;
            const char* a3 = a2 + kstep; const char* b3 = b2 + kstepB;
            if (last && has_next) S.a_ready(nxt);
            PG8_LDB(B0, 0, 0); PG8_LDB(B1, 0, 1); PG8_SCHED; PG8_LDA(At, 0, 0); PG8_STAGE(PG8_SA(1, 1), a1 + hstep, voffA);
            PG8_WAIT_V(8); PG8_WAIT_L(0); PG8_BAR; PG8_MMA(0, 0, At, B0); PG8_MMA(0, 1, At, B1); PG8_BAR; PG8_SCHED;
            PG8_STAGE(PG8_SB(0, 0), b2, voffB); PG8_STAGE(PG8_SB(0, 1), b2 + hstepB, voffB); PG8_STAGE(PG8_SA(0, 0), a2, voffA);
            PG8_WAIT_V(8); PG8_WAIT_L(0); PG8_BAR; PG8_BAR; PG8_SCHED;
            PG8_LDB(B0, 1, 0); PG8_LDB(B1, 1, 1); PG8_SCHED; PG8_LDA(At, 1, 0); PG8_STAGE(PG8_SA(0, 1), a2 + hstep, voffA);
            PG8_WAIT_V(8); PG8_WAIT_L(0); PG8_BAR; PG8_MMA(0, 0, At, B0); PG8_MMA(0, 1, At, B1); PG8_BAR; PG8_SCHED;
            PG8_STAGE(PG8_SB(1, 0), b3, voffB); PG8_STAGE(PG8_SB(1, 1), b3 + hstepB, voffB); PG8_STAGE(PG8_SA(1, 0), a3, voffA);
            PG8_WAIT_V(8); PG8_WAIT_L(0); PG8_BAR; PG8_BAR; PG8_SCHED;
        }
        } else {
        for (int t = 0; t < nt; t += 2) {
            const bool last = (t == nt - 2);
            const char* a1 = cA + (size_t)(t + 1) * kstep;
            const char* a2 = last ? nA : cA + (size_t)(t + 2) * kstep; const char* b2 = last ? nB : cB + (size_t)(t + 2) * kstepB;
            const char* a3 = a2 + kstep; const char* b3 = b2 + kstepB;
            if (last && has_next) S.a_ready(nxt);
            PG8_LDB(B0, 0, 0); PG8_LDB(B1, 0, 1); PG8_SCHED; PG8_LDA(At, 0, 0); PG8_STAGE(PG8_SA(1, 1), a1 + hstep, voffA);
            PG8_WAIT_V(8); PG8_WAIT_L(0); PG8_BAR; PG8_MMA(0, 0, At, B0); PG8_MMA(0, 1, At, B1); PG8_BAR; PG8_SCHED;
            PG8_LDA(At, 0, 1); PG8_STAGE(PG8_SB(0, 0), b2, voffB); PG8_STAGE(PG8_SB(0, 1), b2 + hstepB, voffB); PG8_STAGE(PG8_SA(0, 0), a2, voffA);
            PG8_WAIT_V(8); PG8_WAIT_L(0); PG8_BAR; PG8_MMA(1, 0, At, B0); PG8_MMA(1, 1, At, B1); PG8_BAR; PG8_SCHED;
            PG8_LDB(B0, 1, 0); PG8_LDB(B1, 1, 1); PG8_SCHED; PG8_LDA(At, 1, 0); PG8_STAGE(PG8_SA(0, 1), a2 + hstep, voffA);
            PG8_WAIT_V(8); PG8_WAIT_L(0); PG8_BAR; PG8_MMA(0, 0, At, B0); PG8_MMA(0, 1, At, B1); PG8_BAR; PG8_SCHED;
            PG8_LDA(At, 1, 1); PG8_STAGE(PG8_SB(1, 0), b3, voffB); PG8_STAGE(PG8_SB(1, 1), b3 + hstepB, voffB); PG8_STAGE(PG8_SA(1, 0), a3, voffA);
            PG8_WAIT_V(8); PG8_WAIT_L(0); PG8_BAR; PG8_MMA(1, 0, At, B0); PG8_MMA(1, 1, At, B1); PG8_BAR; PG8_SCHED;
        }
        }
        } else {
        for (int t = 0; t < nt; t += 2) {
            const bool last = (t == nt - 2);
            const char* a1 = cA + (size_t)(t + 1) * kstep;
            const char* a2 = last ? nA : cA + (size_t)(t + 2) * kstep; const char* b2 = last ? nB : cB + (size_t)(t + 2) * kstepB;
            const char* a3 = a2 + kstep; const char* b3 = b2 + kstepB;
            if (last && has_next) S.a_ready(nxt);
            PG8_LDB(B0, 0, 0); PG8_SCHED; PG8_LDA(At, 0, 0); PG8_STAGE(PG8_SA(1, 1), a1 + hstep, voffA);
            PG8_WAIT_L(8); PG8_BAR; PG8_WAIT_L(0); PG8_MMA(0, 0, At, B0); PG8_BAR; PG8_SCHED;
            PG8_LDB(B1, 0, 1); PG8_STAGE(PG8_SB(0, 0), b2, voffB);
            PG8_BAR; PG8_WAIT_L(0); PG8_MMA(0, 1, At, B1); PG8_BAR;
            PG8_LDA(At, 0, 1); PG8_STAGE(PG8_SA(0, 0), a2, voffA);
            PG8_BAR; PG8_WAIT_L(0); PG8_MMA(1, 0, At, B0); PG8_BAR; PG8_SCHED;
            PG8_STAGE(PG8_SB(0, 1), b2 + hstepB, voffB);
            PG8_WAIT_V(6); PG8_BAR; PG8_MMA(1, 1, At, B1); PG8_BAR;
            PG8_LDB(B0, 1, 0); PG8_SCHED; PG8_LDA(At, 1, 0); PG8_STAGE(PG8_SA(0, 1), a2 + hstep, voffA);
            PG8_WAIT_L(8); PG8_BAR; PG8_WAIT_L(0); PG8_MMA(0, 0, At, B0); PG8_BAR; PG8_SCHED;
            PG8_LDB(B1, 1, 1); PG8_STAGE(PG8_SB(1, 0), b3, voffB);
            PG8_BAR; PG8_WAIT_L(0); PG8_MMA(0, 1, At, B1); PG8_BAR;
            PG8_LDA(At, 1, 1); PG8_STAGE(PG8_SA(1, 0), a3, voffA);
            PG8_BAR; PG8_WAIT_L(0); PG8_MMA(1, 0, At, B0); PG8_BAR; PG8_SCHED;
            PG8_STAGE(PG8_SB(1, 1), b3 + hstepB, voffB);
            PG8_WAIT_V(6); PG8_BAR; PG8_MMA(1, 1, At, B1); PG8_BAR;
        }
        }
        if constexpr (ALIGN_EPI) { if (wr == 0) PG8_BAR; }
        if constexpr (!Epi::AFTER_DRAIN) { E(acc, cur, wr, wc, fr, fq, rs8); S.done(cur); }
        if (!has_next) break;
#pragma unroll
        for (int a = 0; a < 2; ++a)
#pragma unroll
            for (int b = 0; b < 2; ++b)
#pragma unroll
                for (int m = 0; m < 4; ++m)
#pragma unroll
                    for (int n = 0; n < 2; ++n) acc[a][b][m][n] = (f32x4){0.f, 0.f, 0.f, 0.f};
        cur = nxt; cA = nA; cB = nB; nt = cur.nkt; ++ui; E.load_rs(cur, wr, fr, rs8);
        if constexpr (ALIGN_EPI) { if (wr == 1) PG8_BAR; }
    }
    PG8_WAIT_V(0);
    if constexpr (!ALIGN_EPI) { if (wr == 0) PG8_BAR; }
    PG8_BAR;
    if constexpr (Epi::AFTER_DRAIN) { E.fused(acc, cur, wr, wc, fr, fq, lds, wid, lane); S.done(cur); }
#undef PG8_SA
#undef PG8_SB
#undef PG8_STAGE
#undef PG8_LDA
#undef PG8_LDB
#undef PG8_MMA
#undef PG8_WAIT_V
#undef PG8_WAIT_L
#undef PG8_BAR
#undef PG8_SCHED
}
}
#define LAS __attribute__((address_space(3)))
#define XB_TMO      128
#define XB_XCNT(j)  (256  + 64 * (j))
#define XB_XSUB(j)  (1280 + 64 * (j))
#define XB_XGEN(j)  (2304 + 64 * (j))
#define XB_TOP      3328
#define XB_TOPGEN   3392
#define XCD_BAR_WORDS 3456
#define XB_SPIN_CAP (1u << 21)

__device__ __forceinline__ unsigned xb_ld(unsigned* p)              { return __hip_atomic_load(p, __ATOMIC_RELAXED, __HIP_MEMORY_SCOPE_AGENT); }
__device__ __forceinline__ unsigned xb_add(unsigned* p, unsigned v) { return __hip_atomic_fetch_add(p, v, __ATOMIC_RELAXED, __HIP_MEMORY_SCOPE_AGENT); }
__device__ __forceinline__ unsigned xb_xcc_id() { return (unsigned)__builtin_amdgcn_s_getreg((3 << 11) | 20) & 0xFu; }
#define XB_SPIN(cond, bar) do { unsigned _sp = 0; while (cond) { __builtin_amdgcn_s_sleep(1); \
    if ((++_sp & 255u) == 0u) { if (xb_ld(&(bar)[XB_TMO])) break; if (_sp > XB_SPIN_CAP) { atomicAdd(&(bar)[XB_TMO], 1u); break; } } } } while (0)

struct XcdBarrier {
    unsigned* bar; unsigned x;
    volatile LAS unsigned* st;
};

__device__ __forceinline__ XcdBarrier xcd_barrier_post(unsigned* bar, volatile LAS unsigned* st) {
    XcdBarrier b; b.bar = bar; b.x = xb_xcc_id(); b.st = st;
    if (threadIdx.x == 0) (void)xb_add(&bar[XB_XCNT(b.x)], 1u);
    return b;
}
__device__ __forceinline__ void xcd_barrier_complete(unsigned* bar, unsigned x, unsigned& nloc, unsigned& nx) {
    const unsigned G = gridDim.x * gridDim.y * gridDim.z;
    unsigned sum, cnt, mine, sp = 0u;
    for (;;) {
        sum = 0u; cnt = 0u; mine = 0u;
#pragma unroll
        for (unsigned j = 0; j < 16; ++j) { const unsigned c = xb_ld(&bar[XB_XCNT(j)]); sum += c; cnt += (c > 0u) ? 1u : 0u; mine = (j == x) ? c : mine; }
        if (sum == G) break;
        __builtin_amdgcn_s_sleep(1);
        if ((++sp & 255u) == 0u) { if (xb_ld(&bar[XB_TMO])) break; if (sp > XB_SPIN_CAP) { atomicAdd(&bar[XB_TMO], 1u); break; } }
    }
    nloc = mine > 0u ? mine : 1u; nx = cnt > 0u ? cnt : 1u;
}

__device__ __forceinline__ void xcd_barrier(const XcdBarrier& b) {
    asm volatile("s_waitcnt vmcnt(0)" ::: "memory");
    __syncthreads();
    if (threadIdx.x == 0) {
        unsigned* bar = b.bar;
        __builtin_amdgcn_s_waitcnt(0);
        unsigned nloc = b.st[0], nx = b.st[1];
        if (nloc == 0u) { xcd_barrier_complete(bar, b.x, nloc, nx); b.st[0] = nloc; b.st[1] = nx; }
        const unsigned old = xb_add(&bar[XB_XSUB(b.x)], 1u);
        const unsigned gen = old / nloc;
        if (old + 1u == (gen + 1u) * nloc) {
            __builtin_amdgcn_fence(__ATOMIC_RELEASE, "agent");
            asm volatile("s_waitcnt vmcnt(0)" ::: "memory");
            const unsigned og = xb_add(&bar[XB_TOP], 1u);
            const unsigned tg = og / nx;
            if (og + 1u == (tg + 1u) * nx) xb_add(&bar[XB_TOPGEN], 1u);
            else XB_SPIN(xb_ld(&bar[XB_TOPGEN]) == tg, bar);
            __builtin_amdgcn_fence(__ATOMIC_ACQUIRE, "agent");
            xb_add(&bar[XB_XGEN(b.x)], 1u);
            asm volatile("s_waitcnt vmcnt(0)" ::: "memory");
        } else {
            XB_SPIN(xb_ld(&bar[XB_XGEN(b.x)]) == gen, bar);
            __builtin_amdgcn_fence(__ATOMIC_ACQUIRE, "agent");
            asm volatile("s_waitcnt vmcnt(0)" ::: "memory");
        }
    }
    __syncthreads();
}

namespace P {
constexpr int D = 4096, SEQ = 4096, BATCH = 2, DEC_B = 8, DEC_S = 16, PAST = 1024;
constexpr int NP = BATCH * SEQ;
constexpr int NS = DEC_B * DEC_S;
constexpr int M = NP + NS;
constexpr int MP = 8448;
constexpr int DA = 2048, DB = 2048, HB = 16, DHB = 128;
constexpr int AB_LD = 10256, AB_N = 10240;
constexpr int HC = 8, DKC = 256, DVC = 512;
constexpr int C_LD = 12304, C_N = 12288;
constexpr int DFF = 11008;
constexpr float EPS = 1e-6f;
constexpr size_t O_YP = 0;
constexpr size_t O_YS = O_YP + (size_t)NP * D;
constexpr size_t O_PK = O_YS + (size_t)NS * D;
constexpr size_t O_PV = O_PK + (size_t)NP * DB;
constexpr size_t O_PLF = O_PV + (size_t)NP * DB;
constexpr size_t O_PC = O_PLF + (size_t)NP * HB;
constexpr size_t O_PN = O_PC + (size_t)BATCH * HC * DKC * DVC;
constexpr size_t O_PM = O_PN + (size_t)BATCH * HC * DKC;
constexpr size_t O_SK = O_PM + (size_t)BATCH * HC;
constexpr size_t O_SV = O_SK + (size_t)NS * DB;
constexpr size_t O_SLF = O_SV + (size_t)NS * DB;
constexpr size_t O_SGV = O_SLF + (size_t)NS * HB;
constexpr size_t O_SC = O_SGV + (size_t)NS * DA;
constexpr size_t O_SN = O_SC + (size_t)DEC_B * HC * DKC * DVC;
constexpr size_t O_SM = O_SN + (size_t)DEC_B * HC * DKC;
constexpr size_t O_END = O_SM + (size_t)DEC_B * HC;
enum { I_XP = 0, I_XS, I_CK, I_CV, I_CLF, I_SC, I_SN, I_SM, I_NMIX, I_NFFN, I_NFIN, I_ABWIN, I_ABWOUT, I_GWS, I_GB, I_FBF, I_CWIN, I_CBI, I_CBF, I_CHN, I_CWOUT, I_FG, I_FU, I_FD, N_IN };
constexpr size_t MiB = 1u << 20;
constexpr size_t WS_CTL = 0, CTL_ZERO_BYTES = 1 * MiB;
constexpr size_t WS_WABIN = 1 * MiB;
constexpr size_t WS_WABF = 81 * MiB;
constexpr size_t WS_WABOUT = 82 * MiB;
constexpr size_t WS_WCIN = 114 * MiB;
constexpr size_t WS_WCIF = 210 * MiB;
constexpr size_t WS_WCOUT = 211 * MiB;
constexpr size_t WS_WGU0 = 243 * MiB;
constexpr size_t WS_WGU1 = 415 * MiB;
constexpr size_t WS_WDN0 = 587 * MiB;
constexpr size_t WS_WDN1 = 673 * MiB;
constexpr size_t WS_H = 759 * MiB;
constexpr size_t WS_Y = 825 * MiB;
constexpr size_t WS_PROJ = 957 * MiB;
constexpr size_t WS_MIX = 1155 * MiB;
constexpr size_t WS_G = 1221 * MiB;
constexpr size_t WS_GATES = 1400 * MiB;
constexpr size_t WS_SLAB = 1401 * MiB;
constexpr size_t WS_GS = 1435 * MiB;
constexpr size_t WS_PB = 1436 * MiB;
constexpr size_t WS_END = 1444 * MiB;
static_assert(WS_WABIN + (size_t)AB_N * D * 2 <= WS_WABF && WS_WCIN + (size_t)C_N * D * 2 <= WS_WCIF && WS_WGU0 + (size_t)2 * DFF * D * 2 <= WS_WGU1 && WS_WGU1 + (size_t)2 * DFF * D * 2 <= WS_WDN0, "ws map 1");
static_assert(WS_WDN0 + (size_t)DFF * D * 2 <= WS_WDN1 && WS_WDN1 + (size_t)DFF * D * 2 <= WS_H && WS_H + (size_t)MP * D * 2 <= WS_Y && WS_Y + (size_t)MP * D * 4 <= WS_PROJ, "ws map 2");
static_assert(WS_PROJ + (size_t)MP * C_N * 2 <= WS_MIX && WS_MIX + (size_t)MP * D * 2 <= WS_G && WS_G + (size_t)MP * DFF * 2 <= WS_END, "ws map 3");
constexpr int CW_BAR = 4096;
constexpr size_t CTL_SSQ = 524288;
constexpr int RING_BYTES = 131072, MISC_OFF = RING_BYTES, LDS_BYTES = 147456;
}

typedef unsigned short bf16_t;
typedef float f32x4 __attribute__((ext_vector_type(4)));
typedef short bf16x8 __attribute__((ext_vector_type(8)));
typedef unsigned u32x4 __attribute__((ext_vector_type(4)));
typedef unsigned u32x2 __attribute__((ext_vector_type(2)));
#define LDS_WAIT() asm volatile("s_waitcnt lgkmcnt(0)" ::: "memory")
#define VM_WAIT() asm volatile("s_waitcnt vmcnt(0)" ::: "memory")
using pg8::cvt_pk_bf16;

__device__ __forceinline__ float wave_sum(float v) {
#pragma unroll
    for (int o = 1; o < 64; o <<= 1) v += __shfl_xor(v, o);
    return v;
}
__device__ __forceinline__ float log_sigmoid_f(float z) { return fminf(z, 0.f) - log1pf(__expf(-fabsf(z))); }

__device__ __forceinline__ void transpose_item(const float* __restrict__ W, int ld, int K, int k0, int n0, int nvalid, bf16_t* __restrict__ WT, int drow0, LAS float* scr, int lane, const float* __restrict__ gain = nullptr) {
    const int nn = lane & 31, ncl = nn < nvalid ? nn : nvalid - 1;
    float wv[32];
#pragma unroll
    for (int i = 0; i < 32; ++i) wv[i] = W[(size_t)(k0 + 2 * i + (lane >> 5)) * ld + n0 + ncl];
#pragma unroll
    for (int i = 0; i < 32; ++i) scr[(2 * i + (lane >> 5)) * 33 + nn] = wv[i];
    LDS_WAIT();
    const int c = lane & 7;
    f32x4 g0 = {1.f, 1.f, 1.f, 1.f}, g1 = {1.f, 1.f, 1.f, 1.f};
    if (gain) { g0 = *(const f32x4*)(gain + k0 + 8 * c); g1 = *(const f32x4*)(gain + k0 + 8 * c + 4); }
#pragma unroll
    for (int j = 0; j < 4; ++j) { const int n = (lane >> 3) + 8 * j; const LAS float* s = scr + (8 * c) * 33 + n;
        u32x4 o; o.x = cvt_pk_bf16(s[0 * 33] * g0[0], s[1 * 33] * g0[1]); o.y = cvt_pk_bf16(s[2 * 33] * g0[2], s[3 * 33] * g0[3]); o.z = cvt_pk_bf16(s[4 * 33] * g1[0], s[5 * 33] * g1[1]); o.w = cvt_pk_bf16(s[6 * 33] * g1[2], s[7 * 33] * g1[3]);
        if (n < nvalid) *(u32x4*)(WT + (size_t)(drow0 + n) * K + k0 + 8 * c) = o; }
    LDS_WAIT();
}

struct Ctx {
    const float* const* in; float* out; unsigned char* ws;
    int tid, lane, wave, gw, ngw, G;
};


struct SplitOrder {
    pg8::StaticOrder Pm; int nfull, nmini, S, G, c, b, e;
    __device__ void init(int N, int K, int S_, int G_, int c_) { Pm.init(P::NP, N, K, G_, c_); nfull = Pm.nwg; S = S_; nmini = (N / 256) * S_; G = G_; c = c_;
        const int kt = K / 64; b = (kt / S_) & ~1; e = (kt - S_ * b) / 2; }
    __device__ bool next(int i, pg8::Unit& u) const {
        const int L = i * G + c;
        if (L < nfull) return Pm.next(i, u);
        const int j = L - nfull; if (j >= nmini) return false;
        const int pn = j / S, s = j - pn * S;
        u.pm = P::NP / 256; u.pn = pn; u.kt0 = s * b + 2 * (s < e ? s : e); u.nkt = b + (s < e ? 2 : 0); u.slab = j; return true;
    }
    __device__ __forceinline__ void a_ready(const pg8::Unit&) const {}
    __device__ __forceinline__ void done(const pg8::Unit&) const {}
};

template <int CW> struct CvVec;
template <> struct CvVec<4> { typedef f32x4 T; };
template <> struct CvVec<2> { typedef float T __attribute__((ext_vector_type(2))); };
template <> struct CvVec<1> { typedef float T; };
__device__ __forceinline__ float cv_el(const f32x4& v, int e) { return v[e]; }
__device__ __forceinline__ float cv_el(const CvVec<2>::T& v, int e) { return v[e]; }
__device__ __forceinline__ float cv_el(const float& v, int) { return v; }
template <int CW, int NBLK, int LD>
__device__ __forceinline__ void cv_load(const float* __restrict__ src, int r, int lane, typename CvVec<CW>::T (&v)[8]) {
    const int o = r / NBLK, nb = r - o * NBLK;
    const float* p = src + (size_t)(8 * o) * LD + 64 * CW * nb + CW * lane;
#pragma unroll
    for (int j = 0; j < 8; ++j) v[j] = *(const typename CvVec<CW>::T*)(p + (size_t)j * LD);
}
template <int CW, int NBLK, int KOCT, int MODE>
__device__ __forceinline__ void cv_store(bf16_t* __restrict__ dst, const float* __restrict__ gain, int r, int lane, const typename CvVec<CW>::T (&v)[8]) {
    const int o = r / NBLK, nb = r - o * NBLK;
    float g[8];
#pragma unroll
    for (int j = 0; j < 8; ++j) g[j] = gain ? gain[8 * o + j] : 1.0f;
    const int n = 64 * CW * nb + CW * lane, np = MODE == 0 ? n : 256 * (n >> 7) + (n & 127) + (MODE == 2 ? 128 : 0);
    u32x4* q = (u32x4*)(dst + (((size_t)(np >> 8) * KOCT + o) * 256 + (np & 255)) * 8);
#pragma unroll
    for (int e = 0; e < CW; ++e) { u32x4 w; w.x = cvt_pk_bf16(cv_el(v[0], e) * g[0], cv_el(v[1], e) * g[1]); w.y = cvt_pk_bf16(cv_el(v[2], e) * g[2], cv_el(v[3], e) * g[3]); w.z = cvt_pk_bf16(cv_el(v[4], e) * g[4], cv_el(v[5], e) * g[5]); w.w = cvt_pk_bf16(cv_el(v[6], e) * g[6], cv_el(v[7], e) * g[7]); q[e] = w; }
}
template <int CW, int JOB> struct CvJob {
    static constexpr int CB = 64 * CW;
    static constexpr int COUNT = JOB == 0 ? (P::D / 8) * (P::AB_N / CB) : JOB == 1 ? (P::D / 8) * (P::C_N / CB) : (JOB == 2 || JOB == 6) ? (P::D / 8) * (P::D / CB) : (JOB == 5 || JOB == 9) ? (P::DFF / 8) * (P::D / CB) : (P::D / 8) * (P::DFF / CB);
    static __device__ __forceinline__ void load(const Ctx& C, int r, typename CvVec<CW>::T (&v)[8]) {
        using namespace P;
        if (JOB == 0) cv_load<CW, AB_N / CB, AB_LD>(C.in[I_ABWIN], r, C.lane, v);
        else if (JOB == 1) cv_load<CW, C_N / CB, C_LD>(C.in[I_CWIN], r, C.lane, v);
        else if (JOB == 2) cv_load<CW, D / CB, D>(C.in[I_ABWOUT], r, C.lane, v);
        else if (JOB == 6) cv_load<CW, D / CB, D>(C.in[I_CWOUT], r, C.lane, v);
        else if (JOB == 3 || JOB == 7) cv_load<CW, DFF / CB, DFF>(C.in[I_FG] + (size_t)(JOB == 7) * D * DFF, r, C.lane, v);
        else if (JOB == 4 || JOB == 8) cv_load<CW, DFF / CB, DFF>(C.in[I_FU] + (size_t)(JOB == 8) * D * DFF, r, C.lane, v);
        else cv_load<CW, D / CB, D>(C.in[I_FD] + (size_t)(JOB == 9) * DFF * D, r, C.lane, v);
    }
    static __device__ __forceinline__ void store(const Ctx& C, int r, const typename CvVec<CW>::T (&v)[8]) {
        using namespace P; unsigned char* ws = C.ws;
        if (JOB == 0) cv_store<CW, AB_N / CB, D / 8, 0>((bf16_t*)(ws + WS_WABIN), C.in[I_NMIX], r, C.lane, v);
        else if (JOB == 1) cv_store<CW, C_N / CB, D / 8, 0>((bf16_t*)(ws + WS_WCIN), C.in[I_NMIX] + D, r, C.lane, v);
        else if (JOB == 2) cv_store<CW, D / CB, D / 8, 0>((bf16_t*)(ws + WS_WABOUT), nullptr, r, C.lane, v);
        else if (JOB == 6) cv_store<CW, D / CB, D / 8, 0>((bf16_t*)(ws + WS_WCOUT), nullptr, r, C.lane, v);
        else if (JOB == 3 || JOB == 7) cv_store<CW, DFF / CB, D / 8, 1>((bf16_t*)(ws + (JOB == 7 ? WS_WGU1 : WS_WGU0)), C.in[I_NFFN] + (size_t)(JOB == 7) * D, r, C.lane, v);
        else if (JOB == 4 || JOB == 8) cv_store<CW, DFF / CB, D / 8, 2>((bf16_t*)(ws + (JOB == 8 ? WS_WGU1 : WS_WGU0)), C.in[I_NFFN] + (size_t)(JOB == 8) * D, r, C.lane, v);
        else cv_store<CW, D / CB, DFF / 8, 0>((bf16_t*)(ws + (JOB == 9 ? WS_WDN1 : WS_WDN0)), nullptr, r, C.lane, v);
    }
};
template <int CW_, int... JOBS> struct CvList;
template <int CW_> struct CvList<CW_> { static constexpr int CW = CW_, COUNT = 0;
    static __device__ __forceinline__ void load(const Ctx&, int, typename CvVec<CW_>::T (&)[8]) {}
    static __device__ __forceinline__ void store(const Ctx&, int, const typename CvVec<CW_>::T (&)[8]) {} };
template <int CW_, int J, int... REST> struct CvList<CW_, J, REST...> { static constexpr int CW = CW_, COUNT = CvJob<CW_, J>::COUNT + CvList<CW_, REST...>::COUNT;
    static __device__ __forceinline__ void load(const Ctx& C, int r, typename CvVec<CW_>::T (&v)[8]) { if (r < CvJob<CW_, J>::COUNT) CvJob<CW_, J>::load(C, r, v); else CvList<CW_, REST...>::load(C, r - CvJob<CW_, J>::COUNT, v); }
    static __device__ __forceinline__ void store(const Ctx& C, int r, const typename CvVec<CW_>::T (&v)[8]) { if (r < CvJob<CW_, J>::COUNT) CvJob<CW_, J>::store(C, r, v); else CvList<CW_, REST...>::store(C, r - CvJob<CW_, J>::COUNT, v); } };
template <class L> struct Bg { int next, cur; typename CvVec<L::CW>::T v[8]; };
template <class L> __device__ __forceinline__ void bg_issue(const Ctx& C, Bg<L>& b) { if (b.cur < 0 && b.next < L::COUNT) { L::load(C, b.next, b.v); b.cur = b.next; b.next += C.ngw; } }
template <class L> __device__ __forceinline__ void bg_commit(const Ctx& C, Bg<L>& b) { if (b.cur >= 0) { L::store(C, b.cur, b.v); b.cur = -1; } }
template <class L> __device__ __forceinline__ void bg_drain(const Ctx& C, Bg<L>& b) { bg_commit(C, b); while (b.next < L::COUNT) { bg_issue(C, b); bg_commit(C, b); } }
typedef CvList<4, 0, 1, 2, 3, 4, 5, 6, 7, 8, 9> CvL0;

__device__ __forceinline__ float rstd_of(float ssq) { return __builtin_amdgcn_rsqf(ssq * (1.0f / P::D) + P::EPS); }
__device__ __forceinline__ void xrow_to_bf16(const float* __restrict__ xrow, bf16_t* __restrict__ yrow, float* __restrict__ ssq, int lane) {
    const f32x4* xr = (const f32x4*)xrow + lane; u32x2* o = (u32x2*)yrow + lane; float s = 0.f;
#pragma unroll
    for (int j = 0; j < 16; ++j) { const f32x4 v = xr[64 * j]; s += (v.x * v.x + v.y * v.y) + (v.z * v.z + v.w * v.w); u32x2 w; w.x = cvt_pk_bf16(v.x, v.y); w.y = cvt_pk_bf16(v.z, v.w); o[64 * j] = w; }
    s = wave_sum(s); if (lane == 0) *ssq = s;
}
__device__ __forceinline__ void final_row(const bf16_t* __restrict__ yrow, float rstd, const float* __restrict__ gain, float* __restrict__ orow, int lane) {
    const u32x2* yr = (const u32x2*)yrow + lane; const f32x4* gr = (const f32x4*)gain + lane; f32x4* o = (f32x4*)orow + lane;
#pragma unroll
    for (int j = 0; j < 16; ++j) { const u32x2 w = yr[64 * j]; const f32x4 g = gr[64 * j];
        f32x4 v; v.x = __uint_as_float(w.x << 16) * rstd * g.x; v.y = __uint_as_float(w.x & 0xffff0000u) * rstd * g.y; v.z = __uint_as_float(w.y << 16) * rstd * g.z; v.w = __uint_as_float(w.y & 0xffff0000u) * rstd * g.w; __builtin_nontemporal_store(v, &o[64 * j]); }
}

__device__ __forceinline__ f32x4 gate_tile_part(const bf16_t* __restrict__ H, const bf16_t* __restrict__ Wg, int row0, int k0, int lane) {
    const bf16x8* a = (const bf16x8*)(H + (size_t)(row0 + (lane & 15)) * P::D + k0 + 8 * (lane >> 4));
    const bf16x8* b = (const bf16x8*)(Wg + (size_t)(lane & 15) * P::D + k0 + 8 * (lane >> 4));
    f32x4 acc = {0.f, 0.f, 0.f, 0.f};
#pragma unroll
    for (int kk = 0; kk < 16; ++kk) acc = __builtin_amdgcn_mfma_f32_16x16x32_bf16(a[4 * kk], b[4 * kk], acc, 0, 0, 0);
    return acc;
}
__device__ __forceinline__ f32x4 gate_tile(const bf16_t* __restrict__ H, const bf16_t* __restrict__ Wg, int row0, int lane) {
    const bf16x8* a = (const bf16x8*)(H + (size_t)(row0 + (lane & 15)) * P::D + 8 * (lane >> 4));
    const bf16x8* b = (const bf16x8*)(Wg + (size_t)(lane & 15) * P::D + 8 * (lane >> 4));
    f32x4 acc = {0.f, 0.f, 0.f, 0.f};
#pragma unroll 8
    for (int kk = 0; kk < P::D / 32; ++kk) acc = __builtin_amdgcn_mfma_f32_16x16x32_bf16(a[4 * kk], b[4 * kk], acc, 0, 0, 0);
    return acc;
}

struct EpiAbIn {
    static constexpr bool PERM = true, AFTER_DRAIN = false;
    bf16_t* proj; float* out; float* slab; const float* ssq;
    __device__ __forceinline__ void load_rs(const pg8::Unit& u, int wr, int fr, float (&q)[8]) const {
        if (u.slab >= 0) return;
        const float* sp = ssq + u.pm * 256 + wr * 64 + fr;
#pragma unroll
        for (int ai = 0; ai < 2; ++ai)
#pragma unroll
            for (int m = 0; m < 4; ++m) asm volatile("global_load_dword %0, %1, off offset:%2" : "=v"(q[4 * ai + m]) : "v"(sp), "i"((ai * 128 + m * 16) * 4) : "memory");
    }
    __device__ __forceinline__ void operator()(const f32x4 (&acc)[2][2][4][2], const pg8::Unit& u, int wr, int wc, int fr, int fq, const float (&q)[8]) const {
        using namespace P;
        if (u.slab >= 0) {
            float* sp = slab + (size_t)u.slab * 32768 + (size_t)(wr * 64 + fr) * 256 + wc * 32 + 8 * fq;
#pragma unroll
            for (int m = 0; m < 4; ++m)
#pragma unroll
                for (int bj = 0; bj < 2; ++bj) { *(f32x4*)(sp + m * 16 * 256 + bj * 128) = acc[0][bj][m][0]; *(f32x4*)(sp + m * 16 * 256 + bj * 128 + 4) = acc[0][bj][m][1]; }
            return;
        }
        const int seg = u.pn >> 3;
        const int row0 = u.pm * 256 + wr * 64 + fr, col0 = u.pn * 256 + wc * 32 + 8 * fq, cseg = col0 - seg * 2048;
#pragma unroll
        for (int ai = 0; ai < 2; ++ai)
#pragma unroll
            for (int m = 0; m < 4; ++m) { const int row = row0 + ai * 128 + m * 16; bf16_t* rp = proj + (size_t)row * AB_N + col0;
                float* fo = nullptr;
                if (seg == 3) fo = out + O_PK + (size_t)row * DB + cseg; else if (seg == 4) fo = out + O_PV + (size_t)row * DB + cseg;
                const float rs = rstd_of(q[4 * ai + m]);
#pragma unroll
                for (int bj = 0; bj < 2; ++bj) { const f32x4 v0 = acc[ai][bj][m][0] * rs, v1 = acc[ai][bj][m][1] * rs;
                    u32x4 w; w.x = cvt_pk_bf16(v0[0], v0[1]); w.y = cvt_pk_bf16(v0[2], v0[3]); w.z = cvt_pk_bf16(v1[0], v1[1]); w.w = cvt_pk_bf16(v1[2], v1[3]);
                    *(u32x4*)(rp + bj * 128) = w;
                    if (fo) { __builtin_nontemporal_store(v0, (f32x4*)(fo + bj * 128)); __builtin_nontemporal_store(v1, (f32x4*)(fo + bj * 128 + 4)); } } }
    }
};

struct EpiResid {
    static constexpr bool PERM = true, AFTER_DRAIN = false;
    bf16_t* Yb; float* slab; float* ssq;
    __device__ __forceinline__ void load_rs(const pg8::Unit&, int, int, float (&)[8]) const {}
    __device__ __forceinline__ void operator()(const f32x4 (&acc)[2][2][4][2], const pg8::Unit& u, int wr, int wc, int fr, int fq, const float (&)[8]) const {
        using namespace P;
        if (u.slab >= 0) {
            float* sp = slab + (size_t)u.slab * 32768 + (size_t)(wr * 64 + fr) * 256 + wc * 32 + 8 * fq;
#pragma unroll
            for (int m = 0; m < 4; ++m)
#pragma unroll
                for (int bj = 0; bj < 2; ++bj) { *(f32x4*)(sp + m * 16 * 256 + bj * 128) = acc[0][bj][m][0]; *(f32x4*)(sp + m * 16 * 256 + bj * 128 + 4) = acc[0][bj][m][1]; }
            return;
        }
        const int row0 = u.pm * 256 + wr * 64 + fr, col0 = u.pn * 256 + wc * 32 + 8 * fq;
#pragma unroll
        for (int ai = 0; ai < 2; ++ai)
#pragma unroll
            for (int m = 0; m < 4; ++m) { const int row = row0 + ai * 128 + m * 16; bf16_t* __restrict__ yp = Yb + (size_t)row * D + col0;
                u32x4 b[2];
#pragma unroll
                for (int bj = 0; bj < 2; ++bj) b[bj] = *(const u32x4*)(yp + bj * 128);
                float ss = 0.f;
#pragma unroll
                for (int bj = 0; bj < 2; ++bj) { f32x4 y0 = acc[ai][bj][m][0], y1 = acc[ai][bj][m][1];
                    y0[0] += __uint_as_float(b[bj].x << 16); y0[1] += __uint_as_float(b[bj].x & 0xffff0000u); y0[2] += __uint_as_float(b[bj].y << 16); y0[3] += __uint_as_float(b[bj].y & 0xffff0000u);
                    y1[0] += __uint_as_float(b[bj].z << 16); y1[1] += __uint_as_float(b[bj].z & 0xffff0000u); y1[2] += __uint_as_float(b[bj].w << 16); y1[3] += __uint_as_float(b[bj].w & 0xffff0000u);
                    ss += (y0[0] * y0[0] + y0[1] * y0[1]) + (y0[2] * y0[2] + y0[3] * y0[3]) + (y1[0] * y1[0] + y1[1] * y1[1]) + (y1[2] * y1[2] + y1[3] * y1[3]);
                    u32x4 w; w.x = cvt_pk_bf16(y0[0], y0[1]); w.y = cvt_pk_bf16(y0[2], y0[3]); w.z = cvt_pk_bf16(y1[0], y1[1]); w.w = cvt_pk_bf16(y1[2], y1[3]);
                    *(u32x4*)(yp + bj * 128) = w; }
                ss += __shfl_xor(ss, 16); ss += __shfl_xor(ss, 32);
                if (fq == 0) atomicAdd(ssq + row, ss); }
    }
};
struct EpiSwiGLU {
    static constexpr bool PERM = true, AFTER_DRAIN = false;
    bf16_t* G; float* slab; const float* ssq;
    __device__ __forceinline__ void load_rs(const pg8::Unit& u, int wr, int fr, float (&q)[8]) const {
        if (u.slab >= 0) return;
        const float* sp = ssq + u.pm * 256 + wr * 64 + fr;
#pragma unroll
        for (int ai = 0; ai < 2; ++ai)
#pragma unroll
            for (int m = 0; m < 4; ++m) asm volatile("global_load_dword %0, %1, off offset:%2" : "=v"(q[4 * ai + m]) : "v"(sp), "i"((ai * 128 + m * 16) * 4) : "memory");
    }
    __device__ __forceinline__ void operator()(const f32x4 (&acc)[2][2][4][2], const pg8::Unit& u, int wr, int wc, int fr, int fq, const float (&q)[8]) const {
        using namespace P;
        if (u.slab >= 0) {
            float* sp = slab + (size_t)u.slab * 32768 + (size_t)(wr * 64 + fr) * 256 + wc * 32 + 8 * fq;
#pragma unroll
            for (int m = 0; m < 4; ++m)
#pragma unroll
                for (int bj = 0; bj < 2; ++bj) { *(f32x4*)(sp + m * 16 * 256 + bj * 128) = acc[0][bj][m][0]; *(f32x4*)(sp + m * 16 * 256 + bj * 128 + 4) = acc[0][bj][m][1]; }
            return;
        }
        const int row0 = u.pm * 256 + wr * 64 + fr, col0 = u.pn * 128 + wc * 32 + 8 * fq;
#pragma unroll
        for (int ai = 0; ai < 2; ++ai)
#pragma unroll
            for (int m = 0; m < 4; ++m) { const int row = row0 + ai * 128 + m * 16; float o[8]; const float rs = rstd_of(q[4 * ai + m]);
#pragma unroll
                for (int n = 0; n < 2; ++n)
#pragma unroll
                    for (int j = 0; j < 4; ++j) { const float gt = acc[ai][0][m][n][j] * rs, up = acc[ai][1][m][n][j] * rs;
                        o[4 * n + j] = gt * __builtin_amdgcn_rcpf(1.0f + __builtin_amdgcn_exp2f(-1.4426950408889634f * gt)) * up; }
                u32x4 w; w.x = cvt_pk_bf16(o[0], o[1]); w.y = cvt_pk_bf16(o[2], o[3]); w.z = cvt_pk_bf16(o[4], o[5]); w.w = cvt_pk_bf16(o[6], o[7]);
                *(u32x4*)(G + (size_t)row * DFF + col0) = w; }
    }
};
struct EpiBf16Plain {
    static constexpr bool PERM = true, AFTER_DRAIN = false;
    bf16_t* O; int ldc; float* slab; const float* ssq;
    __device__ __forceinline__ void load_rs(const pg8::Unit& u, int wr, int fr, float (&q)[8]) const {
        if (u.slab >= 0) return;
        const float* sp = ssq + u.pm * 256 + wr * 64 + fr;
#pragma unroll
        for (int ai = 0; ai < 2; ++ai)
#pragma unroll
            for (int m = 0; m < 4; ++m) asm volatile("global_load_dword %0, %1, off offset:%2" : "=v"(q[4 * ai + m]) : "v"(sp), "i"((ai * 128 + m * 16) * 4) : "memory");
    }
    __device__ __forceinline__ void operator()(const f32x4 (&acc)[2][2][4][2], const pg8::Unit& u, int wr, int wc, int fr, int fq, const float (&q)[8]) const {
        if (u.slab >= 0) {
            float* sp = slab + (size_t)u.slab * 32768 + (size_t)(wr * 64 + fr) * 256 + wc * 32 + 8 * fq;
#pragma unroll
            for (int m = 0; m < 4; ++m)
#pragma unroll
                for (int bj = 0; bj < 2; ++bj) { *(f32x4*)(sp + m * 16 * 256 + bj * 128) = acc[0][bj][m][0]; *(f32x4*)(sp + m * 16 * 256 + bj * 128 + 4) = acc[0][bj][m][1]; }
            return;
        }
        const int row0 = u.pm * 256 + wr * 64 + fr, col0 = u.pn * 256 + wc * 32 + 8 * fq;
#pragma unroll
        for (int ai = 0; ai < 2; ++ai)
#pragma unroll
            for (int m = 0; m < 4; ++m) { bf16_t* rp = O + (size_t)(row0 + ai * 128 + m * 16) * ldc + col0; const float rs = rstd_of(q[4 * ai + m]);
#pragma unroll
                for (int bj = 0; bj < 2; ++bj) { const f32x4 v0 = acc[ai][bj][m][0] * rs, v1 = acc[ai][bj][m][1] * rs;
                    u32x4 w; w.x = cvt_pk_bf16(v0[0], v0[1]); w.y = cvt_pk_bf16(v0[2], v0[3]); w.z = cvt_pk_bf16(v1[0], v1[1]); w.w = cvt_pk_bf16(v1[2], v1[3]);
                    *(u32x4*)(rp + bj * 128) = w; } }
    }
};

template <bool FINAL>
__device__ __forceinline__ void sample_row_wg(const Ctx& C, LAS unsigned char* lds, const float* __restrict__ slab, int r, const float* xs, bf16_t* yrow, float* ssq_out, const float* __restrict__ gain, float* orow) {
    f32x4 v[2]; float ss = 0.f; LAS float* red = (LAS float*)lds;
#pragma unroll
    for (int jj = 0; jj < 2; ++jj) { const int j = 2 * C.wave + jj; f32x4 a;
        if (xs) a = ((const f32x4*)xs)[64 * j + C.lane];
        else { const u32x2 w = ((const u32x2*)yrow)[64 * j + C.lane]; a.x = __uint_as_float(w.x << 16); a.y = __uint_as_float(w.x & 0xffff0000u); a.z = __uint_as_float(w.y << 16); a.w = __uint_as_float(w.y & 0xffff0000u); }
        const float* sp = slab + (size_t)(j * 16) * 32768 + (size_t)r * 256 + 4 * C.lane; f32x4 p[16];
#pragma unroll
        for (int s = 0; s < 16; ++s) p[s] = *(const f32x4*)(sp + (size_t)s * 32768);
#pragma unroll
        for (int s = 0; s < 16; ++s) a = a + p[s];
        v[jj] = a; ss += (a.x * a.x + a.y * a.y) + (a.z * a.z + a.w * a.w);
        if (!FINAL) { u32x2 w; w.x = cvt_pk_bf16(a.x, a.y); w.y = cvt_pk_bf16(a.z, a.w); ((u32x2*)yrow)[64 * j + C.lane] = w; } }
    ss = wave_sum(ss);
    __syncthreads();
    if (C.lane == 0) red[C.wave] = ss;
    __syncthreads();
    float tot = 0.f;
#pragma unroll
    for (int w = 0; w < 8; ++w) tot += red[w];
    if (!FINAL) { if (C.tid == 0) *ssq_out = tot; }
    else { const float rr = rstd_of(tot);
#pragma unroll
        for (int jj = 0; jj < 2; ++jj) { const int j = 2 * C.wave + jj; const f32x4 g = ((const f32x4*)gain)[64 * j + C.lane]; ((f32x4*)orow)[64 * j + C.lane] = v[jj] * rr * g; } }
}
template <bool LAYER0>
__device__ __forceinline__ void combine_inproj(const Ctx& C, const float* __restrict__ slab, bf16_t* __restrict__ PROJ, const float* __restrict__ ssq) {
    using namespace P;
    constexpr int NT = LAYER0 ? AB_N / 256 : C_N / 256, S = LAYER0 ? 6 : 5, LD = LAYER0 ? AB_N : C_N;
    for (int it = C.gw; it < 128 * NT; it += C.ngw) { const int r = it / NT, pn = it - r * NT;
        f32x4 a = {0.f, 0.f, 0.f, 0.f};
#pragma unroll
        for (int s = 0; s < S; ++s) a = a + *(const f32x4*)(slab + (size_t)(pn * S + s) * 32768 + (size_t)r * 256 + 4 * C.lane);
        a = a * rstd_of(ssq[NP + r]);
        const int col = pn * 256 + 4 * C.lane; u32x2 w; w.x = cvt_pk_bf16(a[0], a[1]); w.y = cvt_pk_bf16(a[2], a[3]);
        *(u32x2*)(PROJ + (size_t)(NP + r) * LD + col) = w;
        if (LAYER0) { const int seg = pn >> 3, cseg = col - seg * 2048;
            if (seg == 1) *(f32x4*)(C.out + O_SGV + (size_t)r * DA + cseg) = a;
            else if (seg == 3) *(f32x4*)(C.out + O_SK + (size_t)r * DB + cseg) = a;
            else if (seg == 4) *(f32x4*)(C.out + O_SV + (size_t)r * DB + cseg) = a; }
    }
}
__device__ __forceinline__ void combine_swiglu(const Ctx& C, const float* __restrict__ slab, bf16_t* __restrict__ G, const float* __restrict__ ssq) {
    using namespace P;
    typedef float f32x2 __attribute__((ext_vector_type(2)));
    constexpr int NT = DFF / 128, S = 3;
    for (int it = C.gw; it < 128 * NT; it += C.ngw) { const int r = it / NT, pn = it - r * NT;
        f32x2 g = {0.f, 0.f}, u = {0.f, 0.f};
#pragma unroll
        for (int s = 0; s < S; ++s) { const float* sp = slab + (size_t)(pn * S + s) * 32768 + (size_t)r * 256 + 2 * C.lane; g = g + *(const f32x2*)sp; u = u + *(const f32x2*)(sp + 128); }
        { const float rs = rstd_of(ssq[NP + r]); g = g * rs; u = u * rs; }
        const float o0 = g.x * __builtin_amdgcn_rcpf(1.0f + __builtin_amdgcn_exp2f(-1.4426950408889634f * g.x)) * u.x, o1 = g.y * __builtin_amdgcn_rcpf(1.0f + __builtin_amdgcn_exp2f(-1.4426950408889634f * g.y)) * u.y;
        *(unsigned*)(G + (size_t)(NP + r) * DFF + pn * 128 + 2 * C.lane) = cvt_pk_bf16(o0, o1);
    }
}

typedef short v4i16 __attribute__((ext_vector_type(4)));
__device__ __forceinline__ v4i16 tr16(LAS unsigned char* p) { return __builtin_amdgcn_ds_read_tr16_b64_v4i16((LAS v4i16*)p); }
__device__ __forceinline__ bf16x8 cat44(v4i16 lo, v4i16 hi) { bf16x8 r; r[0] = lo[0]; r[1] = lo[1]; r[2] = lo[2]; r[3] = lo[3]; r[4] = hi[0]; r[5] = hi[1]; r[6] = hi[2]; r[7] = hi[3]; return r; }
__device__ __forceinline__ bf16x8 pack8f(f32x4 a, f32x4 b) { u32x4 w; w.x = cvt_pk_bf16(a[0], a[1]); w.y = cvt_pk_bf16(a[2], a[3]); w.z = cvt_pk_bf16(b[0], b[1]); w.w = cvt_pk_bf16(b[2], b[3]); return __builtin_bit_cast(bf16x8, w); }

namespace AT {
constexpr int KT = 0, VT = 17408, TBUF = 34816, CK = 69632, SCAN = 86272, TSTR = 272;
constexpr float C2 = 0.12751743f;
constexpr float LOG2E = 1.4426950408889634f;
}

template <bool SAMPLE>
__device__ __forceinline__ void attn_prepare_ck(const Ctx& C, LAS unsigned char* lds, int b, int h) {
    using namespace P;
    LAS float* ck = (LAS float*)(lds + AT::CK); LAS float* scan = (LAS float*)(lds + AT::SCAN);
    constexpr int n = SAMPLE ? PAST + DEC_S : SEQ;
    float v[8]; const int t0 = 8 * C.tid;
#pragma unroll
    for (int j = 0; j < 8; ++j) { const int t = t0 + j; float x = 0.f;
        if (t < n) { if (!SAMPLE) x = C.out[O_PLF + ((size_t)b * SEQ + t) * HB + h];
                     else x = t < PAST ? C.in[I_CLF][((size_t)b * PAST + t) * HB + h] : C.out[O_SLF + ((size_t)b * DEC_S + (t - PAST)) * HB + h]; }
        v[j] = x; }
#pragma unroll
    for (int j = 1; j < 8; ++j) v[j] += v[j - 1];
    const float tot = v[7]; float x = tot;
#pragma unroll
    for (int o = 1; o < 64; o <<= 1) { const float y = __shfl_up(x, o); if (C.lane >= o) x += y; }
    if (C.lane == 63) scan[C.wave] = x;
    __syncthreads();
    float base = 0.f;
    for (int w = 0; w < C.wave; ++w) base += scan[w];
    const float excl = base + x - tot;
#pragma unroll
    for (int j = 0; j < 8; ++j) if (t0 + j < n + 64) ck[t0 + j] = (excl + v[j]) * AT::LOG2E;
    __syncthreads();
}

template <bool SAMPLE>
__device__ __forceinline__ void attn_load_tile(const Ctx& C, const bf16_t* __restrict__ PROJ, int b, int h, int j, bf16x8 (&kreg)[2], bf16x8 (&vreg)[2]) {
    using namespace P;
#pragma unroll
    for (int i = 0; i < 2; ++i) { const int id = C.tid + 512 * i, r = id >> 4, ch = id & 15;
        if (!SAMPLE) { const bf16_t* p = PROJ + (size_t)(b * SEQ + 64 * j + r) * AB_N + h * DHB + 8 * ch;
            kreg[i] = *(const bf16x8*)(p + 3 * 2048); vreg[i] = *(const bf16x8*)(p + 4 * 2048); }
        else { const int kidx = 64 * j + r;
            if (kidx < PAST) { const size_t o = (((size_t)b * PAST + kidx) * HB + h) * DHB + 8 * ch; const float* kp = C.in[I_CK] + o; const float* vp = C.in[I_CV] + o;
                kreg[i] = pack8f(*(const f32x4*)kp, *(const f32x4*)(kp + 4)); vreg[i] = pack8f(*(const f32x4*)vp, *(const f32x4*)(vp + 4)); }
            else if (kidx < PAST + DEC_S) { const bf16_t* p = PROJ + (size_t)(NP + b * DEC_S + (kidx - PAST)) * AB_N + h * DHB + 8 * ch;
                kreg[i] = *(const bf16x8*)(p + 3 * 2048); vreg[i] = *(const bf16x8*)(p + 4 * 2048); }
            else { kreg[i] = (bf16x8){0, 0, 0, 0, 0, 0, 0, 0}; vreg[i] = (bf16x8){0, 0, 0, 0, 0, 0, 0, 0}; } }
    }
}

template <bool SAMPLE>
__device__ __forceinline__ void attn_qblock(const Ctx& C, LAS unsigned char* lds, const bf16_t* __restrict__ PROJ, bf16_t* __restrict__ MIX, int b, int h, int qb) {
    using namespace P;
    const int fr = C.lane & 15, fq = C.lane >> 4;
    const bool active = SAMPLE ? (C.wave == 0) : true;
    const int qpos0 = SAMPLE ? PAST : 256 * qb + 32 * C.wave;
    const int qrow0 = SAMPLE ? NP + b * DEC_S : b * SEQ + qpos0;
    const int ntiles = SAMPLE ? (PAST + DEC_S + 63) / 64 : 4 * qb + 4;
    LAS float* ck = (LAS float*)(lds + AT::CK);
    bf16x8 qf[2][4]; float cq2[2], mrow[2], lrow[2]; int qpos[2];
    f32x4 oacc[2][8];
#pragma unroll
    for (int qt = 0; qt < 2; ++qt) {
#pragma unroll
        for (int kk = 0; kk < 4; ++kk) qf[qt][kk] = *(const bf16x8*)(PROJ + (size_t)(qrow0 + 16 * qt + fr) * AB_N + 2 * 2048 + h * DHB + 32 * kk + 8 * fq);
        qpos[qt] = qpos0 + 16 * qt + fr; cq2[qt] = ck[qpos[qt]]; mrow[qt] = -1e30f; lrow[qt] = 0.f;
#pragma unroll
        for (int c = 0; c < 8; ++c) oacc[qt][c] = (f32x4){0.f, 0.f, 0.f, 0.f};
    }
    bf16x8 kreg[2], vreg[2];
    attn_load_tile<SAMPLE>(C, PROJ, b, h, ntiles - 1, kreg, vreg);
#define ATTN_STEP(IT, TBOFF) do { const int j = ntiles - 1 - (IT); LAS unsigned char* tb = lds + (TBOFF); \
_Pragma("unroll") \
        for (int i = 0; i < 2; ++i) { const int id = C.tid + 512 * i, r = id >> 4, ch = id & 15; \
            *(LAS bf16x8*)(tb + AT::KT + r * AT::TSTR + ch * 16) = kreg[i]; *(LAS bf16x8*)(tb + AT::VT + r * AT::TSTR + ch * 16) = vreg[i]; } \
        __syncthreads(); \
        if (j > 0) attn_load_tile<SAMPLE>(C, PROJ, b, h, j - 1, kreg, vreg); \
        const int key0 = 64 * j; \
        if (active && key0 <= qpos0 + 31) { \
        const bool need_mask = key0 + 63 > qpos0; \
        f32x4 s[2][4]; \
_Pragma("unroll") \
        for (int qt = 0; qt < 2; ++qt) \
_Pragma("unroll") \
            for (int kt = 0; kt < 4; ++kt) s[qt][kt] = (f32x4){0.f, 0.f, 0.f, 0.f}; \
_Pragma("unroll") \
        for (int kt = 0; kt < 4; ++kt) { \
_Pragma("unroll") \
            for (int kk = 0; kk < 4; ++kk) { const bf16x8 kf = *(const LAS bf16x8*)(tb + AT::KT + (16 * kt + fr) * AT::TSTR + (32 * kk + 8 * fq) * 2); \
_Pragma("unroll") \
                for (int qt = 0; qt < 2; ++qt) s[qt][kt] = __builtin_amdgcn_mfma_f32_16x16x32_bf16(kf, qf[qt][kk], s[qt][kt], 0, 0, 0); } \
            __builtin_amdgcn_sched_barrier(0); } \
_Pragma("unroll") \
        for (int kt = 0; kt < 4; ++kt) { const f32x4 cb = *(const LAS f32x4*)(ck + key0 + 16 * kt + 4 * fq); \
_Pragma("unroll") \
            for (int qt = 0; qt < 2; ++qt) \
_Pragma("unroll") \
                for (int r = 0; r < 4; ++r) s[qt][kt][r] = s[qt][kt][r] * AT::C2 + (cq2[qt] - cb[r]); } \
        if (need_mask) { \
_Pragma("unroll") \
            for (int kt = 0; kt < 4; ++kt) \
_Pragma("unroll") \
                for (int qt = 0; qt < 2; ++qt) \
_Pragma("unroll") \
                    for (int r = 0; r < 4; ++r) if (key0 + 16 * kt + 4 * fq + r > qpos[qt]) s[qt][kt][r] = -__builtin_inff(); } \
        bf16x8 pf[2][2]; \
_Pragma("unroll") \
        for (int qt = 0; qt < 2; ++qt) { \
            float tmax = s[qt][0][0]; \
_Pragma("unroll") \
            for (int kt = 0; kt < 4; ++kt) \
_Pragma("unroll") \
                for (int r = 0; r < 4; ++r) tmax = fmaxf(tmax, s[qt][kt][r]); \
            tmax = fmaxf(tmax, __shfl_xor(tmax, 16)); tmax = fmaxf(tmax, __shfl_xor(tmax, 32)); \
            if (__any(tmax > mrow[qt])) { \
                const float mn = fmaxf(mrow[qt], tmax), alpha = __builtin_amdgcn_exp2f(mrow[qt] - mn); mrow[qt] = mn; lrow[qt] *= alpha; \
_Pragma("unroll") \
                for (int c = 0; c < 8; ++c) oacc[qt][c] = oacc[qt][c] * alpha; } \
            const float mn = mrow[qt]; float psum = 0.f; \
_Pragma("unroll") \
            for (int kt = 0; kt < 4; ++kt) \
_Pragma("unroll") \
                for (int r = 0; r < 4; ++r) { const float p = __builtin_amdgcn_exp2f(s[qt][kt][r] - mn); psum += p; s[qt][kt][r] = p; } \
            lrow[qt] += psum; \
            pf[qt][0] = pack8f(s[qt][0], s[qt][1]); pf[qt][1] = pack8f(s[qt][2], s[qt][3]); \
        } \
_Pragma("unroll") \
        for (int ks = 0; ks < 2; ++ks) \
_Pragma("unroll") \
            for (int c = 0; c < 8; ++c) { LAS unsigned char* vb = tb + AT::VT + (32 * ks + 4 * fq + ((C.lane & 15) >> 2)) * AT::TSTR + (16 * c + 4 * (C.lane & 3)) * 2; \
                const bf16x8 vf = cat44(tr16(vb), tr16(vb + 16 * AT::TSTR)); \
_Pragma("unroll") \
                for (int qt = 0; qt < 2; ++qt) oacc[qt][c] = __builtin_amdgcn_mfma_f32_16x16x32_bf16(vf, pf[qt][ks], oacc[qt][c], 0, 0, 0); \
                if (c & 1) __builtin_amdgcn_sched_barrier(0); } \
            } \
    } while (0)
    for (int it = 0; it < ntiles; it += 2) { ATTN_STEP(it, 0); if (it + 1 < ntiles) ATTN_STEP(it + 1, AT::TBUF); }
#undef ATTN_STEP
    __syncthreads();
    if (active) {
#pragma unroll
        for (int qt = 0; qt < (SAMPLE ? 1 : 2); ++qt) { float lt = lrow[qt]; lt += __shfl_xor(lt, 16); lt += __shfl_xor(lt, 32); const float inv = 1.0f / lt;
            bf16_t* op = MIX + (size_t)(qrow0 + 16 * qt + fr) * D + DA + h * DHB + 4 * fq;
#pragma unroll
            for (int c = 0; c < 8; ++c) { const f32x4 o = oacc[qt][c] * inv; u32x2 w; w.x = cvt_pk_bf16(o[0], o[1]); w.y = cvt_pk_bf16(o[2], o[3]); *(u32x2*)(op + 16 * c) = w; } }
    }
}

namespace GM { constexpr int WT = 0, WSTR = 272, VA = 34816, VSTR = 544; }
__device__ __forceinline__ void gmlp_unit(const Ctx& C, LAS unsigned char* lds, const bf16_t* __restrict__ PROJ, bf16_t* __restrict__ MIX, int rowbase, int nrows, int g) {
    using namespace P;
    __syncthreads();
    { const float* Wg = C.in[I_GWS] + (size_t)g * 128 * 128; const int r = C.tid >> 2, c0 = (C.tid & 3) * 32;
#pragma unroll
        for (int q = 0; q < 4; ++q) { const int c = c0 + 8 * q; f32x4 a = *(const f32x4*)(Wg + r * 128 + c), bb = *(const f32x4*)(Wg + r * 128 + c + 4);
#pragma unroll
            for (int e = 0; e < 4; ++e) { if (c + e > r) a[e] = 0.f; if (c + 4 + e > r) bb[e] = 0.f; }
            *(LAS bf16x8*)(lds + GM::WT + r * GM::WSTR + c * 2) = pack8f(a, bb); } }
#pragma unroll
    for (int i = 0; i < 8; ++i) { const int id = C.tid + 512 * i, s = id >> 5, ch = id & 31; bf16x8 v = (bf16x8){0, 0, 0, 0, 0, 0, 0, 0};
        if (s < nrows) v = *(const bf16x8*)(PROJ + (size_t)(rowbase + s) * AB_N + DA + g * 256 + 8 * ch);
        *(LAS bf16x8*)(lds + GM::VA + s * GM::VSTR + ch * 16) = v; }
    __syncthreads();
    if (16 * C.wave < nrows) {
        const int fr = C.lane & 15, fq = C.lane >> 4, w = C.wave; const int nk = (16 * w + 15) / 32 + 1;
        f32x4 acc[16];
#pragma unroll
        for (int nt = 0; nt < 16; ++nt) acc[nt] = (f32x4){0.f, 0.f, 0.f, 0.f};
        for (int kk = 0; kk < nk; ++kk) { const bf16x8 wf = *(const LAS bf16x8*)(lds + GM::WT + (16 * w + fr) * GM::WSTR + (32 * kk + 8 * fq) * 2);
            LAS unsigned char* vb = lds + GM::VA + (32 * kk + 8 * fq + ((C.lane & 15) >> 2)) * GM::VSTR + 4 * (C.lane & 3) * 2;
#pragma unroll
            for (int nt = 0; nt < 16; ++nt) { const bf16x8 af = cat44(tr16(vb + nt * 32), tr16(vb + nt * 32 + 4 * GM::VSTR)); acc[nt] = __builtin_amdgcn_mfma_f32_16x16x32_bf16(af, wf, acc[nt], 0, 0, 0); } }
        const int row = rowbase + 16 * w + fr; const float bias = C.in[I_GB][g * 128 + 16 * w + fr];
        const bf16_t* up = PROJ + (size_t)row * AB_N + g * 256 + 4 * fq; bf16_t* op = MIX + (size_t)row * D + g * 256 + 4 * fq;
#pragma unroll
        for (int nt = 0; nt < 16; ++nt) { const u32x2 uu = *(const u32x2*)(up + 16 * nt);
            const float u0 = __uint_as_float(uu.x << 16), u1 = __uint_as_float(uu.x & 0xffff0000u), u2 = __uint_as_float(uu.y << 16), u3 = __uint_as_float(uu.y & 0xffff0000u);
            u32x2 wv; wv.x = cvt_pk_bf16(u0 * (acc[nt][0] + bias), u1 * (acc[nt][1] + bias)); wv.y = cvt_pk_bf16(u2 * (acc[nt][2] + bias), u3 * (acc[nt][3] + bias));
            *(u32x2*)(op + 16 * nt) = wv; }
    }
}

__device__ __forceinline__ unsigned cvt_pk_bf16_cv(float lo, float hi) { typedef __bf16 bf2_t __attribute__((ext_vector_type(2))); typedef float f2_t __attribute__((ext_vector_type(2))); const f2_t v = {lo, hi}; return __builtin_bit_cast(unsigned, __builtin_convertvector(v, bf2_t)); }
__device__ __forceinline__ bf16_t f2bf_rne(float f) { const unsigned u = __float_as_uint(f); return (bf16_t)((u + 0x7fffu + ((u >> 16) & 1u)) >> 16); }
#ifndef ML_T
#define ML_T(k)
#endif
namespace ML {
constexpr int QT = 0, QSTR = 528, KT = 33792, VT = 67584, VSTR = 112, VW = 74752, CIT = 81920, GA = 107264;
constexpr float KSCALE = 0.0625f, LOG2E = 1.4426950408889634f;
}
template <bool SAMPLE>
__device__ __forceinline__ void mlstm_unit(const Ctx& C, LAS unsigned char* lds, const bf16_t* __restrict__ PROJ, const float* __restrict__ GATES, bf16_t* __restrict__ HS, int b, int h, int sl, const f32x4* __restrict__ GS, const bf16x8* __restrict__ PB) {
    using namespace P;
    const int fr = C.lane & 15, fq = C.lane >> 4, w = C.wave, tt = w & 3, vt = w >> 2, qsub = (C.lane & 15) >> 2, psub = C.lane & 3;
    constexpr int NCH = SAMPLE ? 1 : SEQ / 64, LV = SAMPLE ? DEC_S : 64;
    const int rowbase = SAMPLE ? NP + b * DEC_S : b * SEQ;
    const int bh = b * HC + h;
    LAS float* ga = (LAS float*)(lds + ML::GA);
    f32x4 Cacc[2][3]; float mprev = 0.f;
#pragma unroll
    for (int dt = 0; dt < 2; ++dt)
#pragma unroll
        for (int v2 = 0; v2 < 3; ++v2) Cacc[dt][v2] = (f32x4){0.f, 0.f, 0.f, 0.f};
    if (SAMPLE) {
        const float* c0 = C.in[I_SC] + (size_t)bh * DKC * DVC; const float* n0 = C.in[I_SN] + (size_t)bh * DKC;
#pragma unroll
        for (int dt = 0; dt < 2; ++dt) {
#pragma unroll
            for (int v2 = 0; v2 < 2; ++v2)
#pragma unroll
                for (int r = 0; r < 4; ++r) Cacc[dt][v2][r] = c0[(size_t)(32 * w + 16 * dt + 4 * fq + r) * DVC + sl * 32 + 16 * v2 + fr];
#pragma unroll
            for (int r = 0; r < 4; ++r) Cacc[dt][2][r] = fr == 0 ? n0[32 * w + 16 * dt + 4 * fq + r] : 0.f; }
        mprev = C.in[I_SM][bh];
    }
    __syncthreads();
#define ML_WRITE_CIT() do { _Pragma("unroll") for (int dt = 0; dt < 2; ++dt) _Pragma("unroll") for (int v2 = 0; v2 < 3; ++v2) { \
        u32x2 w_; w_.x = cvt_pk_bf16_cv(Cacc[dt][v2][0], Cacc[dt][v2][1]); w_.y = cvt_pk_bf16_cv(Cacc[dt][v2][2], Cacc[dt][v2][3]); \
        *(LAS u32x2*)(lds + ML::CIT + (16 * v2 + fr) * ML::QSTR + (32 * w + 16 * dt + 4 * fq) * 2) = w_; } } while (0)
    ML_WRITE_CIT();
    bf16x8 qreg[4], kreg[4], vreg, pSn[2]; float lfv, igv; f32x4 gsn;
#define ML_LOAD_CHUNK(c) do { \
_Pragma("unroll") \
        for (int i = 0; i < 4; ++i) { const int id = C.tid + 512 * i, r = id >> 5, ch = id & 31; \
            if (r < LV) { const bf16_t* p = PROJ + (size_t)(rowbase + 64 * (c) + r) * C_N + h * DKC + 8 * ch; qreg[i] = *(const bf16x8*)p; kreg[i] = *(const bf16x8*)(p + 2048); } \
            else { qreg[i] = (bf16x8){0, 0, 0, 0, 0, 0, 0, 0}; kreg[i] = (bf16x8){0, 0, 0, 0, 0, 0, 0, 0}; } } \
        { const int r = (C.tid & 255) >> 2, ch = C.tid & 3; \
            if (r < LV) vreg = *(const bf16x8*)(PROJ + (size_t)(rowbase + 64 * (c) + r) * C_N + 4096 + h * DVC + sl * 32 + 8 * ch); else vreg = (bf16x8){0, 0, 0, 0, 0, 0, 0, 0}; } \
        if constexpr (SAMPLE) { if (C.lane < LV) { const float* gp = GATES + (size_t)(rowbase + 64 * (c) + C.lane) * 16; igv = gp[h]; lfv = gp[8 + h]; } else { igv = -__builtin_inff(); lfv = 0.f; } } \
        else { gsn = GS[(size_t)bh * SEQ + 64 * (c) + C.lane]; const bf16x8* pp = PB + ((size_t)(bh * 64 + (c)) * 4 + tt) * 128 + C.lane; pSn[0] = pp[0]; pSn[1] = pp[64]; } \
    } while (0)
    ML_LOAD_CHUNK(0);
    for (int c = 0; c < NCH; ++c) {
        ML_T(0);
        float bcs, av, cm; bf16x8 pS0, pS1;
        if constexpr (SAMPLE) {
            bcs = lfv;
#pragma unroll
            for (int o = 1; o < 64; o <<= 1) { const float y = __shfl_up(bcs, o); if (C.lane >= o) bcs += y; }
            av = igv - bcs; cm = av;
#pragma unroll
            for (int o = 1; o < 64; o <<= 1) { const float y = __shfl_up(cm, o); if (C.lane >= o) cm = fmaxf(cm, y); }
        } else { bcs = gsn[0]; av = gsn[1]; cm = gsn[2]; pS0 = pSn[0]; pS1 = pSn[1]; }
        const float Mt = fmaxf(mprev, cm), Mend = __shfl(Mt, 63), bend = __shfl(bcs, 63);
        const float wsv = __builtin_amdgcn_exp2f((av - Mend) * ML::LOG2E), wc = __builtin_amdgcn_exp2f((mprev - Mend) * ML::LOG2E);
#pragma unroll
        for (int i = 0; i < 4; ++i) { const int id = C.tid + 512 * i, r = id >> 5, ch = id & 31;
            *(LAS bf16x8*)(lds + ML::QT + r * ML::QSTR + ch * 16) = qreg[i]; *(LAS bf16x8*)(lds + ML::KT + r * ML::QSTR + ch * 16) = kreg[i]; }
        { const int r = C.tid < 256 ? (C.tid >> 2) : ((C.tid - 256) >> 1) & 63; const float sc = __shfl(wsv, r) * ML::KSCALE;
            if (C.tid < 256) { const int ch = C.tid & 3; *(LAS bf16x8*)(lds + ML::VT + r * ML::VSTR + ch * 16) = vreg;
                const u32x4 vv = __builtin_bit_cast(u32x4, vreg); u32x4 o;
#pragma unroll
                for (int e = 0; e < 4; ++e) o[e] = cvt_pk_bf16(__uint_as_float(vv[e] << 16) * sc, __uint_as_float(vv[e] & 0xffff0000u) * sc);
                *(LAS u32x4*)(lds + ML::VW + r * ML::VSTR + ch * 16) = o; }
            else if (C.tid < 384) { const int hf = C.tid & 1;
                u32x4 o1 = {0u, 0u, 0u, 0u}, o2 = {0u, 0u, 0u, 0u}; if (hf == 0) { o1.x = 0x3F80u; o2.x = cvt_pk_bf16(sc, 0.f); }
                *(LAS u32x4*)(lds + ML::VT + r * ML::VSTR + 64 + hf * 16) = o1; *(LAS u32x4*)(lds + ML::VW + r * ML::VSTR + 64 + hf * 16) = o2; } }
        if (SAMPLE && w == 0) { ga[C.lane] = av; ga[64 + C.lane] = wsv; }
        __syncthreads();
        ML_T(1);
        if (c + 1 < NCH) ML_LOAD_CHUNK(c + 1);
        {
            const float Mrow = __shfl(Mt, 16 * tt + fr), brow = __shfl(bcs, 16 * tt + fr);
            const float winter = __builtin_amdgcn_exp2f((mprev - Mrow) * ML::LOG2E);
            bf16x8 qfr[8];
#pragma unroll
            for (int kk = 0; kk < 8; ++kk) qfr[kk] = *(const LAS bf16x8*)(lds + ML::QT + (16 * tt + fr) * ML::QSTR + (32 * kk + 8 * fq) * 2);
            const int tpos = 16 * tt + fr; float rrow = 1.0f;
            if constexpr (SAMPLE) {
                f32x4 sT[4];
#pragma unroll
                for (int st = 0; st < 4; ++st) { sT[st] = (f32x4){0.f, 0.f, 0.f, 0.f};
#pragma unroll
                    for (int kk = 0; kk < 8; ++kk) { const bf16x8 kf = *(const LAS bf16x8*)(lds + ML::KT + (16 * st + fr) * ML::QSTR + (32 * kk + 8 * fq) * 2);
                        sT[st] = __builtin_amdgcn_mfma_f32_16x16x32_bf16(kf, qfr[kk], sT[st], 0, 0, 0); }
                    __builtin_amdgcn_sched_barrier(0); }
#pragma unroll
                for (int st = 0; st < 4; ++st) { const f32x4 a4 = *(const LAS f32x4*)(ga + 16 * st + 4 * fq);
#pragma unroll
                    for (int r = 0; r < 4; ++r) { const int spos = 16 * st + 4 * fq + r;
                        float wgt = __builtin_amdgcn_exp2f((a4[r] - Mrow) * ML::LOG2E); if (spos > tpos) wgt = 0.f;
                        sT[st][r] = sT[st][r] * ML::KSCALE * wgt; } }
                pS0 = pack8f(sT[0], sT[1]); pS1 = pack8f(sT[2], sT[3]);
            } else rrow = __builtin_amdgcn_exp2f((__shfl(cm, tpos) - Mrow) * ML::LOG2E);
            f32x4 acc = (f32x4){0.f, 0.f, 0.f, 0.f}, acc3 = (f32x4){0.f, 0.f, 0.f, 0.f}, accP = (f32x4){0.f, 0.f, 0.f, 0.f}, acc3P = (f32x4){0.f, 0.f, 0.f, 0.f};
#pragma unroll
            for (int kk = 0; kk < 8; ++kk) { const bf16x8 cf = *(const LAS bf16x8*)(lds + ML::CIT + (16 * vt + fr) * ML::QSTR + (32 * kk + 8 * fq) * 2);
                const bf16x8 nf = *(const LAS bf16x8*)(lds + ML::CIT + (32 + fr) * ML::QSTR + (32 * kk + 8 * fq) * 2);
                acc = __builtin_amdgcn_mfma_f32_16x16x32_bf16(cf, qfr[kk], acc, 0, 0, 0); acc3 = __builtin_amdgcn_mfma_f32_16x16x32_bf16(nf, qfr[kk], acc3, 0, 0, 0); }
            { LAS unsigned char* vb = lds + ML::VT + (4 * fq + qsub) * ML::VSTR + (16 * vt + 4 * psub) * 2; LAS unsigned char* ob = lds + ML::VT + (4 * fq + qsub) * ML::VSTR + (32 + 4 * psub) * 2;
                const bf16x8 vf0 = cat44(tr16(vb), tr16(vb + 16 * ML::VSTR)), of0 = cat44(tr16(ob), tr16(ob + 16 * ML::VSTR));
                accP = __builtin_amdgcn_mfma_f32_16x16x32_bf16(vf0, pS0, accP, 0, 0, 0); acc3P = __builtin_amdgcn_mfma_f32_16x16x32_bf16(of0, pS0, acc3P, 0, 0, 0);
                const bf16x8 vf1 = cat44(tr16(vb + 32 * ML::VSTR), tr16(vb + 48 * ML::VSTR)), of1 = cat44(tr16(ob + 32 * ML::VSTR), tr16(ob + 48 * ML::VSTR));
                accP = __builtin_amdgcn_mfma_f32_16x16x32_bf16(vf1, pS1, accP, 0, 0, 0); acc3P = __builtin_amdgcn_mfma_f32_16x16x32_bf16(of1, pS1, acc3P, 0, 0, 0); }
            acc = acc * winter + accP * rrow; acc3 = acc3 * winter + acc3P * rrow;
            const float den = __shfl(acc3[0], fr);
            const float lim = __builtin_amdgcn_exp2f(-(brow + Mrow) * ML::LOG2E);
            const float inv = 1.0f / fmaxf(fabsf(den), lim);
            if (tpos < LV) { const f32x4 hv = acc * inv; u32x2 hw; hw.x = cvt_pk_bf16(hv[0], hv[1]); hw.y = cvt_pk_bf16(hv[2], hv[3]); *(u32x2*)(HS + (size_t)(rowbase + 64 * c + tpos) * D + h * DVC + sl * 32 + 16 * vt + 4 * fq) = hw; }
        }
        __syncthreads();
        ML_T(2);
        {
#pragma unroll
            for (int dt = 0; dt < 2; ++dt)
#pragma unroll
                for (int v2 = 0; v2 < 3; ++v2) Cacc[dt][v2] = Cacc[dt][v2] * wc;
#pragma unroll
            for (int ks = 0; ks < 2; ++ks) { bf16x8 vw[3];
#pragma unroll
                for (int v2 = 0; v2 < 3; ++v2) { LAS unsigned char* vb = lds + ML::VW + (32 * ks + 8 * fq + qsub) * ML::VSTR + (16 * v2 + 4 * psub) * 2; vw[v2] = cat44(tr16(vb), tr16(vb + 4 * ML::VSTR)); }
#pragma unroll
                for (int dt = 0; dt < 2; ++dt) { LAS unsigned char* kb = lds + ML::KT + (32 * ks + 8 * fq + qsub) * ML::QSTR + (32 * w + 16 * dt + 4 * psub) * 2;
                    const bf16x8 kf = cat44(tr16(kb), tr16(kb + 4 * ML::QSTR));
#pragma unroll
                    for (int v2 = 0; v2 < 3; ++v2) Cacc[dt][v2] = __builtin_amdgcn_mfma_f32_16x16x32_bf16(kf, vw[v2], Cacc[dt][v2], 0, 0, 0); } }
            ML_WRITE_CIT();
            mprev = bend + Mend;
        }
        __syncthreads();
        ML_T(3);
    }
    { float* co = C.out + (SAMPLE ? O_SC : O_PC) + (size_t)bh * DKC * DVC;
#pragma unroll
        for (int dt = 0; dt < 2; ++dt)
#pragma unroll
            for (int v2 = 0; v2 < 2; ++v2)
#pragma unroll
                for (int r = 0; r < 4; ++r) co[(size_t)(32 * w + 16 * dt + 4 * fq + r) * DVC + sl * 32 + 16 * v2 + fr] = Cacc[dt][v2][r];
        if (sl == 0) { float* no = C.out + (SAMPLE ? O_SN : O_PN) + (size_t)bh * DKC;
            if (fr == 0) {
#pragma unroll
                for (int dt = 0; dt < 2; ++dt)
#pragma unroll
                    for (int r = 0; r < 4; ++r) no[32 * w + 16 * dt + 4 * fq + r] = Cacc[dt][2][r]; }
            if (C.tid == 0) C.out[(SAMPLE ? O_SM : O_PM) + bh] = mprev; } }
}
#undef ML_WRITE_CIT
#undef ML_LOAD_CHUNK
__device__ __forceinline__ void mlstm_prepass(const Ctx& C, const bf16_t* __restrict__ PROJ, const float* __restrict__ GATES, f32x4* __restrict__ GS, bf16x8* __restrict__ PB, int bh, int c) {
    using namespace P;
    const int fr = C.lane & 15, fq = C.lane >> 4, w = C.wave, tt = w & 3, sh = w >> 2, b = bh >> 3, h = bh & 7;
    const size_t rowc = (size_t)b * SEQ + 64 * c;
    const float* gp = GATES + (rowc + C.lane) * 16; const float igv = gp[h], lfv = gp[8 + h];
    bf16x8 qfr[8];
#pragma unroll
    for (int kk = 0; kk < 8; ++kk) qfr[kk] = *(const bf16x8*)(PROJ + (rowc + 16 * tt + fr) * C_N + h * DKC + 32 * kk + 8 * fq);
    float bcs = lfv;
#pragma unroll
    for (int o = 1; o < 64; o <<= 1) { const float y = __shfl_up(bcs, o); if (C.lane >= o) bcs += y; }
    const float av = igv - bcs; float cm = av;
#pragma unroll
    for (int o = 1; o < 64; o <<= 1) { const float y = __shfl_up(cm, o); if (C.lane >= o) cm = fmaxf(cm, y); }
    if (w == 0) GS[(size_t)bh * SEQ + 64 * c + C.lane] = (f32x4){bcs, av, cm, 0.f};
    const int tpos = 16 * tt + fr; const float cmrow = __shfl(cm, tpos);
    f32x4 sT[2];
#pragma unroll
    for (int i = 0; i < 2; ++i) { const int st = 2 * sh + i; sT[i] = (f32x4){0.f, 0.f, 0.f, 0.f};
        if (st <= tt) {
#pragma unroll
            for (int kk = 0; kk < 8; ++kk) { const bf16x8 kf = *(const bf16x8*)(PROJ + (rowc + 16 * st + fr) * C_N + 2048 + h * DKC + 32 * kk + 8 * fq);
                sT[i] = __builtin_amdgcn_mfma_f32_16x16x32_bf16(kf, qfr[kk], sT[i], 0, 0, 0); } }
#pragma unroll
        for (int r = 0; r < 4; ++r) { const int spos = 16 * st + 4 * fq + r; const float as = __shfl(av, spos);
            float wgt = __builtin_amdgcn_exp2f((as - cmrow) * ML::LOG2E); if (spos > tpos) wgt = 0.f;
            sT[i][r] = sT[i][r] * ML::KSCALE * wgt; } }
    PB[((size_t)(bh * 64 + c) * 4 + tt) * 128 + sh * 64 + C.lane] = pack8f(sT[0], sT[1]);
}
__device__ __forceinline__ void mlstm_headnorm_row(const bf16_t* __restrict__ hs, const bf16_t* __restrict__ opre, const float* __restrict__ gn, bf16_t* __restrict__ mix, int lane) {
    const u32x4* hr = (const u32x4*)hs + lane; const f32x4* gr = (const f32x4*)gn + 2 * lane; const u32x4* orr = (const u32x4*)opre + lane; u32x4* mo = (u32x4*)mix + lane;
#pragma unroll
    for (int hh = 0; hh < 8; ++hh) { const u32x4 hw = hr[64 * hh], ow = orr[64 * hh]; const f32x4 g0 = gr[128 * hh], g1 = gr[128 * hh + 1];
        float v[8], o[8];
#pragma unroll
        for (int e = 0; e < 4; ++e) { v[2 * e] = __uint_as_float(hw[e] << 16); v[2 * e + 1] = __uint_as_float(hw[e] & 0xffff0000u); o[2 * e] = __uint_as_float(ow[e] << 16); o[2 * e + 1] = __uint_as_float(ow[e] & 0xffff0000u); }
        float ss = 0.f;
#pragma unroll
        for (int e = 0; e < 8; ++e) ss += v[e] * v[e];
        ss = wave_sum(ss);
        const float r = 1.0f / sqrtf(ss * (1.0f / 512.0f) + P::EPS);
        float y[8];
#pragma unroll
        for (int e = 0; e < 8; ++e) { const float sg = __builtin_amdgcn_rcpf(1.0f + __builtin_amdgcn_exp2f(-1.4426950408889634f * o[e])); y[e] = sg * v[e] * r * (e < 4 ? g0[e] : g1[e - 4]); }
        u32x4 w; w.x = cvt_pk_bf16(y[0], y[1]); w.y = cvt_pk_bf16(y[2], y[3]); w.z = cvt_pk_bf16(y[4], y[5]); w.w = cvt_pk_bf16(y[6], y[7]); mo[64 * hh] = w; }
}

struct Args { const float* in[P::N_IN]; float* out; unsigned char* ws; };

__global__ void __launch_bounds__(512, 2) fwd(Args args) {
    using namespace P;
    extern __shared__ __attribute__((aligned(16))) unsigned char lds_raw[];
    LAS unsigned char* lds = (LAS unsigned char*)lds_raw;
    Ctx C;
    C.in = args.in;
    C.out = args.out; C.ws = args.ws;
    C.tid = threadIdx.x; C.lane = C.tid & 63; C.wave = __builtin_amdgcn_readfirstlane(C.tid >> 6);
    C.G = gridDim.x; C.gw = blockIdx.x * 8 + C.wave; C.ngw = C.G * 8;
    volatile LAS unsigned* MISC = (volatile LAS unsigned*)(lds + MISC_OFF);
    for (int u = C.tid; u < (LDS_BYTES - MISC_OFF) / 4; u += 512) ((LAS unsigned*)(lds + MISC_OFF))[u] = 0u;
    __syncthreads();
    unsigned* ctl = (unsigned*)(C.ws + WS_CTL);
    XcdBarrier bar = xcd_barrier_post(ctl + CW_BAR, MISC + 8);

#define Yb ((bf16_t*)(args.ws + P::WS_H))
#define SSQ(i) ((float*)(args.ws + P::WS_CTL + P::CTL_SSQ) + (i) * P::MP)
#define PROJ ((bf16_t*)(args.ws + P::WS_PROJ))
#define MIX ((bf16_t*)(args.ws + P::WS_MIX))
#define Gb ((bf16_t*)(args.ws + P::WS_G))
#define HS ((bf16_t*)(args.ws + P::WS_G))
#define GATES ((float*)(args.ws + P::WS_GATES))
#define SLAB ((float*)(args.ws + P::WS_SLAB))
    const int bid = (int)blockIdx.x;
#define TS(n)
#define PHASE_BEGIN() do { int t_ = threadIdx.x; asm volatile("" : "+v"(t_)); C.tid = t_; C.lane = t_ & 63; } while (0)

    PHASE_BEGIN();
    {
        { Bg<CvL0> bg; bg.next = C.gw; bg.cur = -1; bg_drain(C, bg); }
        LAS float* scr = (LAS float*)(lds + C.wave * 16384);
        if ((C.gw & 15) == 0 && (C.gw >> 4) < 128) { const int it = C.gw >> 4;
            if (it < 64) transpose_item(C.in[I_ABWIN], AB_LD, D, 64 * it, AB_N, 16, (bf16_t*)(C.ws + WS_WABF), 0, scr, C.lane, C.in[I_NMIX]);
            else transpose_item(C.in[I_CWIN], C_LD, D, 64 * (it - 64), C_N, 16, (bf16_t*)(C.ws + WS_WCIF), 0, scr, C.lane, C.in[I_NMIX] + D); }
        for (int m = C.gw; m < M; m += C.ngw) {
            const float* xr = m < NP ? C.in[I_XP] + (size_t)m * D : C.in[I_XS] + (size_t)(m - NP) * D;
            xrow_to_bf16(xr, Yb + (size_t)m * D, SSQ(0) + m, C.lane);
        }
    }
    xcd_barrier(bar);

    PHASE_BEGIN();
    {
        const bf16_t* Wf = (const bf16_t*)(C.ws + WS_WABF);
        for (int t = bid; t < M / 16; t += C.G) {
            const int row0 = 16 * t; const f32x4 part = gate_tile_part(Yb, Wf, row0, 512 * C.wave, C.lane);
            ((LAS f32x4*)lds)[C.wave * 64 + C.lane] = part;
            __syncthreads();
            if (C.wave == 0) { f32x4 acc = ((LAS f32x4*)lds)[C.lane];
#pragma unroll
                for (int w = 1; w < 8; ++w) acc = acc + ((LAS f32x4*)lds)[w * 64 + C.lane];
                const int n = C.lane & 15, g4 = 4 * (C.lane >> 4); const float bf = C.in[I_FBF][n];
#pragma unroll
                for (int r = 0; r < 4; ++r) { const int row = row0 + g4 + r; const float lf = log_sigmoid_f(acc[r] * rstd_of(SSQ(0)[row]) + bf);
                    if (row < NP) C.out[O_PLF + (size_t)row * HB + n] = lf; else C.out[O_SLF + (size_t)(row - NP) * HB + n] = lf; } }
            __syncthreads();
        }
        pg8::Gemm g{Yb, (const bf16_t*)(C.ws + WS_WABIN), MP, AB_N, D}; SplitOrder S; S.init(AB_N, D, 6, C.G, bid);
        EpiAbIn E{PROJ, C.out, SLAB, SSQ(0)};
        pg8::gemm_phase<EpiAbIn, SplitOrder, true, true>(lds, g, S, E);
    }
    xcd_barrier(bar);
    PHASE_BEGIN();
    combine_inproj<true>(C, SLAB, PROJ, SSQ(0));
    xcd_barrier(bar);

    PHASE_BEGIN();
    {
        for (int u = bid; u < 256; u += C.G) {
            const int bh = u >> 3, s = u & 7, b = bh >> 4, h = bh & 15;
            attn_prepare_ck<false>(C, lds, b, h);
            attn_qblock<false>(C, lds, PROJ, MIX, b, h, s);
            attn_qblock<false>(C, lds, PROJ, MIX, b, h, 15 - s);
            __syncthreads();
        }
        TS(21);
        PHASE_BEGIN();
        for (int u = bid; u < DEC_B * HB; u += C.G) {
            const int b = u >> 4, h = u & 15;
            attn_prepare_ck<true>(C, lds, b, h);
            attn_qblock<true>(C, lds, PROJ, MIX, b, h, 0);
            __syncthreads();
        }
        TS(22);
        PHASE_BEGIN();
        if (C.G == 256) {
            if (bid < 128) gmlp_unit(C, lds, PROJ, MIX, (bid >> 3) * 128, 128, bid & 7);
            else { for (int i = 0; i < 3; ++i) { const int u = 128 + 3 * (bid - 128) + i; gmlp_unit(C, lds, PROJ, MIX, (u >> 3) * 128, 128, u & 7); }
                if (bid >= 192) { const int u = bid - 192; gmlp_unit(C, lds, PROJ, MIX, NP + (u >> 3) * DEC_S, DEC_S, u & 7); } }
        } else {
            for (int u = bid; u < 512 + 64; u += C.G) {
                if (u < 512) gmlp_unit(C, lds, PROJ, MIX, (u >> 3) * 128, 128, u & 7);
                else gmlp_unit(C, lds, PROJ, MIX, NP + ((u - 512) >> 3) * DEC_S, DEC_S, (u - 512) & 7);
            }
        }
    }
    xcd_barrier(bar);

    PHASE_BEGIN();
    {
        pg8::Gemm g{MIX, (const bf16_t*)(C.ws + WS_WABOUT), MP, D, D}; SplitOrder S; S.init(D, D, 16, C.G, bid);
        EpiResid E{Yb, SLAB, SSQ(1)};
        pg8::gemm_phase<EpiResid, SplitOrder, true, true>(lds, g, S, E);
    }
    xcd_barrier(bar);
    PHASE_BEGIN();
    for (int r = bid; r < NS; r += C.G) sample_row_wg<false>(C, lds, SLAB, r, C.in[I_XS] + (size_t)r * D, Yb + (size_t)(NP + r) * D, SSQ(1) + NP + r, nullptr, nullptr);
    xcd_barrier(bar);
    PHASE_BEGIN();
    {
        pg8::Gemm g{Yb, (const bf16_t*)(C.ws + WS_WGU0), MP, 2 * DFF, D}; SplitOrder S; S.init(2 * DFF, D, 3, C.G, bid);
        EpiSwiGLU E{Gb, SLAB, SSQ(1)};
        pg8::gemm_phase<EpiSwiGLU, SplitOrder, true, true>(lds, g, S, E);
    }
    xcd_barrier(bar);
    PHASE_BEGIN();
    combine_swiglu(C, SLAB, Gb, SSQ(1));
    xcd_barrier(bar);
    PHASE_BEGIN();
    {
        pg8::Gemm g{Gb, (const bf16_t*)(C.ws + WS_WDN0), MP, D, DFF}; SplitOrder S; S.init(D, DFF, 16, C.G, bid);
        EpiResid E{Yb, SLAB, SSQ(2)};
        pg8::gemm_phase<EpiResid, SplitOrder, true, true>(lds, g, S, E);
    }
    xcd_barrier(bar);
    PHASE_BEGIN();
    for (int r = bid; r < NS; r += C.G) sample_row_wg<false>(C, lds, SLAB, r, nullptr, Yb + (size_t)(NP + r) * D, SSQ(2) + NP + r, nullptr, nullptr);
    xcd_barrier(bar);
    PHASE_BEGIN();
    {
        const bf16_t* Wif = (const bf16_t*)(C.ws + WS_WCIF);
        for (int t = bid; t < M / 16; t += C.G) {
            const int row0 = 16 * t; const f32x4 part = gate_tile_part(Yb, Wif, row0, 512 * C.wave, C.lane);
            ((LAS f32x4*)lds)[C.wave * 64 + C.lane] = part;
            __syncthreads();
            if (C.wave == 0) { f32x4 acc = ((LAS f32x4*)lds)[C.lane];
#pragma unroll
                for (int w = 1; w < 8; ++w) acc = acc + ((LAS f32x4*)lds)[w * 64 + C.lane];
                const int n = C.lane & 15, g4 = 4 * (C.lane >> 4); const float bb = n < 8 ? C.in[I_CBI][n] : C.in[I_CBF][n - 8];
#pragma unroll
                for (int r = 0; r < 4; ++r) { const float z = acc[r] * rstd_of(SSQ(2)[row0 + g4 + r]) + bb; GATES[(size_t)(row0 + g4 + r) * 16 + n] = n < 8 ? z : log_sigmoid_f(z); } }
            __syncthreads();
        }
        pg8::Gemm g{Yb, (const bf16_t*)(C.ws + WS_WCIN), MP, C_N, D}; SplitOrder S; S.init(C_N, D, 5, C.G, bid);
        EpiBf16Plain E{PROJ, C_N, SLAB, SSQ(2)};
        pg8::gemm_phase<EpiBf16Plain, SplitOrder, true, true>(lds, g, S, E);
    }
    xcd_barrier(bar);
    PHASE_BEGIN();
    combine_inproj<false>(C, SLAB, PROJ, SSQ(2));
    for (int u = bid; u < BATCH * HC * 64; u += C.G) mlstm_prepass(C, PROJ, GATES, (f32x4*)(C.ws + WS_GS), (bf16x8*)(C.ws + WS_PB), u >> 6, u & 63);
    xcd_barrier(bar);
    PHASE_BEGIN();
    {
        for (int u = bid; u < BATCH * HC * 16; u += C.G) mlstm_unit<false>(C, lds, PROJ, GATES, HS, u >> 7, (u >> 4) & 7, u & 15, (const f32x4*)(C.ws + WS_GS), (const bf16x8*)(C.ws + WS_PB));
        TS(23);
        PHASE_BEGIN();
        for (int u = bid; u < DEC_B * HC * 16; u += C.G) mlstm_unit<true>(C, lds, PROJ, GATES, HS, u >> 7, (u >> 4) & 7, u & 15, nullptr, nullptr);
    }
    xcd_barrier(bar);
    PHASE_BEGIN();
    for (int m = C.gw; m < M; m += C.ngw) mlstm_headnorm_row(HS + (size_t)m * D, PROJ + (size_t)m * C_N + 8192, C.in[I_CHN], MIX + (size_t)m * D, C.lane);
    xcd_barrier(bar);
    PHASE_BEGIN();
    {
        pg8::Gemm g{MIX, (const bf16_t*)(C.ws + WS_WCOUT), MP, D, D}; SplitOrder S; S.init(D, D, 16, C.G, bid);
        EpiResid E{Yb, SLAB, SSQ(3)};
        pg8::gemm_phase<EpiResid, SplitOrder, true, true>(lds, g, S, E);
    }
    xcd_barrier(bar);
    PHASE_BEGIN();
    for (int r = bid; r < NS; r += C.G) sample_row_wg<false>(C, lds, SLAB, r, nullptr, Yb + (size_t)(NP + r) * D, SSQ(3) + NP + r, nullptr, nullptr);
    xcd_barrier(bar);
    PHASE_BEGIN();
    {
        pg8::Gemm g{Yb, (const bf16_t*)(C.ws + WS_WGU1), MP, 2 * DFF, D}; SplitOrder S; S.init(2 * DFF, D, 3, C.G, bid);
        EpiSwiGLU E{Gb, SLAB, SSQ(3)};
        pg8::gemm_phase<EpiSwiGLU, SplitOrder, true, true>(lds, g, S, E);
    }
    xcd_barrier(bar);
    PHASE_BEGIN();
    combine_swiglu(C, SLAB, Gb, SSQ(3));
    xcd_barrier(bar);
    PHASE_BEGIN();
    {
        pg8::Gemm g{Gb, (const bf16_t*)(C.ws + WS_WDN1), MP, D, DFF}; SplitOrder S; S.init(D, DFF, 16, C.G, bid);
        EpiResid E{Yb, SLAB, SSQ(4)};
        pg8::gemm_phase<EpiResid, SplitOrder, true, true>(lds, g, S, E);
    }
    xcd_barrier(bar);
    PHASE_BEGIN();
    for (int m = C.gw; m < NP; m += C.ngw) final_row(Yb + (size_t)m * D, rstd_of(SSQ(4)[m]), C.in[I_NFIN], C.out + O_YP + (size_t)m * D, C.lane);
    for (int r = bid; r < NS; r += C.G) sample_row_wg<true>(C, lds, SLAB, r, nullptr, Yb + (size_t)(NP + r) * D, nullptr, C.in[I_NFIN], C.out + O_YS + (size_t)r * D);
}

#undef Yb
#undef SSQ
#undef PROJ
#undef MIX
#undef Gb
#undef HS
#undef GATES
#undef SLAB
extern "C" void kernel_launch(void* const* d_in, const int* in_sizes, int n_in, void* d_out, int out_size, void* d_ws, size_t ws_size, hipStream_t stream) {
    static int grid = 0;
    if (grid == 0) {
        if (n_in != P::N_IN || (size_t)out_size != P::O_END || ws_size < P::WS_END) { fprintf(stderr, "kernel_launch: unexpected shapes: n_in %d out %d ws %zu\n", n_in, out_size, ws_size); grid = -1; return; }
        int dev = 0, cus = 0, per_cu = 0;
        if (hipGetDevice(&dev) != hipSuccess || hipDeviceGetAttribute(&cus, hipDeviceAttributeMultiprocessorCount, dev) != hipSuccess) { grid = -1; return; }
        if (hipFuncSetAttribute((const void*)fwd, hipFuncAttributeMaxDynamicSharedMemorySize, P::LDS_BYTES) != hipSuccess) { fprintf(stderr, "kernel_launch: hipFuncSetAttribute failed\n"); grid = -1; return; }
        if (hipOccupancyMaxActiveBlocksPerMultiprocessor(&per_cu, (const void*)fwd, 512, P::LDS_BYTES) != hipSuccess || per_cu < 1) fprintf(stderr, "kernel_launch: occupancy query reports %d per CU\n", per_cu);
        (void)hipGetLastError();
        grid = cus;
    }
    if (grid < 0) return;
    if (hipMemsetAsync((char*)d_ws + P::WS_CTL, 0, P::CTL_ZERO_BYTES, stream) != hipSuccess) return;
    Args a{};
    for (int i = 0; i < P::N_IN; ++i) a.in[i] = (const float*)d_in[i];
    a.out = (float*)d_out; a.ws = (unsigned char*)d_ws;
    hipLaunchKernelGGL(fwd, dim3(grid), dim3(512), P::LDS_BYTES, stream, a);
}
```

```cpp
#include <hip/hip_runtime.h>
#include <cstdio>
#include <cstdint>
namespace pg8 {
#define PG8_LAS __attribute__((address_space(3)))
typedef unsigned short bf16_t;
typedef short bf16x8 __attribute__((ext_vector_type(8)));
typedef float f32x4 __attribute__((ext_vector_type(4)));
typedef unsigned u32x4 __attribute__((ext_vector_type(4)));
constexpr int BM = 256, BK = 64, HALF = 128, HTB = HALF * BK * 2  , STAGE_BYTES = 8 * HTB, NXCD = 8, WGM = 8;

__host__ __device__ __forceinline__ int lds_byte(int r, int c) { const int st = (r >> 4) * 2 + (c >> 5), rr = r & 15, cc = c & 31, ob = rr * 64 + cc * 2; return st * 1024 + (ob ^ (((ob >> 9) & 1) << 5)); }
__host__ __device__ __forceinline__ void stage_rc(int b, int& R, int& C) { const int st = b / 1024, sb = b % 1024, swz = sb ^ (((sb >> 9) & 1) << 5); R = (st >> 1) * 16 + swz / 64; C = (st & 1) * 32 + (swz % 64) / 2; }
__host__ __device__ __forceinline__ int perm32(int rho) { const int n = rho >> 4, i = rho & 15; return 8 * (i >> 2) + 4 * n + (i & 3); }

struct Unit { int pm, pn, kt0, nkt, slab; };
struct Gemm { const bf16_t* A; const bf16_t* Bt; int M, N, K; };

struct StaticOrder {
    int nM, nN, nwg, G, c, ktiles;
    __host__ __device__ void init(int M, int N, int K, int G_, int c_) { nM = M / BM; nN = N / BM; nwg = nM * nN; G = G_; c = c_; ktiles = K / BK; }
    __host__ __device__ bool next(int i, Unit& u) const {
        const long L = (long)i * G + c; if (L >= nwg) return false;
        int wgid = (int)L; { const int q = nwg / NXCD, r = nwg % NXCD, xcd = wgid % NXCD, off = wgid / NXCD; wgid = (xcd < r ? xcd * (q + 1) : r * (q + 1) + (xcd - r) * q) + off; }
        const int nig = WGM * nN, gid = wgid / nig, fm = gid * WGM, gsz = (nM - fm) < WGM ? (nM - fm) : WGM;
        u.pm = fm + ((wgid % nig) % gsz); u.pn = (wgid % nig) / gsz; u.kt0 = 0; u.nkt = ktiles; u.slab = -1; return true;
    }
    __device__ __forceinline__ void a_ready(const Unit&) const {}
    __device__ __forceinline__ void done(const Unit&) const {}
};

__device__ __forceinline__ unsigned cvt_pk_bf16(float lo, float hi) { unsigned r; asm volatile("v_cvt_pk_bf16_f32 %0, %1, %2" : "=v"(r) : "v"(lo), "v"(hi)); return r; }
typedef float f32x2 __attribute__((ext_vector_type(2)));
template <class Epi, class Sched, bool ALIGN_EPI = false, bool SP2 = false>
__device__ __forceinline__ void gemm_phase(PG8_LAS unsigned char* lds, const Gemm g, const Sched& S, const Epi& E) {
    int tid_ = threadIdx.x; asm volatile("" : "+v"(tid_));
    const int tid = tid_, wid = __builtin_amdgcn_readfirstlane(tid >> 6), lane = tid & 63, wr = wid >> 2, wc = wid & 3, fr = lane & 15, fq = lane >> 4;
    const int K = g.K;
    unsigned voffA[2], voffB[2];
#pragma unroll
    for (int i = 0; i < 2; ++i) { int R, C; stage_rc(tid * 16 + i * 8192, R, C); voffA[i] = (unsigned)(R * K + C) * 2u;
        const int Rl = (wid & 1) * 64 + lane, Rb = Epi::PERM ? ((Rl & ~31) + perm32(Rl & 31)) : Rl; voffB[i] = (unsigned)(((wid >> 1) + 4 * i) * 256 + Rb) * 16u; }
    const size_t kstep = (size_t)(BK * 2);
    const size_t hstep = (size_t)HALF * K * 2;
    const size_t tstep = 2 * hstep;
    const size_t kstepB = 32768, hstepB = 2048, tstepB = (size_t)K * 512;
    const unsigned ldsw = (unsigned)wid * 1024u;
    const int aoff = lds_byte(wr * 64 + fr, fq * 8), boff = fq * 2048 + wc * 512 + fr * 16;
#define PG8_SA(b, h) (((b) * 2 + (h)) * HTB)
#define PG8_SB(b, h) ((4 + (b) * 2 + (h)) * HTB)
#define PG8_STAGE(bufoff, gbase, voff) do { _Pragma("unroll") for (int _i = 0; _i < 2; ++_i) \
        __builtin_amdgcn_global_load_lds((const unsigned*)((const char*)(gbase) + (voff)[_i]), (PG8_LAS unsigned*)(lds + (bufoff) + ldsw + _i * 8192), 16, 0, 0); } while (0)
#define PG8_LDA(dst, b, h) do { _Pragma("unroll") for (int m = 0; m < 4; ++m) _Pragma("unroll") for (int k = 0; k < 2; ++k) dst[m][k] = *(const PG8_LAS bf16x8*)(lds + PG8_SA(b, h) + aoff + m * 2048 + k * 1024); } while (0)
#define PG8_LDB(dst, b, h) do { _Pragma("unroll") for (int n = 0; n < 2; ++n) _Pragma("unroll") for (int k = 0; k < 2; ++k) dst[n][k] = *(const PG8_LAS bf16x8*)(lds + PG8_SB(b, h) + boff + n * 256 + k * 8192); } while (0)
#define PG8_MMA(ai, bj, At, Bt) do { __builtin_amdgcn_s_setprio(1); _Pragma("unroll") for (int m = 0; m < 4; ++m) _Pragma("unroll") for (int n = 0; n < 2; ++n) _Pragma("unroll") for (int k = 0; k < 2; ++k) \
        acc[ai][bj][m][n] = __builtin_amdgcn_mfma_f32_16x16x32_bf16(Bt[n][k], At[m][k], acc[ai][bj][m][n], 0, 0, 0); __builtin_amdgcn_s_setprio(0); } while (0)
#define PG8_WAIT_V(n) asm volatile("s_waitcnt vmcnt(" #n ")" ::: "memory")
#define PG8_WAIT_L(n) asm volatile("s_waitcnt lgkmcnt(" #n ")" ::: "memory")
#define PG8_BAR __builtin_amdgcn_s_barrier()
#define PG8_SCHED __builtin_amdgcn_sched_barrier(0)
    Unit cur, nxt; int ui = 0;
    if (!S.next(0, cur)) return;
    f32x4 acc[2][2][4][2];
#pragma unroll
    for (int a = 0; a < 2; ++a)
#pragma unroll
        for (int b = 0; b < 2; ++b)
#pragma unroll
            for (int m = 0; m < 4; ++m)
#pragma unroll
                for (int n = 0; n < 2; ++n) acc[a][b][m][n] = (f32x4){0.f, 0.f, 0.f, 0.f};
    bf16x8 At[4][2], B0[2][2], B1[2][2];
    float rs8[8];
    const char* cA = (const char*)g.A + (size_t)cur.pm * tstep + (size_t)cur.kt0 * kstep; const char* cB = (const char*)g.Bt + (size_t)cur.pn * tstepB + (size_t)cur.kt0 * kstepB; int nt = cur.nkt;
    S.a_ready(cur); E.load_rs(cur, wr, fr, rs8);
    if constexpr (SP2) {
        PG8_STAGE(PG8_SB(0, 0), cB, voffB); PG8_STAGE(PG8_SB(0, 1), cB + hstepB, voffB); PG8_STAGE(PG8_SA(0, 0), cA, voffA); PG8_STAGE(PG8_SA(0, 1), cA + hstep, voffA);
        if (wr == 1) PG8_BAR;
        PG8_WAIT_V(2); PG8_BAR;
        PG8_STAGE(PG8_SB(1, 0), cB + kstepB, voffB); PG8_STAGE(PG8_SA(1, 0), cA + kstep, voffA); PG8_STAGE(PG8_SB(1, 1), cB + hstepB + kstepB, voffB);
        PG8_WAIT_V(6); PG8_BAR;
    } else {
        PG8_STAGE(PG8_SB(0, 0), cB, voffB); PG8_STAGE(PG8_SA(0, 0), cA, voffA); PG8_STAGE(PG8_SB(0, 1), cB + hstepB, voffB); PG8_STAGE(PG8_SA(0, 1), cA + hstep, voffA);
        if (wr == 1) PG8_BAR;
        PG8_WAIT_V(4); PG8_BAR;
        PG8_STAGE(PG8_SB(1, 0), cB + kstepB, voffB); PG8_STAGE(PG8_SA(1, 0), cA + kstep, voffA); PG8_STAGE(PG8_SB(1, 1), cB + hstepB + kstepB, voffB);
        PG8_WAIT_V(6); PG8_BAR;
    }
    for (;;) {
        const bool has_next = S.next(ui + 1, nxt);
        const char* nA = has_next ? (const char*)g.A + (size_t)nxt.pm * tstep + (size_t)nxt.kt0 * kstep : cA; const char* nB = has_next ? (const char*)g.Bt + (size_t)nxt.pn * tstepB + (size_t)nxt.kt0 * kstepB : cB;
        if constexpr (SP2) {
        if (cur.slab >= 0) {
        for (int t = 0; t < nt; t += 2) {
            const bool last = (t == nt - 2);
            const char* a1 = cA + (size_t)(t + 1) * kstep;
            const char* a2 = last ? nA : cA + (size_t)(t + 2) * kstep; const char* b2 = last ? nB : cB + (size_t)(t + 2) * kstepB;
            const char* a3 = a2 + kstep; const char* b3 = b2 + kstepB;
            if (last && has_next) S.a_ready(nxt);
            PG8_LDB(B0, 0, 0); PG8_LDB(B1, 0, 1); PG8_SCHED; PG8_LDA(At, 0, 0); PG8_STAGE(PG8_SA(1, 1), a1 + hstep, voffA);
            PG8_WAIT_V(8); PG8_WAIT_L(0); PG8_BAR; PG8_MMA(0, 0, At, B0); PG8_MMA(0, 1, At, B1); PG8_BAR; PG8_SCHED;
            PG8_STAGE(PG8_SB(0, 0), b2, voffB); PG8_STAGE(PG8_SB(0, 1), b2 + hstepB, voffB); PG8_STAGE(PG8_SA(0, 0), a2, voffA);
            PG8_WAIT_V(8); PG8_WAIT_L(0); PG8_BAR; PG8_BAR; PG8_SCHED;
            PG8_LDB(B0, 1, 0); PG8_LDB(B1, 1, 1); PG8_SCHED; PG8_LDA(At, 1, 0); PG8_STAGE(PG8_SA(0, 1), a2 + hstep, voffA);
            PG8_WAIT_V(8); PG8_WAIT_L(0); PG8_BAR; PG8_MMA(0, 0, At, B0); PG8_MMA(0, 1, At, B1); PG8_BAR; PG8_SCHED;
            PG8_STAGE(PG8_SB(1, 0), b3, voffB); PG8_STAGE(PG8_SB(1, 1), b3 + hstepB, voffB); PG8_STAGE(PG8_SA(1, 0), a3, voffA);
            PG8_WAIT_V(8); PG8_WAIT_L(0); PG8_BAR; PG8_BAR; PG8_SCHED;
        }
        } else {
        for (int t = 0; t < nt; t += 2) {
            const bool last = (t == nt - 2);
            const char* a1 = cA + (size_t)(t + 1) * kstep;
            const char* a2 = last ? nA : cA + (size_t)(t + 2) * kstep; const char* b2 = last ? nB : cB + (size_t)(t + 2) * kstepB;
            const char* a3 = a2 + kstep; const char* b3 = b2 + kstepB;
            if (last && has_next) S.a_ready(nxt);
            PG8_LDB(B0, 0, 0); PG8_LDB(B1, 0, 1); PG8_SCHED; PG8_LDA(At, 0, 0); PG8_STAGE(PG8_SA(1, 1), a1 + hstep, voffA);
            PG8_WAIT_V(8); PG8_WAIT_L(0); PG8_BAR; PG8_MMA(0, 0, At, B0); PG8_MMA(0, 1, At, B1); PG8_BAR; PG8_SCHED;
            PG8_LDA(At, 0, 1); PG8_STAGE(PG8_SB(0, 0), b2, voffB); PG8_STAGE(PG8_SB(0, 1), b2 + hstepB, voffB); PG8_STAGE(PG8_SA(0, 0), a2, voffA);
            PG8_WAIT_V(8); PG8_WAIT_L(0); PG8_BAR; PG8_MMA(1, 0, At, B0); PG8_MMA(1, 1, At, B1); PG8_BAR; PG8_SCHED;
            PG8_LDB(B0, 1, 0); PG8_LDB(B1, 1, 1); PG8_SCHED; PG8_LDA(At, 1, 0); PG8_STAGE(PG8_SA(0, 1), a2 + hstep, voffA);
            PG8_WAIT_V(8); PG8_WAIT_L(0); PG8_BAR; PG8_MMA(0, 0, At, B0); PG8_MMA(0, 1, At, B1); PG8_BAR; PG8_SCHED;
            PG8_LDA(At, 1, 1); PG8_STAGE(PG8_SB(1, 0), b3, voffB); PG8_STAGE(PG8_SB(1, 1), b3 + hstepB, voffB); PG8_STAGE(PG8_SA(1, 0), a3, voffA);
            PG8_WAIT_V(8); PG8_WAIT_L(0); PG8_BAR; PG8_MMA(1, 0, At, B0); PG8_MMA(1, 1, At, B1); PG8_BAR; PG8_SCHED;
        }
        }
        } else {
        for (int t = 0; t < nt; t += 2) {
            const bool last = (t == nt - 2);
            const char* a1 = cA + (size_t)(t + 1) * kstep;
            const char* a2 = last ? nA : cA + (size_t)(t + 2) * kstep; const char* b2 = last ? nB : cB + (size_t)(t + 2) * kstepB;
            const char* a3 = a2 + kstep; const char* b3 = b2 + kstepB;
            if (last && has_next) S.a_ready(nxt);
            PG8_LDB(B0, 0, 0); PG8_SCHED; PG8_LDA(At, 0, 0); PG8_STAGE(PG8_SA(1, 1), a1 + hstep, voffA);
            PG8_WAIT_L(8); PG8_BAR; PG8_WAIT_L(0); PG8_MMA(0, 0, At, B0); PG8_BAR; PG8_SCHED;
            PG8_LDB(B1, 0, 1); PG8_STAGE(PG8_SB(0, 0), b2, voffB);
            PG8_BAR; PG8_WAIT_L(0); PG8_MMA(0, 1, At, B1); PG8_BAR;
            PG8_LDA(At, 0, 1); PG8_STAGE(PG8_SA(0, 0), a2, voffA);
            PG8_BAR; PG8_WAIT_L(0); PG8_MMA(1, 0, At, B0); PG8_BAR; PG8_SCHED;
            PG8_STAGE(PG8_SB(0, 1), b2 + hstepB, voffB);
            PG8_WAIT_V(6); PG8_BAR; PG8_MMA(1, 1, At, B1); PG8_BAR;
            PG8_LDB(B0, 1, 0); PG8_SCHED; PG8_LDA(At, 1, 0); PG8_STAGE(PG8_SA(0, 1), a2 + hstep, voffA);
            PG8_WAIT_L(8); PG8_BAR; PG8_WAIT_L(0); PG8_MMA(0, 0, At, B0); PG8_BAR; PG8_SCHED;
            PG8_LDB(B1, 1, 1); PG8_STAGE(PG8_SB(1, 0), b3, voffB);
            PG8_BAR; PG8_WAIT_L(0); PG8_MMA(0, 1, At, B1); PG8_BAR;
            PG8_LDA(At, 1, 1); PG8_STAGE(PG8_SA(1, 0), a3, voffA);
            PG8_BAR; PG8_WAIT_L(0); PG8_MMA(1, 0, At, B0); PG8_BAR; PG8_SCHED;
            PG8_STAGE(PG8_SB(1, 1), b3 + hstepB, voffB);
            PG8_WAIT_V(6); PG8_BAR; PG8_MMA(1, 1, At, B1); PG8_BAR;
        }
        }
        if constexpr (ALIGN_EPI) { if (wr == 0) PG8_BAR; }
        if constexpr (!Epi::AFTER_DRAIN) { E(acc, cur, wr, wc, fr, fq, rs8); S.done(cur); }
        if (!has_next) break;
#pragma unroll
        for (int a = 0; a < 2; ++a)
#pragma unroll
            for (int b = 0; b < 2; ++b)
#pragma unroll
                for (int m = 0; m < 4; ++m)
#pragma unroll
                    for (int n = 0; n < 2; ++n) acc[a][b][m][n] = (f32x4){0.f, 0.f, 0.f, 0.f};
        cur = nxt; cA = nA; cB = nB; nt = cur.nkt; ++ui; E.load_rs(cur, wr, fr, rs8);
        if constexpr (ALIGN_EPI) { if (wr == 1) PG8_BAR; }
    }
    PG8_WAIT_V(0);
    if constexpr (!ALIGN_EPI) { if (wr == 0) PG8_BAR; }
    PG8_BAR;
    if constexpr (Epi::AFTER_DRAIN) { E.fused(acc, cur, wr, wc, fr, fq, lds, wid, lane); S.done(cur); }
#undef PG8_SA
#undef PG8_SB
#undef PG8_STAGE
#undef PG8_LDA
#undef PG8_LDB
#undef PG8_MMA
#undef PG8_WAIT_V
#undef PG8_WAIT_L
#undef PG8_BAR
#undef PG8_SCHED
}
}
#define LAS __attribute__((address_space(3)))
#define XB_TMO      128
#define XB_XCNT(j)  (256  + 64 * (j))
#define XB_XSUB(j)  (1280 + 64 * (j))
#define XB_XGEN(j)  (2304 + 64 * (j))
#define XB_TOP      3328
#define XB_TOPGEN   3392
#define XCD_BAR_WORDS 3456
#define XB_SPIN_CAP (1u << 21)

__device__ __forceinline__ unsigned xb_ld(unsigned* p)              { return __hip_atomic_load(p, __ATOMIC_RELAXED, __HIP_MEMORY_SCOPE_AGENT); }
__device__ __forceinline__ unsigned xb_add(unsigned* p, unsigned v) { return __hip_atomic_fetch_add(p, v, __ATOMIC_RELAXED, __HIP_MEMORY_SCOPE_AGENT); }
__device__ __forceinline__ unsigned xb_xcc_id() { return (unsigned)__builtin_amdgcn_s_getreg((3 << 11) | 20) & 0xFu; }
#define XB_SPIN(cond, bar) do { unsigned _sp = 0; while (cond) { __builtin_amdgcn_s_sleep(1); \
    if ((++_sp & 255u) == 0u) { if (xb_ld(&(bar)[XB_TMO])) break; if (_sp > XB_SPIN_CAP) { atomicAdd(&(bar)[XB_TMO], 1u); break; } } } } while (0)

struct XcdBarrier {
    unsigned* bar; unsigned x;
    volatile LAS unsigned* st;
};

__device__ __forceinline__ XcdBarrier xcd_barrier_post(unsigned* bar, volatile LAS unsigned* st) {
    XcdBarrier b; b.bar = bar; b.x = xb_xcc_id(); b.st = st;
    if (threadIdx.x == 0) (void)xb_add(&bar[XB_XCNT(b.x)], 1u);
    return b;
}
__device__ __forceinline__ void xcd_barrier_complete(unsigned* bar, unsigned x, unsigned& nloc, unsigned& nx) {
    const unsigned G = gridDim.x * gridDim.y * gridDim.z;
    unsigned sum, cnt, mine, sp = 0u;
    for (;;) {
        sum = 0u; cnt = 0u; mine = 0u;
#pragma unroll
        for (unsigned j = 0; j < 16; ++j) { const unsigned c = xb_ld(&bar[XB_XCNT(j)]); sum += c; cnt += (c > 0u) ? 1u : 0u; mine = (j == x) ? c : mine; }
        if (sum == G) break;
        __builtin_amdgcn_s_sleep(1);
        if ((++sp & 255u) == 0u) { if (xb_ld(&bar[XB_TMO])) break; if (sp > XB_SPIN_CAP) { atomicAdd(&bar[XB_TMO], 1u); break; } }
    }
    nloc = mine > 0u ? mine : 1u; nx = cnt > 0u ? cnt : 1u;
}

__device__ __forceinline__ void xcd_barrier(const XcdBarrier& b) {
    asm volatile("s_waitcnt vmcnt(0)" ::: "memory");
    __syncthreads();
    if (threadIdx.x == 0) {
        unsigned* bar = b.bar;
        __builtin_amdgcn_s_waitcnt(0);
        unsigned nloc = b.st[0], nx = b.st[1];
        if (nloc == 0u) { xcd_barrier_complete(bar, b.x, nloc, nx); b.st[0] = nloc; b.st[1] = nx; }
        const unsigned old = xb_add(&bar[XB_XSUB(b.x)], 1u);
        const unsigned gen = old / nloc;
        if (old + 1u == (gen + 1u) * nloc) {
            __builtin_amdgcn_fence(__ATOMIC_RELEASE, "agent");
            asm volatile("s_waitcnt vmcnt(0)" ::: "memory");
            const unsigned og = xb_add(&bar[XB_TOP], 1u);
            const unsigned tg = og / nx;
            if (og + 1u == (tg + 1u) * nx) xb_add(&bar[XB_TOPGEN], 1u);
            else XB_SPIN(xb_ld(&bar[XB_TOPGEN]) == tg, bar);
            __builtin_amdgcn_fence(__ATOMIC_ACQUIRE, "agent");
            xb_add(&bar[XB_XGEN(b.x)], 1u);
            asm volatile("s_waitcnt vmcnt(0)" ::: "memory");
        } else {
            XB_SPIN(xb_ld(&bar[XB_XGEN(b.x)]) == gen, bar);
            __builtin_amdgcn_fence(__ATOMIC_ACQUIRE, "agent");
            asm volatile("s_waitcnt vmcnt(0)" ::: "memory");
        }
    }
    __syncthreads();
}

namespace P {
constexpr int D = 4096, SEQ = 4096, BATCH = 2, DEC_B = 8, DEC_S = 16, PAST = 1024;
constexpr int NP = BATCH * SEQ;
constexpr int NS = DEC_B * DEC_S;
constexpr int M = NP + NS;
constexpr int MP = 8448;
constexpr int DA = 2048, DB = 2048, HB = 16, DHB = 128;
constexpr int AB_LD = 10256, AB_N = 10240;
constexpr int HC = 8, DKC = 256, DVC = 512;
constexpr int C_LD = 12304, C_N = 12288;
constexpr int DFF = 11008;
constexpr float EPS = 1e-6f;
constexpr size_t O_YP = 0;
constexpr size_t O_YS = O_YP + (size_t)NP * D;
constexpr size_t O_PK = O_YS + (size_t)NS * D;
constexpr size_t O_PV = O_PK + (size_t)NP * DB;
constexpr size_t O_PLF = O_PV + (size_t)NP * DB;
constexpr size_t O_PC = O_PLF + (size_t)NP * HB;
constexpr size_t O_PN = O_PC + (size_t)BATCH * HC * DKC * DVC;
constexpr size_t O_PM = O_PN + (size_t)BATCH * HC * DKC;
constexpr size_t O_SK = O_PM + (size_t)BATCH * HC;
constexpr size_t O_SV = O_SK + (size_t)NS * DB;
constexpr size_t O_SLF = O_SV + (size_t)NS * DB;
constexpr size_t O_SGV = O_SLF + (size_t)NS * HB;
constexpr size_t O_SC = O_SGV + (size_t)NS * DA;
constexpr size_t O_SN = O_SC + (size_t)DEC_B * HC * DKC * DVC;
constexpr size_t O_SM = O_SN + (size_t)DEC_B * HC * DKC;
constexpr size_t O_END = O_SM + (size_t)DEC_B * HC;
enum { I_XP = 0, I_XS, I_CK, I_CV, I_CLF, I_SC, I_SN, I_SM, I_NMIX, I_NFFN, I_NFIN, I_ABWIN, I_ABWOUT, I_GWS, I_GB, I_FBF, I_CWIN, I_CBI, I_CBF, I_CHN, I_CWOUT, I_FG, I_FU, I_FD, N_IN };
constexpr size_t MiB = 1u << 20;
constexpr size_t WS_CTL = 0, CTL_ZERO_BYTES = 1 * MiB;
constexpr size_t WS_WABIN = 1 * MiB;
constexpr size_t WS_WABF = 81 * MiB;
constexpr size_t WS_WABOUT = 82 * MiB;
constexpr size_t WS_WCIN = 114 * MiB;
constexpr size_t WS_WCIF = 210 * MiB;
constexpr size_t WS_WCOUT = 211 * MiB;
constexpr size_t WS_WGU0 = 243 * MiB;
constexpr size_t WS_WGU1 = 415 * MiB;
constexpr size_t WS_WDN0 = 587 * MiB;
constexpr size_t WS_WDN1 = 673 * MiB;
constexpr size_t WS_H = 759 * MiB;
constexpr size_t WS_Y = 825 * MiB;
constexpr size_t WS_PROJ = 957 * MiB;
constexpr size_t WS_MIX = 1155 * MiB;
constexpr size_t WS_G = 1221 * MiB;
constexpr size_t WS_GATES = 1400 * MiB;
constexpr size_t WS_SLAB = 1401 * MiB;
constexpr size_t WS_GS = 1435 * MiB;
constexpr size_t WS_PB = 1436 * MiB;
constexpr size_t WS_END = 1444 * MiB;
static_assert(WS_WABIN + (size_t)AB_N * D * 2 <= WS_WABF && WS_WCIN + (size_t)C_N * D * 2 <= WS_WCIF && WS_WGU0 + (size_t)2 * DFF * D * 2 <= WS_WGU1 && WS_WGU1 + (size_t)2 * DFF * D * 2 <= WS_WDN0, "ws map 1");
static_assert(WS_WDN0 + (size_t)DFF * D * 2 <= WS_WDN1 && WS_WDN1 + (size_t)DFF * D * 2 <= WS_H && WS_H + (size_t)MP * D * 2 <= WS_Y && WS_Y + (size_t)MP * D * 4 <= WS_PROJ, "ws map 2");
static_assert(WS_PROJ + (size_t)MP * C_N * 2 <= WS_MIX && WS_MIX + (size_t)MP * D * 2 <= WS_G && WS_G + (size_t)MP * DFF * 2 <= WS_END, "ws map 3");
constexpr int CW_BAR = 4096;
constexpr size_t CTL_SSQ = 524288;
constexpr int RING_BYTES = 131072, LDS_BYTES = 147456, MISC_OFF = LDS_BYTES - 256;
}

typedef unsigned short bf16_t;
typedef float f32x4 __attribute__((ext_vector_type(4)));
typedef short bf16x8 __attribute__((ext_vector_type(8)));
typedef unsigned u32x4 __attribute__((ext_vector_type(4)));
typedef unsigned u32x2 __attribute__((ext_vector_type(2)));
#define LDS_WAIT() asm volatile("s_waitcnt lgkmcnt(0)" ::: "memory")
#define VM_WAIT() asm volatile("s_waitcnt vmcnt(0)" ::: "memory")
using pg8::cvt_pk_bf16;

__device__ __forceinline__ float wave_sum(float v) {
#pragma unroll
    for (int o = 1; o < 64; o <<= 1) v += __shfl_xor(v, o);
    return v;
}
__device__ __forceinline__ float log_sigmoid_f(float z) { return fminf(z, 0.f) - log1pf(__expf(-fabsf(z))); }

__device__ __forceinline__ void transpose_item(const float* __restrict__ W, int ld, int K, int k0, int n0, int nvalid, bf16_t* __restrict__ WT, int drow0, LAS float* scr, int lane, const float* __restrict__ gain = nullptr) {
    const int nn = lane & 31, ncl = nn < nvalid ? nn : nvalid - 1;
    float wv[32];
#pragma unroll
    for (int i = 0; i < 32; ++i) wv[i] = W[(size_t)(k0 + 2 * i + (lane >> 5)) * ld + n0 + ncl];
#pragma unroll
    for (int i = 0; i < 32; ++i) scr[(2 * i + (lane >> 5)) * 33 + nn] = wv[i];
    LDS_WAIT();
    const int c = lane & 7;
    f32x4 g0 = {1.f, 1.f, 1.f, 1.f}, g1 = {1.f, 1.f, 1.f, 1.f};
    if (gain) { g0 = *(const f32x4*)(gain + k0 + 8 * c); g1 = *(const f32x4*)(gain + k0 + 8 * c + 4); }
#pragma unroll
    for (int j = 0; j < 4; ++j) { const int n = (lane >> 3) + 8 * j; const LAS float* s = scr + (8 * c) * 33 + n;
        u32x4 o; o.x = cvt_pk_bf16(s[0 * 33] * g0[0], s[1 * 33] * g0[1]); o.y = cvt_pk_bf16(s[2 * 33] * g0[2], s[3 * 33] * g0[3]); o.z = cvt_pk_bf16(s[4 * 33] * g1[0], s[5 * 33] * g1[1]); o.w = cvt_pk_bf16(s[6 * 33] * g1[2], s[7 * 33] * g1[3]);
        if (n < nvalid) *(u32x4*)(WT + (size_t)(drow0 + n) * K + k0 + 8 * c) = o; }
    LDS_WAIT();
}

struct Ctx {
    const float* const* in; float* out; unsigned char* ws;
    int tid, lane, wave, gw, ngw, G;
};


struct SplitOrder {
    pg8::StaticOrder Pm; int nfull, nmini, S, G, c, b, e;
    __device__ void init(int N, int K, int S_, int G_, int c_) { Pm.init(P::NP, N, K, G_, c_); nfull = Pm.nwg; S = S_; nmini = (N / 256) * S_; G = G_; c = c_;
        const int kt = K / 64; b = (kt / S_) & ~1; e = (kt - S_ * b) / 2; }
    __device__ bool next(int i, pg8::Unit& u) const {
        const int L = i * G + c;
        if (L < nfull) return Pm.next(i, u);
        const int j = L - nfull; if (j >= nmini) return false;
        const int pn = j / S, s = j - pn * S;
        u.pm = P::NP / 256; u.pn = pn; u.kt0 = s * b + 2 * (s < e ? s : e); u.nkt = b + (s < e ? 2 : 0); u.slab = j; return true;
    }
    __device__ __forceinline__ void a_ready(const pg8::Unit&) const {}
    __device__ __forceinline__ void done(const pg8::Unit&) const {}
};

template <int CW> struct CvVec;
template <> struct CvVec<4> { typedef f32x4 T; };
template <> struct CvVec<2> { typedef float T __attribute__((ext_vector_type(2))); };
template <> struct CvVec<1> { typedef float T; };
__device__ __forceinline__ float cv_el(const f32x4& v, int e) { return v[e]; }
__device__ __forceinline__ float cv_el(const CvVec<2>::T& v, int e) { return v[e]; }
__device__ __forceinline__ float cv_el(const float& v, int) { return v; }
template <int CW, int NBLK, int LD>
__device__ __forceinline__ void cv_load(const float* __restrict__ src, int r, int lane, typename CvVec<CW>::T (&v)[8]) {
    const int o = r / NBLK, nb = r - o * NBLK;
    const float* p = src + (size_t)(8 * o) * LD + 64 * CW * nb + CW * lane;
#pragma unroll
    for (int j = 0; j < 8; ++j) v[j] = *(const typename CvVec<CW>::T*)(p + (size_t)j * LD);
}
template <int CW, int NBLK, int KOCT, int MODE>
__device__ __forceinline__ void cv_store(bf16_t* __restrict__ dst, const float* __restrict__ gain, int r, int lane, const typename CvVec<CW>::T (&v)[8]) {
    const int o = r / NBLK, nb = r - o * NBLK;
    float g[8];
#pragma unroll
    for (int j = 0; j < 8; ++j) g[j] = gain ? gain[8 * o + j] : 1.0f;
    const int n = 64 * CW * nb + CW * lane, np = MODE == 0 ? n : 256 * (n >> 7) + (n & 127) + (MODE == 2 ? 128 : 0);
    u32x4* q = (u32x4*)(dst + (((size_t)(np >> 8) * KOCT + o) * 256 + (np & 255)) * 8);
#pragma unroll
    for (int e = 0; e < CW; ++e) { u32x4 w; w.x = cvt_pk_bf16(cv_el(v[0], e) * g[0], cv_el(v[1], e) * g[1]); w.y = cvt_pk_bf16(cv_el(v[2], e) * g[2], cv_el(v[3], e) * g[3]); w.z = cvt_pk_bf16(cv_el(v[4], e) * g[4], cv_el(v[5], e) * g[5]); w.w = cvt_pk_bf16(cv_el(v[6], e) * g[6], cv_el(v[7], e) * g[7]); q[e] = w; }
}
template <int CW, int JOB> struct CvJob {
    static constexpr int CB = 64 * CW;
    static constexpr int COUNT = JOB == 0 ? (P::D / 8) * (P::AB_N / CB) : JOB == 1 ? (P::D / 8) * (P::C_N / CB) : (JOB == 2 || JOB == 6) ? (P::D / 8) * (P::D / CB) : (JOB == 5 || JOB == 9) ? (P::DFF / 8) * (P::D / CB) : (P::D / 8) * (P::DFF / CB);
    static __device__ __forceinline__ void load(const Ctx& C, int r, typename CvVec<CW>::T (&v)[8]) {
        using namespace P;
        if (JOB == 0) cv_load<CW, AB_N / CB, AB_LD>(C.in[I_ABWIN], r, C.lane, v);
        else if (JOB == 1) cv_load<CW, C_N / CB, C_LD>(C.in[I_CWIN], r, C.lane, v);
        else if (JOB == 2) cv_load<CW, D / CB, D>(C.in[I_ABWOUT], r, C.lane, v);
        else if (JOB == 6) cv_load<CW, D / CB, D>(C.in[I_CWOUT], r, C.lane, v);
        else if (JOB == 3 || JOB == 7) cv_load<CW, DFF / CB, DFF>(C.in[I_FG] + (size_t)(JOB == 7) * D * DFF, r, C.lane, v);
        else if (JOB == 4 || JOB == 8) cv_load<CW, DFF / CB, DFF>(C.in[I_FU] + (size_t)(JOB == 8) * D * DFF, r, C.lane, v);
        else cv_load<CW, D / CB, D>(C.in[I_FD] + (size_t)(JOB == 9) * DFF * D, r, C.lane, v);
    }
    static __device__ __forceinline__ void store(const Ctx& C, int r, const typename CvVec<CW>::T (&v)[8]) {
        using namespace P; unsigned char* ws = C.ws;
        if (JOB == 0) cv_store<CW, AB_N / CB, D / 8, 0>((bf16_t*)(ws + WS_WABIN), C.in[I_NMIX], r, C.lane, v);
        else if (JOB == 1) cv_store<CW, C_N / CB, D / 8, 0>((bf16_t*)(ws + WS_WCIN), C.in[I_NMIX] + D, r, C.lane, v);
        else if (JOB == 2) cv_store<CW, D / CB, D / 8, 0>((bf16_t*)(ws + WS_WABOUT), nullptr, r, C.lane, v);
        else if (JOB == 6) cv_store<CW, D / CB, D / 8, 0>((bf16_t*)(ws + WS_WCOUT), nullptr, r, C.lane, v);
        else if (JOB == 3 || JOB == 7) cv_store<CW, DFF / CB, D / 8, 1>((bf16_t*)(ws + (JOB == 7 ? WS_WGU1 : WS_WGU0)), C.in[I_NFFN] + (size_t)(JOB == 7) * D, r, C.lane, v);
        else if (JOB == 4 || JOB == 8) cv_store<CW, DFF / CB, D / 8, 2>((bf16_t*)(ws + (JOB == 8 ? WS_WGU1 : WS_WGU0)), C.in[I_NFFN] + (size_t)(JOB == 8) * D, r, C.lane, v);
        else cv_store<CW, D / CB, DFF / 8, 0>((bf16_t*)(ws + (JOB == 9 ? WS_WDN1 : WS_WDN0)), nullptr, r, C.lane, v);
    }
};
template <int CW_, int... JOBS> struct CvList;
template <int CW_> struct CvList<CW_> { static constexpr int CW = CW_, COUNT = 0;
    static __device__ __forceinline__ void load(const Ctx&, int, typename CvVec<CW_>::T (&)[8]) {}
    static __device__ __forceinline__ void store(const Ctx&, int, const typename CvVec<CW_>::T (&)[8]) {} };
template <int CW_, int J, int... REST> struct CvList<CW_, J, REST...> { static constexpr int CW = CW_, COUNT = CvJob<CW_, J>::COUNT + CvList<CW_, REST...>::COUNT;
    static __device__ __forceinline__ void load(const Ctx& C, int r, typename CvVec<CW_>::T (&v)[8]) { if (r < CvJob<CW_, J>::COUNT) CvJob<CW_, J>::load(C, r, v); else CvList<CW_, REST...>::load(C, r - CvJob<CW_, J>::COUNT, v); }
    static __device__ __forceinline__ void store(const Ctx& C, int r, const typename CvVec<CW_>::T (&v)[8]) { if (r < CvJob<CW_, J>::COUNT) CvJob<CW_, J>::store(C, r, v); else CvList<CW_, REST...>::store(C, r - CvJob<CW_, J>::COUNT, v); } };
template <class L> struct Bg { int next, cur; typename CvVec<L::CW>::T v[8]; };
template <class L> __device__ __forceinline__ void bg_issue(const Ctx& C, Bg<L>& b) { if (b.cur < 0 && b.next < L::COUNT) { L::load(C, b.next, b.v); b.cur = b.next; b.next += C.ngw; } }
template <class L> __device__ __forceinline__ void bg_commit(const Ctx& C, Bg<L>& b) { if (b.cur >= 0) { L::store(C, b.cur, b.v); b.cur = -1; } }
template <class L> __device__ __forceinline__ void bg_drain(const Ctx& C, Bg<L>& b) { bg_commit(C, b); while (b.next < L::COUNT) { bg_issue(C, b); bg_commit(C, b); } }
typedef CvList<4, 0, 1, 2, 3, 4, 5, 6, 7, 8, 9> CvL0;

__device__ __forceinline__ float rstd_of(float ssq) { return __builtin_amdgcn_rsqf(ssq * (1.0f / P::D) + P::EPS); }
__device__ __forceinline__ void xrow_to_bf16(const float* __restrict__ xrow, bf16_t* __restrict__ yrow, float* __restrict__ ssq, int lane) {
    const f32x4* xr = (const f32x4*)xrow + lane; u32x2* o = (u32x2*)yrow + lane; float s = 0.f;
#pragma unroll
    for (int j = 0; j < 16; ++j) { const f32x4 v = xr[64 * j]; s += (v.x * v.x + v.y * v.y) + (v.z * v.z + v.w * v.w); u32x2 w; w.x = cvt_pk_bf16(v.x, v.y); w.y = cvt_pk_bf16(v.z, v.w); o[64 * j] = w; }
    s = wave_sum(s); if (lane == 0) *ssq = s;
}
__device__ __forceinline__ void final_row(const bf16_t* __restrict__ yrow, float rstd, const float* __restrict__ gain, float* __restrict__ orow, int lane) {
    const u32x2* yr = (const u32x2*)yrow + lane; const f32x4* gr = (const f32x4*)gain + lane; f32x4* o = (f32x4*)orow + lane;
#pragma unroll
    for (int j = 0; j < 16; ++j) { const u32x2 w = yr[64 * j]; const f32x4 g = gr[64 * j];
        f32x4 v; v.x = __uint_as_float(w.x << 16) * rstd * g.x; v.y = __uint_as_float(w.x & 0xffff0000u) * rstd * g.y; v.z = __uint_as_float(w.y << 16) * rstd * g.z; v.w = __uint_as_float(w.y & 0xffff0000u) * rstd * g.w; __builtin_nontemporal_store(v, &o[64 * j]); }
}

__device__ __forceinline__ f32x4 gate_tile_part(const bf16_t* __restrict__ H, const bf16_t* __restrict__ Wg, int row0, int k0, int lane) {
    const bf16x8* a = (const bf16x8*)(H + (size_t)(row0 + (lane & 15)) * P::D + k0 + 8 * (lane >> 4));
    const bf16x8* b = (const bf16x8*)(Wg + (size_t)(lane & 15) * P::D + k0 + 8 * (lane >> 4));
    f32x4 acc = {0.f, 0.f, 0.f, 0.f};
#pragma unroll
    for (int kk = 0; kk < 16; ++kk) acc = __builtin_amdgcn_mfma_f32_16x16x32_bf16(a[4 * kk], b[4 * kk], acc, 0, 0, 0);
    return acc;
}
__device__ __forceinline__ f32x4 gate_tile(const bf16_t* __restrict__ H, const bf16_t* __restrict__ Wg, int row0, int lane) {
    const bf16x8* a = (const bf16x8*)(H + (size_t)(row0 + (lane & 15)) * P::D + 8 * (lane >> 4));
    const bf16x8* b = (const bf16x8*)(Wg + (size_t)(lane & 15) * P::D + 8 * (lane >> 4));
    f32x4 acc = {0.f, 0.f, 0.f, 0.f};
#pragma unroll 8
    for (int kk = 0; kk < P::D / 32; ++kk) acc = __builtin_amdgcn_mfma_f32_16x16x32_bf16(a[4 * kk], b[4 * kk], acc, 0, 0, 0);
    return acc;
}

struct EpiAbIn {
    static constexpr bool PERM = true, AFTER_DRAIN = false;
    bf16_t* proj; float* out; float* slab; const float* ssq;
    __device__ __forceinline__ void load_rs(const pg8::Unit& u, int wr, int fr, float (&q)[8]) const {
        if (u.slab >= 0) return;
        const float* sp = ssq + u.pm * 256 + wr * 64 + fr;
#pragma unroll
        for (int ai = 0; ai < 2; ++ai)
#pragma unroll
            for (int m = 0; m < 4; ++m) asm volatile("global_load_dword %0, %1, off offset:%2" : "=v"(q[4 * ai + m]) : "v"(sp), "i"((ai * 128 + m * 16) * 4) : "memory");
    }
    __device__ __forceinline__ void operator()(const f32x4 (&acc)[2][2][4][2], const pg8::Unit& u, int wr, int wc, int fr, int fq, const float (&q)[8]) const {
        using namespace P;
        if (u.slab >= 0) {
            float* sp = slab + (size_t)u.slab * 32768 + (size_t)(wr * 64 + fr) * 256 + wc * 32 + 8 * fq;
#pragma unroll
            for (int m = 0; m < 4; ++m)
#pragma unroll
                for (int bj = 0; bj < 2; ++bj) { *(f32x4*)(sp + m * 16 * 256 + bj * 128) = acc[0][bj][m][0]; *(f32x4*)(sp + m * 16 * 256 + bj * 128 + 4) = acc[0][bj][m][1]; }
            return;
        }
        const int seg = u.pn >> 3;
        const int row0 = u.pm * 256 + wr * 64 + fr, col0 = u.pn * 256 + wc * 32 + 8 * fq, cseg = col0 - seg * 2048;
#pragma unroll
        for (int ai = 0; ai < 2; ++ai)
#pragma unroll
            for (int m = 0; m < 4; ++m) { const int row = row0 + ai * 128 + m * 16; bf16_t* rp = proj + (size_t)row * AB_N + col0;
                float* fo = nullptr;
                if (seg == 3) fo = out + O_PK + (size_t)row * DB + cseg; else if (seg == 4) fo = out + O_PV + (size_t)row * DB + cseg;
                const float rs = rstd_of(q[4 * ai + m]);
#pragma unroll
                for (int bj = 0; bj < 2; ++bj) { const f32x4 v0 = acc[ai][bj][m][0] * rs, v1 = acc[ai][bj][m][1] * rs;
                    u32x4 w; w.x = cvt_pk_bf16(v0[0], v0[1]); w.y = cvt_pk_bf16(v0[2], v0[3]); w.z = cvt_pk_bf16(v1[0], v1[1]); w.w = cvt_pk_bf16(v1[2], v1[3]);
                    *(u32x4*)(rp + bj * 128) = w;
                    if (fo) { __builtin_nontemporal_store(v0, (f32x4*)(fo + bj * 128)); __builtin_nontemporal_store(v1, (f32x4*)(fo + bj * 128 + 4)); } } }
    }
};

struct EpiResid {
    static constexpr bool PERM = true, AFTER_DRAIN = false;
    bf16_t* Yb; float* slab; float* ssq;
    __device__ __forceinline__ void load_rs(const pg8::Unit&, int, int, float (&)[8]) const {}
    __device__ __forceinline__ void operator()(const f32x4 (&acc)[2][2][4][2], const pg8::Unit& u, int wr, int wc, int fr, int fq, const float (&)[8]) const {
        using namespace P;
        if (u.slab >= 0) {
            float* sp = slab + (size_t)u.slab * 32768 + (size_t)(wr * 64 + fr) * 256 + wc * 32 + 8 * fq;
#pragma unroll
            for (int m = 0; m < 4; ++m)
#pragma unroll
                for (int bj = 0; bj < 2; ++bj) { *(f32x4*)(sp + m * 16 * 256 + bj * 128) = acc[0][bj][m][0]; *(f32x4*)(sp + m * 16 * 256 + bj * 128 + 4) = acc[0][bj][m][1]; }
            return;
        }
        const int row0 = u.pm * 256 + wr * 64 + fr, col0 = u.pn * 256 + wc * 32 + 8 * fq;
#pragma unroll
        for (int ai = 0; ai < 2; ++ai)
#pragma unroll
            for (int m = 0; m < 4; ++m) { const int row = row0 + ai * 128 + m * 16; bf16_t* __restrict__ yp = Yb + (size_t)row * D + col0;
                u32x4 b[2];
#pragma unroll
                for (int bj = 0; bj < 2; ++bj) b[bj] = *(const u32x4*)(yp + bj * 128);
                float ss = 0.f;
#pragma unroll
                for (int bj = 0; bj < 2; ++bj) { f32x4 y0 = acc[ai][bj][m][0], y1 = acc[ai][bj][m][1];
                    y0[0] += __uint_as_float(b[bj].x << 16); y0[1] += __uint_as_float(b[bj].x & 0xffff0000u); y0[2] += __uint_as_float(b[bj].y << 16); y0[3] += __uint_as_float(b[bj].y & 0xffff0000u);
                    y1[0] += __uint_as_float(b[bj].z << 16); y1[1] += __uint_as_float(b[bj].z & 0xffff0000u); y1[2] += __uint_as_float(b[bj].w << 16); y1[3] += __uint_as_float(b[bj].w & 0xffff0000u);
                    ss += (y0[0] * y0[0] + y0[1] * y0[1]) + (y0[2] * y0[2] + y0[3] * y0[3]) + (y1[0] * y1[0] + y1[1] * y1[1]) + (y1[2] * y1[2] + y1[3] * y1[3]);
                    u32x4 w; w.x = cvt_pk_bf16(y0[0], y0[1]); w.y = cvt_pk_bf16(y0[2], y0[3]); w.z = cvt_pk_bf16(y1[0], y1[1]); w.w = cvt_pk_bf16(y1[2], y1[3]);
                    *(u32x4*)(yp + bj * 128) = w; }
                ss += __shfl_xor(ss, 16); ss += __shfl_xor(ss, 32);
                if (fq == 0) atomicAdd(ssq + row, ss); }
    }
};
struct EpiSwiGLU {
    static constexpr bool PERM = true, AFTER_DRAIN = false;
    bf16_t* G; float* slab; const float* ssq;
    __device__ __forceinline__ void load_rs(const pg8::Unit& u, int wr, int fr, float (&q)[8]) const {
        if (u.slab >= 0) return;
        const float* sp = ssq + u.pm * 256 + wr * 64 + fr;
#pragma unroll
        for (int ai = 0; ai < 2; ++ai)
#pragma unroll
            for (int m = 0; m < 4; ++m) asm volatile("global_load_dword %0, %1, off offset:%2" : "=v"(q[4 * ai + m]) : "v"(sp), "i"((ai * 128 + m * 16) * 4) : "memory");
    }
    __device__ __forceinline__ void operator()(const f32x4 (&acc)[2][2][4][2], const pg8::Unit& u, int wr, int wc, int fr, int fq, const float (&q)[8]) const {
        using namespace P;
        if (u.slab >= 0) {
            float* sp = slab + (size_t)u.slab * 32768 + (size_t)(wr * 64 + fr) * 256 + wc * 32 + 8 * fq;
#pragma unroll
            for (int m = 0; m < 4; ++m)
#pragma unroll
                for (int bj = 0; bj < 2; ++bj) { *(f32x4*)(sp + m * 16 * 256 + bj * 128) = acc[0][bj][m][0]; *(f32x4*)(sp + m * 16 * 256 + bj * 128 + 4) = acc[0][bj][m][1]; }
            return;
        }
        const int row0 = u.pm * 256 + wr * 64 + fr, col0 = u.pn * 128 + wc * 32 + 8 * fq;
#pragma unroll
        for (int ai = 0; ai < 2; ++ai)
#pragma unroll
            for (int m = 0; m < 4; ++m) { const int row = row0 + ai * 128 + m * 16; float o[8]; const float rs = rstd_of(q[4 * ai + m]);
#pragma unroll
                for (int n = 0; n < 2; ++n)
#pragma unroll
                    for (int j = 0; j < 4; ++j) { const float gt = acc[ai][0][m][n][j] * rs, up = acc[ai][1][m][n][j] * rs;
                        o[4 * n + j] = gt * __builtin_amdgcn_rcpf(1.0f + __builtin_amdgcn_exp2f(-1.4426950408889634f * gt)) * up; }
                u32x4 w; w.x = cvt_pk_bf16(o[0], o[1]); w.y = cvt_pk_bf16(o[2], o[3]); w.z = cvt_pk_bf16(o[4], o[5]); w.w = cvt_pk_bf16(o[6], o[7]);
                *(u32x4*)(G + (size_t)row * DFF + col0) = w; }
    }
};
struct EpiBf16Plain {
    static constexpr bool PERM = true, AFTER_DRAIN = false;
    bf16_t* O; int ldc; float* slab; const float* ssq;
    __device__ __forceinline__ void load_rs(const pg8::Unit& u, int wr, int fr, float (&q)[8]) const {
        if (u.slab >= 0) return;
        const float* sp = ssq + u.pm * 256 + wr * 64 + fr;
#pragma unroll
        for (int ai = 0; ai < 2; ++ai)
#pragma unroll
            for (int m = 0; m < 4; ++m) asm volatile("global_load_dword %0, %1, off offset:%2" : "=v"(q[4 * ai + m]) : "v"(sp), "i"((ai * 128 + m * 16) * 4) : "memory");
    }
    __device__ __forceinline__ void operator()(const f32x4 (&acc)[2][2][4][2], const pg8::Unit& u, int wr, int wc, int fr, int fq, const float (&q)[8]) const {
        if (u.slab >= 0) {
            float* sp = slab + (size_t)u.slab * 32768 + (size_t)(wr * 64 + fr) * 256 + wc * 32 + 8 * fq;
#pragma unroll
            for (int m = 0; m < 4; ++m)
#pragma unroll
                for (int bj = 0; bj < 2; ++bj) { *(f32x4*)(sp + m * 16 * 256 + bj * 128) = acc[0][bj][m][0]; *(f32x4*)(sp + m * 16 * 256 + bj * 128 + 4) = acc[0][bj][m][1]; }
            return;
        }
        const int row0 = u.pm * 256 + wr * 64 + fr, col0 = u.pn * 256 + wc * 32 + 8 * fq;
#pragma unroll
        for (int ai = 0; ai < 2; ++ai)
#pragma unroll
            for (int m = 0; m < 4; ++m) { bf16_t* rp = O + (size_t)(row0 + ai * 128 + m * 16) * ldc + col0; const float rs = rstd_of(q[4 * ai + m]);
#pragma unroll
                for (int bj = 0; bj < 2; ++bj) { const f32x4 v0 = acc[ai][bj][m][0] * rs, v1 = acc[ai][bj][m][1] * rs;
                    u32x4 w; w.x = cvt_pk_bf16(v0[0], v0[1]); w.y = cvt_pk_bf16(v0[2], v0[3]); w.z = cvt_pk_bf16(v1[0], v1[1]); w.w = cvt_pk_bf16(v1[2], v1[3]);
                    *(u32x4*)(rp + bj * 128) = w; } }
    }
};

template <bool FINAL>
__device__ __forceinline__ void sample_row_wg(const Ctx& C, LAS unsigned char* lds, const float* __restrict__ slab, int r, const float* xs, bf16_t* yrow, float* ssq_out, const float* __restrict__ gain, float* orow) {
    f32x4 v[2]; float ss = 0.f; LAS float* red = (LAS float*)lds;
#pragma unroll
    for (int jj = 0; jj < 2; ++jj) { const int j = 2 * C.wave + jj; f32x4 a;
        if (xs) a = ((const f32x4*)xs)[64 * j + C.lane];
        else { const u32x2 w = ((const u32x2*)yrow)[64 * j + C.lane]; a.x = __uint_as_float(w.x << 16); a.y = __uint_as_float(w.x & 0xffff0000u); a.z = __uint_as_float(w.y << 16); a.w = __uint_as_float(w.y & 0xffff0000u); }
        const float* sp = slab + (size_t)(j * 16) * 32768 + (size_t)r * 256 + 4 * C.lane; f32x4 p[16];
#pragma unroll
        for (int s = 0; s < 16; ++s) p[s] = *(const f32x4*)(sp + (size_t)s * 32768);
#pragma unroll
        for (int s = 0; s < 16; ++s) a = a + p[s];
        v[jj] = a; ss += (a.x * a.x + a.y * a.y) + (a.z * a.z + a.w * a.w);
        if (!FINAL) { u32x2 w; w.x = cvt_pk_bf16(a.x, a.y); w.y = cvt_pk_bf16(a.z, a.w); ((u32x2*)yrow)[64 * j + C.lane] = w; } }
    ss = wave_sum(ss);
    __syncthreads();
    if (C.lane == 0) red[C.wave] = ss;
    __syncthreads();
    float tot = 0.f;
#pragma unroll
    for (int w = 0; w < 8; ++w) tot += red[w];
    if (!FINAL) { if (C.tid == 0) *ssq_out = tot; }
    else { const float rr = rstd_of(tot);
#pragma unroll
        for (int jj = 0; jj < 2; ++jj) { const int j = 2 * C.wave + jj; const f32x4 g = ((const f32x4*)gain)[64 * j + C.lane]; ((f32x4*)orow)[64 * j + C.lane] = v[jj] * rr * g; } }
}
template <bool LAYER0>
__device__ __forceinline__ void combine_inproj(const Ctx& C, const float* __restrict__ slab, bf16_t* __restrict__ PROJ, const float* __restrict__ ssq) {
    using namespace P;
    constexpr int NT = LAYER0 ? AB_N / 256 : C_N / 256, S = LAYER0 ? 6 : 5, LD = LAYER0 ? AB_N : C_N;
    for (int it = C.gw; it < 128 * NT; it += C.ngw) { const int r = it / NT, pn = it - r * NT;
        f32x4 a = {0.f, 0.f, 0.f, 0.f};
#pragma unroll
        for (int s = 0; s < S; ++s) a = a + *(const f32x4*)(slab + (size_t)(pn * S + s) * 32768 + (size_t)r * 256 + 4 * C.lane);
        a = a * rstd_of(ssq[NP + r]);
        const int col = pn * 256 + 4 * C.lane; u32x2 w; w.x = cvt_pk_bf16(a[0], a[1]); w.y = cvt_pk_bf16(a[2], a[3]);
        *(u32x2*)(PROJ + (size_t)(NP + r) * LD + col) = w;
        if (LAYER0) { const int seg = pn >> 3, cseg = col - seg * 2048;
            if (seg == 1) *(f32x4*)(C.out + O_SGV + (size_t)r * DA + cseg) = a;
            else if (seg == 3) *(f32x4*)(C.out + O_SK + (size_t)r * DB + cseg) = a;
            else if (seg == 4) *(f32x4*)(C.out + O_SV + (size_t)r * DB + cseg) = a; }
    }
}
__device__ __forceinline__ void combine_swiglu(const Ctx& C, const float* __restrict__ slab, bf16_t* __restrict__ G, const float* __restrict__ ssq) {
    using namespace P;
    typedef float f32x2 __attribute__((ext_vector_type(2)));
    constexpr int NT = DFF / 128, S = 3;
    for (int it = C.gw; it < 128 * NT; it += C.ngw) { const int r = it / NT, pn = it - r * NT;
        f32x2 g = {0.f, 0.f}, u = {0.f, 0.f};
#pragma unroll
        for (int s = 0; s < S; ++s) { const float* sp = slab + (size_t)(pn * S + s) * 32768 + (size_t)r * 256 + 2 * C.lane; g = g + *(const f32x2*)sp; u = u + *(const f32x2*)(sp + 128); }
        { const float rs = rstd_of(ssq[NP + r]); g = g * rs; u = u * rs; }
        const float o0 = g.x * __builtin_amdgcn_rcpf(1.0f + __builtin_amdgcn_exp2f(-1.4426950408889634f * g.x)) * u.x, o1 = g.y * __builtin_amdgcn_rcpf(1.0f + __builtin_amdgcn_exp2f(-1.4426950408889634f * g.y)) * u.y;
        *(unsigned*)(G + (size_t)(NP + r) * DFF + pn * 128 + 2 * C.lane) = cvt_pk_bf16(o0, o1);
    }
}

typedef short v4i16 __attribute__((ext_vector_type(4)));
__device__ __forceinline__ v4i16 tr16(LAS unsigned char* p) { return __builtin_amdgcn_ds_read_tr16_b64_v4i16((LAS v4i16*)p); }
__device__ __forceinline__ bf16x8 cat44(v4i16 lo, v4i16 hi) { bf16x8 r; r[0] = lo[0]; r[1] = lo[1]; r[2] = lo[2]; r[3] = lo[3]; r[4] = hi[0]; r[5] = hi[1]; r[6] = hi[2]; r[7] = hi[3]; return r; }
__device__ __forceinline__ bf16x8 pack8f(f32x4 a, f32x4 b) { u32x4 w; w.x = cvt_pk_bf16(a[0], a[1]); w.y = cvt_pk_bf16(a[2], a[3]); w.z = cvt_pk_bf16(b[0], b[1]); w.w = cvt_pk_bf16(b[2], b[3]); return __builtin_bit_cast(bf16x8, w); }

namespace AT {
constexpr int KT = 0, VT = 17408, TBUF = 34816, CK = 69632, SCAN = 86272, TSTR = 272;
constexpr float C2 = 0.12751743f;
constexpr float LOG2E = 1.4426950408889634f;
}

template <bool SAMPLE>
__device__ __forceinline__ void attn_prepare_ck(const Ctx& C, LAS unsigned char* lds, int b, int h) {
    using namespace P;
    LAS float* ck = (LAS float*)(lds + AT::CK); LAS float* scan = (LAS float*)(lds + AT::SCAN);
    constexpr int n = SAMPLE ? PAST + DEC_S : SEQ;
    float v[8]; const int t0 = 8 * C.tid;
#pragma unroll
    for (int j = 0; j < 8; ++j) { const int t = t0 + j; float x = 0.f;
        if (t < n) { if (!SAMPLE) x = C.out[O_PLF + ((size_t)b * SEQ + t) * HB + h];
                     else x = t < PAST ? C.in[I_CLF][((size_t)b * PAST + t) * HB + h] : C.out[O_SLF + ((size_t)b * DEC_S + (t - PAST)) * HB + h]; }
        v[j] = x; }
#pragma unroll
    for (int j = 1; j < 8; ++j) v[j] += v[j - 1];
    const float tot = v[7]; float x = tot;
#pragma unroll
    for (int o = 1; o < 64; o <<= 1) { const float y = __shfl_up(x, o); if (C.lane >= o) x += y; }
    if (C.lane == 63) scan[C.wave] = x;
    __syncthreads();
    float base = 0.f;
    for (int w = 0; w < C.wave; ++w) base += scan[w];
    const float excl = base + x - tot;
#pragma unroll
    for (int j = 0; j < 8; ++j) if (t0 + j < n + 64) ck[t0 + j] = (excl + v[j]) * AT::LOG2E;
    __syncthreads();
}

template <bool SAMPLE>
__device__ __forceinline__ void attn_load_tile(const Ctx& C, const bf16_t* __restrict__ PROJ, int b, int h, int j, bf16x8 (&kreg)[2], bf16x8 (&vreg)[2]) {
    using namespace P;
#pragma unroll
    for (int i = 0; i < 2; ++i) { const int id = C.tid + 512 * i, r = id >> 4, ch = id & 15;
        if (!SAMPLE) { const bf16_t* p = PROJ + (size_t)(b * SEQ + 64 * j + r) * AB_N + h * DHB + 8 * ch;
            kreg[i] = *(const bf16x8*)(p + 3 * 2048); vreg[i] = *(const bf16x8*)(p + 4 * 2048); }
        else { const int kidx = 64 * j + r;
            if (kidx < PAST) { const size_t o = (((size_t)b * PAST + kidx) * HB + h) * DHB + 8 * ch; const float* kp = C.in[I_CK] + o; const float* vp = C.in[I_CV] + o;
                kreg[i] = pack8f(*(const f32x4*)kp, *(const f32x4*)(kp + 4)); vreg[i] = pack8f(*(const f32x4*)vp, *(const f32x4*)(vp + 4)); }
            else if (kidx < PAST + DEC_S) { const bf16_t* p = PROJ + (size_t)(NP + b * DEC_S + (kidx - PAST)) * AB_N + h * DHB + 8 * ch;
                kreg[i] = *(const bf16x8*)(p + 3 * 2048); vreg[i] = *(const bf16x8*)(p + 4 * 2048); }
            else { kreg[i] = (bf16x8){0, 0, 0, 0, 0, 0, 0, 0}; vreg[i] = (bf16x8){0, 0, 0, 0, 0, 0, 0, 0}; } }
    }
}

template <bool SAMPLE>
__device__ __forceinline__ void attn_qblock(const Ctx& C, LAS unsigned char* lds, const bf16_t* __restrict__ PROJ, bf16_t* __restrict__ MIX, int b, int h, int qb) {
    using namespace P;
    const int fr = C.lane & 15, fq = C.lane >> 4;
    const bool active = SAMPLE ? (C.wave == 0) : true;
    const int qpos0 = SAMPLE ? PAST : 256 * qb + 32 * C.wave;
    const int qrow0 = SAMPLE ? NP + b * DEC_S : b * SEQ + qpos0;
    const int ntiles = SAMPLE ? (PAST + DEC_S + 63) / 64 : 4 * qb + 4;
    LAS float* ck = (LAS float*)(lds + AT::CK);
    bf16x8 qf[2][4]; float cq2[2], mrow[2], lrow[2]; int qpos[2];
    f32x4 oacc[2][8];
#pragma unroll
    for (int qt = 0; qt < 2; ++qt) {
#pragma unroll
        for (int kk = 0; kk < 4; ++kk) qf[qt][kk] = *(const bf16x8*)(PROJ + (size_t)(qrow0 + 16 * qt + fr) * AB_N + 2 * 2048 + h * DHB + 32 * kk + 8 * fq);
        qpos[qt] = qpos0 + 16 * qt + fr; cq2[qt] = ck[qpos[qt]]; mrow[qt] = -1e30f; lrow[qt] = 0.f;
#pragma unroll
        for (int c = 0; c < 8; ++c) oacc[qt][c] = (f32x4){0.f, 0.f, 0.f, 0.f};
    }
    bf16x8 kreg[2], vreg[2];
    attn_load_tile<SAMPLE>(C, PROJ, b, h, ntiles - 1, kreg, vreg);
#define ATTN_STEP(IT, TBOFF) do { const int j = ntiles - 1 - (IT); LAS unsigned char* tb = lds + (TBOFF); \
_Pragma("unroll") \
        for (int i = 0; i < 2; ++i) { const int id = C.tid + 512 * i, r = id >> 4, ch = id & 15; \
            *(LAS bf16x8*)(tb + AT::KT + r * AT::TSTR + ch * 16) = kreg[i]; *(LAS bf16x8*)(tb + AT::VT + r * AT::TSTR + ch * 16) = vreg[i]; } \
        __syncthreads(); \
        if (j > 0) attn_load_tile<SAMPLE>(C, PROJ, b, h, j - 1, kreg, vreg); \
        const int key0 = 64 * j; \
        if (active && key0 <= qpos0 + 31) { \
        const bool need_mask = key0 + 63 > qpos0; \
        f32x4 s[2][4]; \
_Pragma("unroll") \
        for (int qt = 0; qt < 2; ++qt) \
_Pragma("unroll") \
            for (int kt = 0; kt < 4; ++kt) s[qt][kt] = (f32x4){0.f, 0.f, 0.f, 0.f}; \
_Pragma("unroll") \
        for (int kt = 0; kt < 4; ++kt) { \
_Pragma("unroll") \
            for (int kk = 0; kk < 4; ++kk) { const bf16x8 kf = *(const LAS bf16x8*)(tb + AT::KT + (16 * kt + fr) * AT::TSTR + (32 * kk + 8 * fq) * 2); \
_Pragma("unroll") \
                for (int qt = 0; qt < 2; ++qt) s[qt][kt] = __builtin_amdgcn_mfma_f32_16x16x32_bf16(kf, qf[qt][kk], s[qt][kt], 0, 0, 0); } \
            __builtin_amdgcn_sched_barrier(0); } \
_Pragma("unroll") \
        for (int kt = 0; kt < 4; ++kt) { const f32x4 cb = *(const LAS f32x4*)(ck + key0 + 16 * kt + 4 * fq); \
_Pragma("unroll") \
            for (int qt = 0; qt < 2; ++qt) \
_Pragma("unroll") \
                for (int r = 0; r < 4; ++r) s[qt][kt][r] = s[qt][kt][r] * AT::C2 + (cq2[qt] - cb[r]); } \
        if (need_mask) { \
_Pragma("unroll") \
            for (int kt = 0; kt < 4; ++kt) \
_Pragma("unroll") \
                for (int qt = 0; qt < 2; ++qt) \
_Pragma("unroll") \
                    for (int r = 0; r < 4; ++r) if (key0 + 16 * kt + 4 * fq + r > qpos[qt]) s[qt][kt][r] = -__builtin_inff(); } \
        bf16x8 pf[2][2]; \
_Pragma("unroll") \
        for (int qt = 0; qt < 2; ++qt) { \
            float tmax = s[qt][0][0]; \
_Pragma("unroll") \
            for (int kt = 0; kt < 4; ++kt) \
_Pragma("unroll") \
                for (int r = 0; r < 4; ++r) tmax = fmaxf(tmax, s[qt][kt][r]); \
            tmax = fmaxf(tmax, __shfl_xor(tmax, 16)); tmax = fmaxf(tmax, __shfl_xor(tmax, 32)); \
            if (__any(tmax > mrow[qt])) { \
                const float mn = fmaxf(mrow[qt], tmax), alpha = __builtin_amdgcn_exp2f(mrow[qt] - mn); mrow[qt] = mn; lrow[qt] *= alpha; \
_Pragma("unroll") \
                for (int c = 0; c < 8; ++c) oacc[qt][c] = oacc[qt][c] * alpha; } \
            const float mn = mrow[qt]; float psum = 0.f; \
_Pragma("unroll") \
            for (int kt = 0; kt < 4; ++kt) \
_Pragma("unroll") \
                for (int r = 0; r < 4; ++r) { const float p = __builtin_amdgcn_exp2f(s[qt][kt][r] - mn); psum += p; s[qt][kt][r] = p; } \
            lrow[qt] += psum; \
            pf[qt][0] = pack8f(s[qt][0], s[qt][1]); pf[qt][1] = pack8f(s[qt][2], s[qt][3]); \
        } \
_Pragma("unroll") \
        for (int ks = 0; ks < 2; ++ks) \
_Pragma("unroll") \
            for (int c = 0; c < 8; ++c) { LAS unsigned char* vb = tb + AT::VT + (32 * ks + 4 * fq + ((C.lane & 15) >> 2)) * AT::TSTR + (16 * c + 4 * (C.lane & 3)) * 2; \
                const bf16x8 vf = cat44(tr16(vb), tr16(vb + 16 * AT::TSTR)); \
_Pragma("unroll") \
                for (int qt = 0; qt < 2; ++qt) oacc[qt][c] = __builtin_amdgcn_mfma_f32_16x16x32_bf16(vf, pf[qt][ks], oacc[qt][c], 0, 0, 0); \
                if (c & 1) __builtin_amdgcn_sched_barrier(0); } \
            } \
    } while (0)
    for (int it = 0; it < ntiles; it += 2) { ATTN_STEP(it, 0); if (it + 1 < ntiles) ATTN_STEP(it + 1, AT::TBUF); }
#undef ATTN_STEP
    __syncthreads();
    if (active) {
#pragma unroll
        for (int qt = 0; qt < (SAMPLE ? 1 : 2); ++qt) { float lt = lrow[qt]; lt += __shfl_xor(lt, 16); lt += __shfl_xor(lt, 32); const float inv = 1.0f / lt;
            bf16_t* op = MIX + (size_t)(qrow0 + 16 * qt + fr) * D + DA + h * DHB + 4 * fq;
#pragma unroll
            for (int c = 0; c < 8; ++c) { const f32x4 o = oacc[qt][c] * inv; u32x2 w; w.x = cvt_pk_bf16(o[0], o[1]); w.y = cvt_pk_bf16(o[2], o[3]); *(u32x2*)(op + 16 * c) = w; } }
    }
}

namespace GM { constexpr int WT = 0, WSTR = 272, VA = 34816, VSTR = 544; }
__device__ __forceinline__ void gmlp_unit(const Ctx& C, LAS unsigned char* lds, const bf16_t* __restrict__ PROJ, bf16_t* __restrict__ MIX, int rowbase, int nrows, int g) {
    using namespace P;
    __syncthreads();
    { const float* Wg = C.in[I_GWS] + (size_t)g * 128 * 128; const int r = C.tid >> 2, c0 = (C.tid & 3) * 32;
#pragma unroll
        for (int q = 0; q < 4; ++q) { const int c = c0 + 8 * q; f32x4 a = *(const f32x4*)(Wg + r * 128 + c), bb = *(const f32x4*)(Wg + r * 128 + c + 4);
#pragma unroll
            for (int e = 0; e < 4; ++e) { if (c + e > r) a[e] = 0.f; if (c + 4 + e > r) bb[e] = 0.f; }
            *(LAS bf16x8*)(lds + GM::WT + r * GM::WSTR + c * 2) = pack8f(a, bb); } }
#pragma unroll
    for (int i = 0; i < 8; ++i) { const int id = C.tid + 512 * i, s = id >> 5, ch = id & 31; bf16x8 v = (bf16x8){0, 0, 0, 0, 0, 0, 0, 0};
        if (s < nrows) v = *(const bf16x8*)(PROJ + (size_t)(rowbase + s) * AB_N + DA + g * 256 + 8 * ch);
        *(LAS bf16x8*)(lds + GM::VA + s * GM::VSTR + ch * 16) = v; }
    __syncthreads();
    if (16 * C.wave < nrows) {
        const int fr = C.lane & 15, fq = C.lane >> 4, w = C.wave; const int nk = (16 * w + 15) / 32 + 1;
        f32x4 acc[16];
#pragma unroll
        for (int nt = 0; nt < 16; ++nt) acc[nt] = (f32x4){0.f, 0.f, 0.f, 0.f};
        for (int kk = 0; kk < nk; ++kk) { const bf16x8 wf = *(const LAS bf16x8*)(lds + GM::WT + (16 * w + fr) * GM::WSTR + (32 * kk + 8 * fq) * 2);
            LAS unsigned char* vb = lds + GM::VA + (32 * kk + 8 * fq + ((C.lane & 15) >> 2)) * GM::VSTR + 4 * (C.lane & 3) * 2;
#pragma unroll
            for (int nt = 0; nt < 16; ++nt) { const bf16x8 af = cat44(tr16(vb + nt * 32), tr16(vb + nt * 32 + 4 * GM::VSTR)); acc[nt] = __builtin_amdgcn_mfma_f32_16x16x32_bf16(af, wf, acc[nt], 0, 0, 0); } }
        const int row = rowbase + 16 * w + fr; const float bias = C.in[I_GB][g * 128 + 16 * w + fr];
        const bf16_t* up = PROJ + (size_t)row * AB_N + g * 256 + 4 * fq; bf16_t* op = MIX + (size_t)row * D + g * 256 + 4 * fq;
#pragma unroll
        for (int nt = 0; nt < 16; ++nt) { const u32x2 uu = *(const u32x2*)(up + 16 * nt);
            const float u0 = __uint_as_float(uu.x << 16), u1 = __uint_as_float(uu.x & 0xffff0000u), u2 = __uint_as_float(uu.y << 16), u3 = __uint_as_float(uu.y & 0xffff0000u);
            u32x2 wv; wv.x = cvt_pk_bf16(u0 * (acc[nt][0] + bias), u1 * (acc[nt][1] + bias)); wv.y = cvt_pk_bf16(u2 * (acc[nt][2] + bias), u3 * (acc[nt][3] + bias));
            *(u32x2*)(op + 16 * nt) = wv; }
    }
}

__device__ __forceinline__ unsigned cvt_pk_bf16_cv(float lo, float hi) { typedef __bf16 bf2_t __attribute__((ext_vector_type(2))); typedef float f2_t __attribute__((ext_vector_type(2))); const f2_t v = {lo, hi}; return __builtin_bit_cast(unsigned, __builtin_convertvector(v, bf2_t)); }
__device__ __forceinline__ bf16_t f2bf_rne(float f) { const unsigned u = __float_as_uint(f); return (bf16_t)((u + 0x7fffu + ((u >> 16) & 1u)) >> 16); }
#ifndef ML_T
#define ML_T(k)
#endif
namespace ML {
constexpr int QT = 0, QSTR = 528, KT = 33792, VT = 67584, VSTR = 112, VW = 74752, CIT = 81920, GA = 107264, CIT1 = 107776;
constexpr float KSCALE = 0.0625f, LOG2E = 1.4426950408889634f;
}
template <bool SAMPLE>
__device__ __forceinline__ void mlstm_unit(const Ctx& C, LAS unsigned char* lds, const bf16_t* __restrict__ PROJ, const float* __restrict__ GATES, bf16_t* __restrict__ HS, int b, int h, int sl, const f32x4* __restrict__ GS, const bf16x8* __restrict__ PB) {
    using namespace P;
    const int fr = C.lane & 15, fq = C.lane >> 4, w = C.wave, tt = w & 3, vt = w >> 2, qsub = (C.lane & 15) >> 2, psub = C.lane & 3;
    constexpr int NCH = SAMPLE ? 1 : SEQ / 64, LV = SAMPLE ? DEC_S : 64;
    const int rowbase = SAMPLE ? NP + b * DEC_S : b * SEQ;
    const int bh = b * HC + h;
    LAS float* ga = (LAS float*)(lds + ML::GA);
    f32x4 Cacc[2][3]; float mprev = 0.f;
#pragma unroll
    for (int dt = 0; dt < 2; ++dt)
#pragma unroll
        for (int v2 = 0; v2 < 3; ++v2) Cacc[dt][v2] = (f32x4){0.f, 0.f, 0.f, 0.f};
    if (SAMPLE) {
        const float* c0 = C.in[I_SC] + (size_t)bh * DKC * DVC; const float* n0 = C.in[I_SN] + (size_t)bh * DKC;
#pragma unroll
        for (int dt = 0; dt < 2; ++dt) {
#pragma unroll
            for (int v2 = 0; v2 < 2; ++v2)
#pragma unroll
                for (int r = 0; r < 4; ++r) Cacc[dt][v2][r] = c0[(size_t)(32 * w + 16 * dt + 4 * fq + r) * DVC + sl * 32 + 16 * v2 + fr];
#pragma unroll
            for (int r = 0; r < 4; ++r) Cacc[dt][2][r] = fr == 0 ? n0[32 * w + 16 * dt + 4 * fq + r] : 0.f; }
        mprev = C.in[I_SM][bh];
    }
    __syncthreads();
#define ML_WRITE_CIT(CITO) do { _Pragma("unroll") for (int dt = 0; dt < 2; ++dt) _Pragma("unroll") for (int v2 = 0; v2 < 3; ++v2) { \
        u32x2 w_; w_.x = cvt_pk_bf16_cv(Cacc[dt][v2][0], Cacc[dt][v2][1]); w_.y = cvt_pk_bf16_cv(Cacc[dt][v2][2], Cacc[dt][v2][3]); \
        *(LAS u32x2*)(lds + (CITO) + (16 * v2 + fr) * ML::QSTR + (32 * w + 16 * dt + 4 * fq) * 2) = w_; } } while (0)
    ML_WRITE_CIT(ML::CIT);
    bf16x8 qreg[4], kreg[4], vreg, pSn[2]; float lfv, igv; f32x4 gsn;
#define ML_LOAD_CHUNK(c) do { \
_Pragma("unroll") \
        for (int i = 0; i < 4; ++i) { const int id = C.tid + 512 * i, r = id >> 5, ch = id & 31; \
            if (r < LV) { const bf16_t* p = PROJ + (size_t)(rowbase + 64 * (c) + r) * C_N + h * DKC + 8 * ch; qreg[i] = *(const bf16x8*)p; kreg[i] = *(const bf16x8*)(p + 2048); } \
            else { qreg[i] = (bf16x8){0, 0, 0, 0, 0, 0, 0, 0}; kreg[i] = (bf16x8){0, 0, 0, 0, 0, 0, 0, 0}; } } \
        { const int r = (C.tid & 255) >> 2, ch = C.tid & 3; \
            if (r < LV) vreg = *(const bf16x8*)(PROJ + (size_t)(rowbase + 64 * (c) + r) * C_N + 4096 + h * DVC + sl * 32 + 8 * ch); else vreg = (bf16x8){0, 0, 0, 0, 0, 0, 0, 0}; } \
        if constexpr (SAMPLE) { if (C.lane < LV) { const float* gp = GATES + (size_t)(rowbase + 64 * (c) + C.lane) * 16; igv = gp[h]; lfv = gp[8 + h]; } else { igv = -__builtin_inff(); lfv = 0.f; } } \
        else { gsn = GS[(size_t)bh * SEQ + 64 * (c) + C.lane]; const bf16x8* pp = PB + ((size_t)(bh * 64 + (c)) * 4 + tt) * 128 + C.lane; pSn[0] = pp[0]; pSn[1] = pp[64]; } \
    } while (0)
    ML_LOAD_CHUNK(0);
    for (int c = 0; c < NCH; ++c) {
        ML_T(0);
        float bcs, av, cm; bf16x8 pS0, pS1;
        if constexpr (SAMPLE) {
            bcs = lfv;
#pragma unroll
            for (int o = 1; o < 64; o <<= 1) { const float y = __shfl_up(bcs, o); if (C.lane >= o) bcs += y; }
            av = igv - bcs; cm = av;
#pragma unroll
            for (int o = 1; o < 64; o <<= 1) { const float y = __shfl_up(cm, o); if (C.lane >= o) cm = fmaxf(cm, y); }
        } else { bcs = gsn[0]; av = gsn[1]; cm = gsn[2]; pS0 = pSn[0]; pS1 = pSn[1]; }
        const float Mt = fmaxf(mprev, cm), Mend = __shfl(Mt, 63), bend = __shfl(bcs, 63);
        const float wsv = __builtin_amdgcn_exp2f((av - Mend) * ML::LOG2E), wc = __builtin_amdgcn_exp2f((mprev - Mend) * ML::LOG2E);
#pragma unroll
        for (int i = 0; i < 4; ++i) { const int id = C.tid + 512 * i, r = id >> 5, ch = id & 31;
            *(LAS bf16x8*)(lds + ML::QT + r * ML::QSTR + ch * 16) = qreg[i]; *(LAS bf16x8*)(lds + ML::KT + r * ML::QSTR + ch * 16) = kreg[i]; }
        { const int r = C.tid < 256 ? (C.tid >> 2) : ((C.tid - 256) >> 1) & 63; const float sc = __shfl(wsv, r) * ML::KSCALE;
            if (C.tid < 256) { const int ch = C.tid & 3; *(LAS bf16x8*)(lds + ML::VT + r * ML::VSTR + ch * 16) = vreg;
                const u32x4 vv = __builtin_bit_cast(u32x4, vreg); u32x4 o;
#pragma unroll
                for (int e = 0; e < 4; ++e) o[e] = cvt_pk_bf16(__uint_as_float(vv[e] << 16) * sc, __uint_as_float(vv[e] & 0xffff0000u) * sc);
                *(LAS u32x4*)(lds + ML::VW + r * ML::VSTR + ch * 16) = o; }
            else if (C.tid < 384) { const int hf = C.tid & 1;
                u32x4 o1 = {0u, 0u, 0u, 0u}, o2 = {0u, 0u, 0u, 0u}; if (hf == 0) { o1.x = 0x3F80u; o2.x = cvt_pk_bf16(sc, 0.f); }
                *(LAS u32x4*)(lds + ML::VT + r * ML::VSTR + 64 + hf * 16) = o1; *(LAS u32x4*)(lds + ML::VW + r * ML::VSTR + 64 + hf * 16) = o2; } }
        if (SAMPLE && w == 0) { ga[C.lane] = av; ga[64 + C.lane] = wsv; }
        __syncthreads();
        ML_T(1);
        if (c + 1 < NCH) ML_LOAD_CHUNK(c + 1);
        const int citr = (c & 1) ? ML::CIT1 : ML::CIT, citw = (c & 1) ? ML::CIT : ML::CIT1;
        {
            const float Mrow = __shfl(Mt, 16 * tt + fr), brow = __shfl(bcs, 16 * tt + fr);
            const float winter = __builtin_amdgcn_exp2f((mprev - Mrow) * ML::LOG2E);
            bf16x8 qfr[8];
#pragma unroll
            for (int kk = 0; kk < 8; ++kk) qfr[kk] = *(const LAS bf16x8*)(lds + ML::QT + (16 * tt + fr) * ML::QSTR + (32 * kk + 8 * fq) * 2);
            const int tpos = 16 * tt + fr; float rrow = 1.0f;
            if constexpr (SAMPLE) {
                f32x4 sT[4];
#pragma unroll
                for (int st = 0; st < 4; ++st) { sT[st] = (f32x4){0.f, 0.f, 0.f, 0.f};
#pragma unroll
                    for (int kk = 0; kk < 8; ++kk) { const bf16x8 kf = *(const LAS bf16x8*)(lds + ML::KT + (16 * st + fr) * ML::QSTR + (32 * kk + 8 * fq) * 2);
                        sT[st] = __builtin_amdgcn_mfma_f32_16x16x32_bf16(kf, qfr[kk], sT[st], 0, 0, 0); }
                    __builtin_amdgcn_sched_barrier(0); }
#pragma unroll
                for (int st = 0; st < 4; ++st) { const f32x4 a4 = *(const LAS f32x4*)(ga + 16 * st + 4 * fq);
#pragma unroll
                    for (int r = 0; r < 4; ++r) { const int spos = 16 * st + 4 * fq + r;
                        float wgt = __builtin_amdgcn_exp2f((a4[r] - Mrow) * ML::LOG2E); if (spos > tpos) wgt = 0.f;
                        sT[st][r] = sT[st][r] * ML::KSCALE * wgt; } }
                pS0 = pack8f(sT[0], sT[1]); pS1 = pack8f(sT[2], sT[3]);
            } else rrow = __builtin_amdgcn_exp2f((__shfl(cm, tpos) - Mrow) * ML::LOG2E);
            f32x4 acc = (f32x4){0.f, 0.f, 0.f, 0.f}, acc3 = (f32x4){0.f, 0.f, 0.f, 0.f}, accP = (f32x4){0.f, 0.f, 0.f, 0.f}, acc3P = (f32x4){0.f, 0.f, 0.f, 0.f};
#pragma unroll
            for (int kk = 0; kk < 8; ++kk) { const bf16x8 cf = *(const LAS bf16x8*)(lds + citr + (16 * vt + fr) * ML::QSTR + (32 * kk + 8 * fq) * 2);
                const bf16x8 nf = *(const LAS bf16x8*)(lds + citr + (32 + fr) * ML::QSTR + (32 * kk + 8 * fq) * 2);
                acc = __builtin_amdgcn_mfma_f32_16x16x32_bf16(cf, qfr[kk], acc, 0, 0, 0); acc3 = __builtin_amdgcn_mfma_f32_16x16x32_bf16(nf, qfr[kk], acc3, 0, 0, 0); }
            { LAS unsigned char* vb = lds + ML::VT + (4 * fq + qsub) * ML::VSTR + (16 * vt + 4 * psub) * 2; LAS unsigned char* ob = lds + ML::VT + (4 * fq + qsub) * ML::VSTR + (32 + 4 * psub) * 2;
                const bf16x8 vf0 = cat44(tr16(vb), tr16(vb + 16 * ML::VSTR)), of0 = cat44(tr16(ob), tr16(ob + 16 * ML::VSTR));
                accP = __builtin_amdgcn_mfma_f32_16x16x32_bf16(vf0, pS0, accP, 0, 0, 0); acc3P = __builtin_amdgcn_mfma_f32_16x16x32_bf16(of0, pS0, acc3P, 0, 0, 0);
                const bf16x8 vf1 = cat44(tr16(vb + 32 * ML::VSTR), tr16(vb + 48 * ML::VSTR)), of1 = cat44(tr16(ob + 32 * ML::VSTR), tr16(ob + 48 * ML::VSTR));
                accP = __builtin_amdgcn_mfma_f32_16x16x32_bf16(vf1, pS1, accP, 0, 0, 0); acc3P = __builtin_amdgcn_mfma_f32_16x16x32_bf16(of1, pS1, acc3P, 0, 0, 0); }
            acc = acc * winter + accP * rrow; acc3 = acc3 * winter + acc3P * rrow;
            const float den = __shfl(acc3[0], fr);
            const float lim = __builtin_amdgcn_exp2f(-(brow + Mrow) * ML::LOG2E);
            const float inv = 1.0f / fmaxf(fabsf(den), lim);
            if (tpos < LV) { const f32x4 hv = acc * inv; u32x2 hw; hw.x = cvt_pk_bf16(hv[0], hv[1]); hw.y = cvt_pk_bf16(hv[2], hv[3]); *(u32x2*)(HS + (size_t)(rowbase + 64 * c + tpos) * D + h * DVC + sl * 32 + 16 * vt + 4 * fq) = hw; }
        }
        ML_T(2);
        {
#pragma unroll
            for (int dt = 0; dt < 2; ++dt)
#pragma unroll
                for (int v2 = 0; v2 < 3; ++v2) Cacc[dt][v2] = Cacc[dt][v2] * wc;
#pragma unroll
            for (int ks = 0; ks < 2; ++ks) { bf16x8 vw[3];
#pragma unroll
                for (int v2 = 0; v2 < 3; ++v2) { LAS unsigned char* vb = lds + ML::VW + (32 * ks + 8 * fq + qsub) * ML::VSTR + (16 * v2 + 4 * psub) * 2; vw[v2] = cat44(tr16(vb), tr16(vb + 4 * ML::VSTR)); }
#pragma unroll
                for (int dt = 0; dt < 2; ++dt) { LAS unsigned char* kb = lds + ML::KT + (32 * ks + 8 * fq + qsub) * ML::QSTR + (32 * w + 16 * dt + 4 * psub) * 2;
                    const bf16x8 kf = cat44(tr16(kb), tr16(kb + 4 * ML::QSTR));
#pragma unroll
                    for (int v2 = 0; v2 < 3; ++v2) Cacc[dt][v2] = __builtin_amdgcn_mfma_f32_16x16x32_bf16(kf, vw[v2], Cacc[dt][v2], 0, 0, 0); } }
            ML_WRITE_CIT(citw);
            mprev = bend + Mend;
        }
        __syncthreads();
        ML_T(3);
    }
    { float* co = C.out + (SAMPLE ? O_SC : O_PC) + (size_t)bh * DKC * DVC;
#pragma unroll
        for (int dt = 0; dt < 2; ++dt)
#pragma unroll
            for (int v2 = 0; v2 < 2; ++v2)
#pragma unroll
                for (int r = 0; r < 4; ++r) co[(size_t)(32 * w + 16 * dt + 4 * fq + r) * DVC + sl * 32 + 16 * v2 + fr] = Cacc[dt][v2][r];
        if (sl == 0) { float* no = C.out + (SAMPLE ? O_SN : O_PN) + (size_t)bh * DKC;
            if (fr == 0) {
#pragma unroll
                for (int dt = 0; dt < 2; ++dt)
#pragma unroll
                    for (int r = 0; r < 4; ++r) no[32 * w + 16 * dt + 4 * fq + r] = Cacc[dt][2][r]; }
            if (C.tid == 0) C.out[(SAMPLE ? O_SM : O_PM) + bh] = mprev; } }
}
#undef ML_WRITE_CIT
#undef ML_LOAD_CHUNK
__device__ __forceinline__ float rdlane63(float x) { return __int_as_float(__builtin_amdgcn_readlane(__float_as_int(x), 63)); }
namespace MP2 { constexpr int SET = 48128, KT = 0, VT = 33792, VW = 40960, CIT = 96256, CITSZ = 25344, QSTR = 528, VSTR = 112; }
__device__ __forceinline__ void mlstm_prompt_unit(const Ctx& C, LAS unsigned char* lds, const bf16_t* __restrict__ PROJ, bf16_t* __restrict__ HS, int b, int h, int sl, const f32x4* __restrict__ GS, const bf16x8* __restrict__ PB) {
    using namespace P;
    const int fr = C.lane & 15, fq = C.lane >> 4, w = C.wave, tt = w & 3, vt = w >> 2, qsub = (C.lane & 15) >> 2, psub = C.lane & 3;
    constexpr int NCH = SEQ / 64;
    const int rowbase = b * SEQ, bh = b * HC + h;
    f32x4 Cacc[2][3]; float mprev = 0.f;
#pragma unroll
    for (int dt = 0; dt < 2; ++dt)
#pragma unroll
        for (int v2 = 0; v2 < 3; ++v2) Cacc[dt][v2] = (f32x4){0.f, 0.f, 0.f, 0.f};
    bf16x8 kreg[4], vreg, qfr[8], pS0, pS1; f32x4 gsA, gsB;
#define MP_LOAD_KV(c) do { \
_Pragma("unroll") \
        for (int i = 0; i < 4; ++i) { const int id = C.tid + 512 * i, r = id >> 5, ch = id & 31; kreg[i] = *(const bf16x8*)(PROJ + (size_t)(rowbase + 64 * (c) + r) * C_N + 2048 + h * DKC + 8 * ch); } \
        { const int r = (C.tid & 255) >> 2, ch = C.tid & 3; vreg = *(const bf16x8*)(PROJ + (size_t)(rowbase + 64 * (c) + r) * C_N + 4096 + h * DVC + sl * 32 + 8 * ch); } } while (0)
#define MP_LOAD_QP(c) do { \
_Pragma("unroll") \
        for (int kk = 0; kk < 8; ++kk) qfr[kk] = *(const bf16x8*)(PROJ + (size_t)(rowbase + 64 * (c) + 16 * tt + fr) * C_N + h * DKC + 32 * kk + 8 * fq); \
        { const bf16x8* pp = PB + ((size_t)(bh * 64 + (c)) * 4 + tt) * 128 + C.lane; pS0 = pp[0]; pS1 = pp[64]; } } while (0)
#define MP_STAGE(s, g) do { LAS unsigned char* sb_ = lds + (s) * MP2::SET; \
        const float wl_ = __builtin_amdgcn_exp2f(((g)[1] - rdlane63((g)[2])) * ML::LOG2E); \
_Pragma("unroll") \
        for (int i = 0; i < 4; ++i) { const int id = C.tid + 512 * i, r = id >> 5, ch = id & 31; *(LAS bf16x8*)(sb_ + MP2::KT + r * MP2::QSTR + ch * 16) = kreg[i]; } \
        { const int r = C.tid < 256 ? (C.tid >> 2) : ((C.tid - 256) >> 1) & 63; const float sc = __shfl(wl_, r) * ML::KSCALE; \
            if (C.tid < 256) { const int ch = C.tid & 3; *(LAS bf16x8*)(sb_ + MP2::VT + r * MP2::VSTR + ch * 16) = vreg; \
                const u32x4 vv = __builtin_bit_cast(u32x4, vreg); u32x4 o; \
_Pragma("unroll") \
                for (int e = 0; e < 4; ++e) o[e] = cvt_pk_bf16(__uint_as_float(vv[e] << 16) * sc, __uint_as_float(vv[e] & 0xffff0000u) * sc); \
                *(LAS u32x4*)(sb_ + MP2::VW + r * MP2::VSTR + ch * 16) = o; } \
            else if (C.tid < 384) { const int hf = C.tid & 1; \
                u32x4 o1 = {0u, 0u, 0u, 0u}, o2 = {0u, 0u, 0u, 0u}; if (hf == 0) { o1.x = 0x3F80u; o2.x = cvt_pk_bf16(sc, 0.f); } \
                *(LAS u32x4*)(sb_ + MP2::VT + r * MP2::VSTR + 64 + hf * 16) = o1; *(LAS u32x4*)(sb_ + MP2::VW + r * MP2::VSTR + 64 + hf * 16) = o2; } } } while (0)
#define MP_WRITE_CIT(i) do { LAS unsigned char* cb_ = lds + MP2::CIT + (i) * MP2::CITSZ; _Pragma("unroll") for (int dt = 0; dt < 2; ++dt) _Pragma("unroll") for (int v2 = 0; v2 < 3; ++v2) { \
        u32x2 w_; w_.x = cvt_pk_bf16_cv(Cacc[dt][v2][0], Cacc[dt][v2][1]); w_.y = cvt_pk_bf16_cv(Cacc[dt][v2][2], Cacc[dt][v2][3]); \
        *(LAS u32x2*)(cb_ + (16 * v2 + fr) * MP2::QSTR + (32 * w + 16 * dt + 4 * fq) * 2) = w_; } } while (0)
    __syncthreads();
    MP_WRITE_CIT(0);
    MP_LOAD_KV(0); gsA = GS[(size_t)bh * SEQ + C.lane];
    MP_STAGE(0, gsA);
    MP_LOAD_KV(1); gsB = GS[(size_t)bh * SEQ + 64 + C.lane];
    MP_LOAD_QP(0);
    __syncthreads();
    for (int c = 0; c < NCH; ++c) {
        LAS unsigned char* sb = lds + (c & 1) * MP2::SET; LAS unsigned char* citr = lds + MP2::CIT + (c & 1) * MP2::CITSZ;
        const float bcs = gsA[0], av = gsA[1], cm = gsA[2];
        const float Mt = fmaxf(mprev, cm), Mend = rdlane63(Mt), bend = rdlane63(bcs), cm63 = rdlane63(cm);
        const float wc = __builtin_amdgcn_exp2f((mprev - Mend) * ML::LOG2E), beta = __builtin_amdgcn_exp2f((cm63 - Mend) * ML::LOG2E);
        f32x4 gsN = gsB;
        if (c + 1 < NCH) { MP_STAGE((c + 1) & 1, gsB); }
        if (c + 2 < NCH) { MP_LOAD_KV(c + 2); gsN = GS[(size_t)bh * SEQ + 64 * (c + 2) + C.lane]; }
        __builtin_amdgcn_sched_barrier(0);
        {
            const int tpos = 16 * tt + fr;
            const float Mrow = __shfl(Mt, tpos), brow = __shfl(bcs, tpos);
            const float winter = __builtin_amdgcn_exp2f((mprev - Mrow) * ML::LOG2E), rrow = __builtin_amdgcn_exp2f((__shfl(cm, tpos) - Mrow) * ML::LOG2E);
            f32x4 acc = (f32x4){0.f, 0.f, 0.f, 0.f}, acc3 = (f32x4){0.f, 0.f, 0.f, 0.f}, accP = (f32x4){0.f, 0.f, 0.f, 0.f}, acc3P = (f32x4){0.f, 0.f, 0.f, 0.f};
#pragma unroll
            for (int kk = 0; kk < 8; ++kk) { const bf16x8 cf = *(const LAS bf16x8*)(citr + (16 * vt + fr) * MP2::QSTR + (32 * kk + 8 * fq) * 2);
                const bf16x8 nf = *(const LAS bf16x8*)(citr + (32 + fr) * MP2::QSTR + (32 * kk + 8 * fq) * 2);
                acc = __builtin_amdgcn_mfma_f32_16x16x32_bf16(cf, qfr[kk], acc, 0, 0, 0); acc3 = __builtin_amdgcn_mfma_f32_16x16x32_bf16(nf, qfr[kk], acc3, 0, 0, 0);
                if ((kk & 3) == 3) __builtin_amdgcn_sched_barrier(0); }
            { LAS unsigned char* vb = sb + MP2::VT + (4 * fq + qsub) * MP2::VSTR + (16 * vt + 4 * psub) * 2; LAS unsigned char* ob = sb + MP2::VT + (4 * fq + qsub) * MP2::VSTR + (32 + 4 * psub) * 2;
                const bf16x8 vf0 = cat44(tr16(vb), tr16(vb + 16 * MP2::VSTR)), of0 = cat44(tr16(ob), tr16(ob + 16 * MP2::VSTR));
                accP = __builtin_amdgcn_mfma_f32_16x16x32_bf16(vf0, pS0, accP, 0, 0, 0); acc3P = __builtin_amdgcn_mfma_f32_16x16x32_bf16(of0, pS0, acc3P, 0, 0, 0);
                const bf16x8 vf1 = cat44(tr16(vb + 32 * MP2::VSTR), tr16(vb + 48 * MP2::VSTR)), of1 = cat44(tr16(ob + 32 * MP2::VSTR), tr16(ob + 48 * MP2::VSTR));
                accP = __builtin_amdgcn_mfma_f32_16x16x32_bf16(vf1, pS1, accP, 0, 0, 0); acc3P = __builtin_amdgcn_mfma_f32_16x16x32_bf16(of1, pS1, acc3P, 0, 0, 0); }
            if (c + 1 < NCH) MP_LOAD_QP(c + 1);
            acc = acc * winter + accP * rrow; acc3 = acc3 * winter + acc3P * rrow;
            const float den = __shfl(acc3[0], fr);
            const float lim = __builtin_amdgcn_exp2f(-(brow + Mrow) * ML::LOG2E);
            const float inv = 1.0f / fmaxf(fabsf(den), lim);
            { const f32x4 hv = acc * inv; u32x2 hw; hw.x = cvt_pk_bf16(hv[0], hv[1]); hw.y = cvt_pk_bf16(hv[2], hv[3]); *(u32x2*)(HS + (size_t)(rowbase + 64 * c + tpos) * D + h * DVC + sl * 32 + 16 * vt + 4 * fq) = hw; }
        }
        __builtin_amdgcn_sched_barrier(0);
        {
            f32x4 U[2][3];
#pragma unroll
            for (int dt = 0; dt < 2; ++dt)
#pragma unroll
                for (int v2 = 0; v2 < 3; ++v2) U[dt][v2] = (f32x4){0.f, 0.f, 0.f, 0.f};
#pragma unroll
            for (int ks = 0; ks < 2; ++ks) { bf16x8 vw[3];
#pragma unroll
                for (int v2 = 0; v2 < 3; ++v2) { LAS unsigned char* vb = sb + MP2::VW + (32 * ks + 8 * fq + qsub) * MP2::VSTR + (16 * v2 + 4 * psub) * 2; vw[v2] = cat44(tr16(vb), tr16(vb + 4 * MP2::VSTR)); }
#pragma unroll
                for (int dt = 0; dt < 2; ++dt) { LAS unsigned char* kb = sb + MP2::KT + (32 * ks + 8 * fq + qsub) * MP2::QSTR + (32 * w + 16 * dt + 4 * psub) * 2;
                    const bf16x8 kf = cat44(tr16(kb), tr16(kb + 4 * MP2::QSTR));
#pragma unroll
                    for (int v2 = 0; v2 < 3; ++v2) U[dt][v2] = __builtin_amdgcn_mfma_f32_16x16x32_bf16(kf, vw[v2], U[dt][v2], 0, 0, 0); } }
#pragma unroll
            for (int dt = 0; dt < 2; ++dt)
#pragma unroll
                for (int v2 = 0; v2 < 3; ++v2) Cacc[dt][v2] = Cacc[dt][v2] * wc + U[dt][v2] * beta;
            MP_WRITE_CIT((c + 1) & 1);
            mprev = bend + Mend;
        }
        gsA = gsB; gsB = gsN;
        __syncthreads();
    }
    { int l2 = C.lane; asm volatile("" : "+v"(l2));
        const int fr2 = l2 & 15, fq2 = l2 >> 4; float* co = C.out + O_PC + (size_t)bh * DKC * DVC;
#pragma unroll
        for (int dt = 0; dt < 2; ++dt)
#pragma unroll
            for (int v2 = 0; v2 < 2; ++v2)
#pragma unroll
                for (int r = 0; r < 4; ++r) co[(size_t)(32 * w + 16 * dt + 4 * fq2 + r) * DVC + sl * 32 + 16 * v2 + fr2] = Cacc[dt][v2][r];
        if (sl == 0) { float* no = C.out + O_PN + (size_t)bh * DKC;
            if (fr2 == 0) {
#pragma unroll
                for (int dt = 0; dt < 2; ++dt)
#pragma unroll
                    for (int r = 0; r < 4; ++r) no[32 * w + 16 * dt + 4 * fq2 + r] = Cacc[dt][2][r]; }
            if (l2 == 0 && w == 0) C.out[O_PM + bh] = mprev; } }
#undef MP_LOAD_KV
#undef MP_LOAD_QP
#undef MP_STAGE
#undef MP_WRITE_CIT
}

__device__ __forceinline__ void mlstm_prepass(const Ctx& C, const bf16_t* __restrict__ PROJ, const float* __restrict__ GATES, f32x4* __restrict__ GS, bf16x8* __restrict__ PB, int bh, int c) {
    using namespace P;
    const int fr = C.lane & 15, fq = C.lane >> 4, w = C.wave, tt = w & 3, sh = w >> 2, b = bh >> 3, h = bh & 7;
    const size_t rowc = (size_t)b * SEQ + 64 * c;
    const float* gp = GATES + (rowc + C.lane) * 16; const float igv = gp[h], lfv = gp[8 + h];
    bf16x8 qfr[8];
#pragma unroll
    for (int kk = 0; kk < 8; ++kk) qfr[kk] = *(const bf16x8*)(PROJ + (rowc + 16 * tt + fr) * C_N + h * DKC + 32 * kk + 8 * fq);
    float bcs = lfv;
#pragma unroll
    for (int o = 1; o < 64; o <<= 1) { const float y = __shfl_up(bcs, o); if (C.lane >= o) bcs += y; }
    const float av = igv - bcs; float cm = av;
#pragma unroll
    for (int o = 1; o < 64; o <<= 1) { const float y = __shfl_up(cm, o); if (C.lane >= o) cm = fmaxf(cm, y); }
    if (w == 0) GS[(size_t)bh * SEQ + 64 * c + C.lane] = (f32x4){bcs, av, cm, 0.f};
    const int tpos = 16 * tt + fr; const float cmrow = __shfl(cm, tpos);
    f32x4 sT[2];
#pragma unroll
    for (int i = 0; i < 2; ++i) { const int st = 2 * sh + i; sT[i] = (f32x4){0.f, 0.f, 0.f, 0.f};
        if (st <= tt) {
#pragma unroll
            for (int kk = 0; kk < 8; ++kk) { const bf16x8 kf = *(const bf16x8*)(PROJ + (rowc + 16 * st + fr) * C_N + 2048 + h * DKC + 32 * kk + 8 * fq);
                sT[i] = __builtin_amdgcn_mfma_f32_16x16x32_bf16(kf, qfr[kk], sT[i], 0, 0, 0); } }
#pragma unroll
        for (int r = 0; r < 4; ++r) { const int spos = 16 * st + 4 * fq + r; const float as = __shfl(av, spos);
            float wgt = __builtin_amdgcn_exp2f((as - cmrow) * ML::LOG2E); if (spos > tpos) wgt = 0.f;
            sT[i][r] = sT[i][r] * ML::KSCALE * wgt; } }
    PB[((size_t)(bh * 64 + c) * 4 + tt) * 128 + sh * 64 + C.lane] = pack8f(sT[0], sT[1]);
}
__device__ __forceinline__ void mlstm_headnorm_row(const bf16_t* __restrict__ hs, const bf16_t* __restrict__ opre, const float* __restrict__ gn, bf16_t* __restrict__ mix, int lane) {
    const u32x4* hr = (const u32x4*)hs + lane; const f32x4* gr = (const f32x4*)gn + 2 * lane; const u32x4* orr = (const u32x4*)opre + lane; u32x4* mo = (u32x4*)mix + lane;
#pragma unroll
    for (int hh = 0; hh < 8; ++hh) { const u32x4 hw = hr[64 * hh], ow = orr[64 * hh]; const f32x4 g0 = gr[128 * hh], g1 = gr[128 * hh + 1];
        float v[8], o[8];
#pragma unroll
        for (int e = 0; e < 4; ++e) { v[2 * e] = __uint_as_float(hw[e] << 16); v[2 * e + 1] = __uint_as_float(hw[e] & 0xffff0000u); o[2 * e] = __uint_as_float(ow[e] << 16); o[2 * e + 1] = __uint_as_float(ow[e] & 0xffff0000u); }
        float ss = 0.f;
#pragma unroll
        for (int e = 0; e < 8; ++e) ss += v[e] * v[e];
        ss = wave_sum(ss);
        const float r = 1.0f / sqrtf(ss * (1.0f / 512.0f) + P::EPS);
        float y[8];
#pragma unroll
        for (int e = 0; e < 8; ++e) { const float sg = __builtin_amdgcn_rcpf(1.0f + __builtin_amdgcn_exp2f(-1.4426950408889634f * o[e])); y[e] = sg * v[e] * r * (e < 4 ? g0[e] : g1[e - 4]); }
        u32x4 w; w.x = cvt_pk_bf16(y[0], y[1]); w.y = cvt_pk_bf16(y[2], y[3]); w.z = cvt_pk_bf16(y[4], y[5]); w.w = cvt_pk_bf16(y[6], y[7]); mo[64 * hh] = w; }
}

struct Args { const float* in[P::N_IN]; float* out; unsigned char* ws; };

__global__ void __launch_bounds__(512, 2) fwd(Args args) {
    using namespace P;
    extern __shared__ __attribute__((aligned(16))) unsigned char lds_raw[];
    LAS unsigned char* lds = (LAS unsigned char*)lds_raw;
    Ctx C;
    C.in = args.in;
    C.out = args.out; C.ws = args.ws;
    C.tid = threadIdx.x; C.lane = C.tid & 63; C.wave = __builtin_amdgcn_readfirstlane(C.tid >> 6);
    C.G = gridDim.x; C.gw = blockIdx.x * 8 + C.wave; C.ngw = C.G * 8;
    volatile LAS unsigned* MISC = (volatile LAS unsigned*)(lds + MISC_OFF);
    for (int u = C.tid; u < (LDS_BYTES - MISC_OFF) / 4; u += 512) ((LAS unsigned*)(lds + MISC_OFF))[u] = 0u;
    __syncthreads();
    unsigned* ctl = (unsigned*)(C.ws + WS_CTL);
    XcdBarrier bar = xcd_barrier_post(ctl + CW_BAR, MISC + 8);

#define Yb ((bf16_t*)(args.ws + P::WS_H))
#define SSQ(i) ((float*)(args.ws + P::WS_CTL + P::CTL_SSQ) + (i) * P::MP)
#define PROJ ((bf16_t*)(args.ws + P::WS_PROJ))
#define MIX ((bf16_t*)(args.ws + P::WS_MIX))
#define Gb ((bf16_t*)(args.ws + P::WS_G))
#define HS ((bf16_t*)(args.ws + P::WS_G))
#define GATES ((float*)(args.ws + P::WS_GATES))
#define SLAB ((float*)(args.ws + P::WS_SLAB))
    const int bid = (int)blockIdx.x;
#define TS(n)
#define PHASE_BEGIN() do { int t_ = threadIdx.x; asm volatile("" : "+v"(t_)); C.tid = t_; C.lane = t_ & 63; } while (0)

    PHASE_BEGIN();
    {
        { Bg<CvL0> bg; bg.next = C.gw; bg.cur = -1; bg_drain(C, bg); }
        LAS float* scr = (LAS float*)(lds + C.wave * 16384);
        if ((C.gw & 15) == 0 && (C.gw >> 4) < 128) { const int it = C.gw >> 4;
            if (it < 64) transpose_item(C.in[I_ABWIN], AB_LD, D, 64 * it, AB_N, 16, (bf16_t*)(C.ws + WS_WABF), 0, scr, C.lane, C.in[I_NMIX]);
            else transpose_item(C.in[I_CWIN], C_LD, D, 64 * (it - 64), C_N, 16, (bf16_t*)(C.ws + WS_WCIF), 0, scr, C.lane, C.in[I_NMIX] + D); }
        for (int m = C.gw; m < M; m += C.ngw) {
            const float* xr = m < NP ? C.in[I_XP] + (size_t)m * D : C.in[I_XS] + (size_t)(m - NP) * D;
            xrow_to_bf16(xr, Yb + (size_t)m * D, SSQ(0) + m, C.lane);
        }
    }
    xcd_barrier(bar);

    PHASE_BEGIN();
    {
        const bf16_t* Wf = (const bf16_t*)(C.ws + WS_WABF);
        for (int t = bid; t < M / 16; t += C.G) {
            const int row0 = 16 * t; const f32x4 part = gate_tile_part(Yb, Wf, row0, 512 * C.wave, C.lane);
            ((LAS f32x4*)lds)[C.wave * 64 + C.lane] = part;
            __syncthreads();
            if (C.wave == 0) { f32x4 acc = ((LAS f32x4*)lds)[C.lane];
#pragma unroll
                for (int w = 1; w < 8; ++w) acc = acc + ((LAS f32x4*)lds)[w * 64 + C.lane];
                const int n = C.lane & 15, g4 = 4 * (C.lane >> 4); const float bf = C.in[I_FBF][n];
#pragma unroll
                for (int r = 0; r < 4; ++r) { const int row = row0 + g4 + r; const float lf = log_sigmoid_f(acc[r] * rstd_of(SSQ(0)[row]) + bf);
                    if (row < NP) C.out[O_PLF + (size_t)row * HB + n] = lf; else C.out[O_SLF + (size_t)(row - NP) * HB + n] = lf; } }
            __syncthreads();
        }
        pg8::Gemm g{Yb, (const bf16_t*)(C.ws + WS_WABIN), MP, AB_N, D}; SplitOrder S; S.init(AB_N, D, 6, C.G, bid);
        EpiAbIn E{PROJ, C.out, SLAB, SSQ(0)};
        pg8::gemm_phase<EpiAbIn, SplitOrder, true, true>(lds, g, S, E);
    }
    xcd_barrier(bar);
    PHASE_BEGIN();
    combine_inproj<true>(C, SLAB, PROJ, SSQ(0));
    xcd_barrier(bar);

    PHASE_BEGIN();
    {
        for (int u = (C.G == 256 ? ((bid & 7) << 5) | (bid >> 3) : bid); u < 256; u += C.G) {
            const int bh = u >> 3, s = u & 7, b = bh >> 4, h = bh & 15;
            attn_prepare_ck<false>(C, lds, b, h);
            attn_qblock<false>(C, lds, PROJ, MIX, b, h, s);
            attn_qblock<false>(C, lds, PROJ, MIX, b, h, 15 - s);
            __syncthreads();
        }
        TS(21);
        PHASE_BEGIN();
        for (int u = bid; u < DEC_B * HB; u += C.G) {
            const int b = u >> 4, h = u & 15;
            attn_prepare_ck<true>(C, lds, b, h);
            attn_qblock<true>(C, lds, PROJ, MIX, b, h, 0);
            __syncthreads();
        }
        TS(22);
        PHASE_BEGIN();
        if (C.G == 256) {
            if (bid < 128) gmlp_unit(C, lds, PROJ, MIX, (bid >> 3) * 128, 128, bid & 7);
            else { for (int i = 0; i < 3; ++i) { const int u = 128 + 3 * (bid - 128) + i; gmlp_unit(C, lds, PROJ, MIX, (u >> 3) * 128, 128, u & 7); }
                if (bid >= 192) { const int u = bid - 192; gmlp_unit(C, lds, PROJ, MIX, NP + (u >> 3) * DEC_S, DEC_S, u & 7); } }
        } else {
            for (int u = bid; u < 512 + 64; u += C.G) {
                if (u < 512) gmlp_unit(C, lds, PROJ, MIX, (u >> 3) * 128, 128, u & 7);
                else gmlp_unit(C, lds, PROJ, MIX, NP + ((u - 512) >> 3) * DEC_S, DEC_S, (u - 512) & 7);
            }
        }
    }
    xcd_barrier(bar);

    PHASE_BEGIN();
    {
        pg8::Gemm g{MIX, (const bf16_t*)(C.ws + WS_WABOUT), MP, D, D}; SplitOrder S; S.init(D, D, 16, C.G, bid);
        EpiResid E{Yb, SLAB, SSQ(1)};
        pg8::gemm_phase<EpiResid, SplitOrder, true, true>(lds, g, S, E);
    }
    xcd_barrier(bar);
    PHASE_BEGIN();
    for (int r = bid; r < NS; r += C.G) sample_row_wg<false>(C, lds, SLAB, r, C.in[I_XS] + (size_t)r * D, Yb + (size_t)(NP + r) * D, SSQ(1) + NP + r, nullptr, nullptr);
    xcd_barrier(bar);
    PHASE_BEGIN();
    {
        pg8::Gemm g{Yb, (const bf16_t*)(C.ws + WS_WGU0), MP, 2 * DFF, D}; SplitOrder S; S.init(2 * DFF, D, 3, C.G, bid);
        EpiSwiGLU E{Gb, SLAB, SSQ(1)};
        pg8::gemm_phase<EpiSwiGLU, SplitOrder, true, true>(lds, g, S, E);
    }
    xcd_barrier(bar);
    PHASE_BEGIN();
    combine_swiglu(C, SLAB, Gb, SSQ(1));
    xcd_barrier(bar);
    PHASE_BEGIN();
    {
        pg8::Gemm g{Gb, (const bf16_t*)(C.ws + WS_WDN0), MP, D, DFF}; SplitOrder S; S.init(D, DFF, 16, C.G, bid);
        EpiResid E{Yb, SLAB, SSQ(2)};
        pg8::gemm_phase<EpiResid, SplitOrder, true, true>(lds, g, S, E);
    }
    xcd_barrier(bar);
    PHASE_BEGIN();
    for (int r = bid; r < NS; r += C.G) sample_row_wg<false>(C, lds, SLAB, r, nullptr, Yb + (size_t)(NP + r) * D, SSQ(2) + NP + r, nullptr, nullptr);
    xcd_barrier(bar);
    PHASE_BEGIN();
    {
        const bf16_t* Wif = (const bf16_t*)(C.ws + WS_WCIF);
        for (int t = bid; t < M / 16; t += C.G) {
            const int row0 = 16 * t; const f32x4 part = gate_tile_part(Yb, Wif, row0, 512 * C.wave, C.lane);
            ((LAS f32x4*)lds)[C.wave * 64 + C.lane] = part;
            __syncthreads();
            if (C.wave == 0) { f32x4 acc = ((LAS f32x4*)lds)[C.lane];
#pragma unroll
                for (int w = 1; w < 8; ++w) acc = acc + ((LAS f32x4*)lds)[w * 64 + C.lane];
                const int n = C.lane & 15, g4 = 4 * (C.lane >> 4); const float bb = n < 8 ? C.in[I_CBI][n] : C.in[I_CBF][n - 8];
#pragma unroll
                for (int r = 0; r < 4; ++r) { const float z = acc[r] * rstd_of(SSQ(2)[row0 + g4 + r]) + bb; GATES[(size_t)(row0 + g4 + r) * 16 + n] = n < 8 ? z : log_sigmoid_f(z); } }
            __syncthreads();
        }
        pg8::Gemm g{Yb, (const bf16_t*)(C.ws + WS_WCIN), MP, C_N, D}; SplitOrder S; S.init(C_N, D, 5, C.G, bid);
        EpiBf16Plain E{PROJ, C_N, SLAB, SSQ(2)};
        pg8::gemm_phase<EpiBf16Plain, SplitOrder, true, true>(lds, g, S, E);
    }
    xcd_barrier(bar);
    PHASE_BEGIN();
    combine_inproj<false>(C, SLAB, PROJ, SSQ(2));
    for (int u = bid; u < BATCH * HC * 64; u += C.G) mlstm_prepass(C, PROJ, GATES, (f32x4*)(C.ws + WS_GS), (bf16x8*)(C.ws + WS_PB), u >> 6, u & 63);
    xcd_barrier(bar);
    PHASE_BEGIN();
    {
        for (int u = (C.G == 256 ? ((bid & 7) << 5) | (bid >> 3) : bid); u < BATCH * HC * 16; u += C.G) mlstm_prompt_unit(
            C, lds, PROJ, HS, u >> 7, (u >> 4) & 7, u & 15, (const f32x4*)(C.ws + WS_GS), (const bf16x8*)(C.ws + WS_PB));
        TS(23);
        PHASE_BEGIN();
        for (int u = bid; u < DEC_B * HC * 16; u += C.G) mlstm_unit<true>(C, lds, PROJ, GATES, HS, u >> 7, (u >> 4) & 7, u & 15, nullptr, nullptr);
    }
    xcd_barrier(bar);
    PHASE_BEGIN();
    for (int m = C.gw; m < M; m += C.ngw) mlstm_headnorm_row(HS + (size_t)m * D, PROJ + (size_t)m * C_N + 8192, C.in[I_CHN], MIX + (size_t)m * D, C.lane);
    xcd_barrier(bar);
    PHASE_BEGIN();
    {
        pg8::Gemm g{MIX, (const bf16_t*)(C.ws + WS_WCOUT), MP, D, D}; SplitOrder S; S.init(D, D, 16, C.G, bid);
        EpiResid E{Yb, SLAB, SSQ(3)};
        pg8::gemm_phase<EpiResid, SplitOrder, true, true>(lds, g, S, E);
    }
    xcd_barrier(bar);
    PHASE_BEGIN();
    for (int r = bid; r < NS; r += C.G) sample_row_wg<false>(C, lds, SLAB, r, nullptr, Yb + (size_t)(NP + r) * D, SSQ(3) + NP + r, nullptr, nullptr);
    xcd_barrier(bar);
    PHASE_BEGIN();
    {
        pg8::Gemm g{Yb, (const bf16_t*)(C.ws + WS_WGU1), MP, 2 * DFF, D}; SplitOrder S; S.init(2 * DFF, D, 3, C.G, bid);
        EpiSwiGLU E{Gb, SLAB, SSQ(3)};
        pg8::gemm_phase<EpiSwiGLU, SplitOrder, true, true>(lds, g, S, E);
    }
    xcd_barrier(bar);
    PHASE_BEGIN();
    combine_swiglu(C, SLAB, Gb, SSQ(3));
    xcd_barrier(bar);
    PHASE_BEGIN();
    {
        pg8::Gemm g{Gb, (const bf16_t*)(C.ws + WS_WDN1), MP, D, DFF}; SplitOrder S; S.init(D, DFF, 16, C.G, bid);
        EpiResid E{Yb, SLAB, SSQ(4)};
        pg8::gemm_phase<EpiResid, SplitOrder, true, true>(lds, g, S, E);
    }
    xcd_barrier(bar);
    PHASE_BEGIN();
    for (int m = C.gw; m < NP; m += C.ngw) final_row(Yb + (size_t)m * D, rstd_of(SSQ(4)[m]), C.in[I_NFIN], C.out + O_YP + (size_t)m * D, C.lane);
    for (int r = bid; r < NS; r += C.G) sample_row_wg<true>(C, lds, SLAB, r, nullptr, Yb + (size_t)(NP + r) * D, nullptr, C.in[I_NFIN], C.out + O_YS + (size_t)r * D);
}

#undef Yb
#undef SSQ
#undef PROJ
#undef MIX
#undef Gb
#undef HS
#undef GATES
#undef SLAB
extern "C" void kernel_launch(void* const* d_in, const int* in_sizes, int n_in, void* d_out, int out_size, void* d_ws, size_t ws_size, hipStream_t stream) {
    static int grid = 0;
    if (grid == 0) {
        if (n_in != P::N_IN || (size_t)out_size != P::O_END || ws_size < P::WS_END) { fprintf(stderr, "kernel_launch: unexpected shapes: n_in %d out %d ws %zu\n", n_in, out_size, ws_size); grid = -1; return; }
        int dev = 0, cus = 0, per_cu = 0;
        if (hipGetDevice(&dev) != hipSuccess || hipDeviceGetAttribute(&cus, hipDeviceAttributeMultiprocessorCount, dev) != hipSuccess) { grid = -1; return; }
        if (hipFuncSetAttribute((const void*)fwd, hipFuncAttributeMaxDynamicSharedMemorySize, P::LDS_BYTES) != hipSuccess) { fprintf(stderr, "kernel_launch: hipFuncSetAttribute failed\n"); grid = -1; return; }
        if (hipOccupancyMaxActiveBlocksPerMultiprocessor(&per_cu, (const void*)fwd, 512, P::LDS_BYTES) != hipSuccess || per_cu < 1) fprintf(stderr, "kernel_launch: occupancy query reports %d per CU\n", per_cu);
        (void)hipGetLastError();
        grid = cus;
    }
    if (grid < 0) return;
    if (hipMemsetAsync((char*)d_ws + P::WS_CTL, 0, P::CTL_ZERO_BYTES, stream) != hipSuccess) return;
    Args a{};
    for (int i = 0; i < P::N_IN; ++i) a.in[i] = (const float*)d_in[i];
    a.out = (float*)d_out; a.ws = (unsigned char*)d_ws;
    hipLaunchKernelGGL(fwd, dim3(grid), dim3(512), P::LDS_BYTES, stream, a);
}
```

```cpp
#include <hip/hip_runtime.h>
#include <cstdio>
#include <cstdint>
namespace pg8 {
#define PG8_LAS __attribute__((address_space(3)))
typedef unsigned short bf16_t;
typedef short bf16x8 __attribute__((ext_vector_type(8)));
typedef float f32x4 __attribute__((ext_vector_type(4)));
typedef unsigned u32x4 __attribute__((ext_vector_type(4)));
constexpr int BM = 256, BK = 64, HALF = 128, HTB = HALF * BK * 2  , STAGE_BYTES = 8 * HTB, NXCD = 8, WGM = 8;

__host__ __device__ __forceinline__ int lds_byte(int r, int c) { const int st = (r >> 4) * 2 + (c >> 5), rr = r & 15, cc = c & 31, ob = rr * 64 + cc * 2; return st * 1024 + (ob ^ (((ob >> 9) & 1) << 5)); }
__host__ __device__ __forceinline__ void stage_rc(int b, int& R, int& C) { const int st = b / 1024, sb = b % 1024, swz = sb ^ (((sb >> 9) & 1) << 5); R = (st >> 1) * 16 + swz / 64; C = (st & 1) * 32 + (swz % 64) / 2; }
__host__ __device__ __forceinline__ int perm32(int rho) { const int n = rho >> 4, i = rho & 15; return 8 * (i >> 2) + 4 * n + (i & 3); }

struct Unit { int pm, pn, kt0, nkt, slab; };
struct Gemm { const bf16_t* A; const bf16_t* Bt; int M, N, K; };

struct StaticOrder {
    int nM, nN, nwg, G, c, ktiles;
    __host__ __device__ void init(int M, int N, int K, int G_, int c_) { nM = M / BM; nN = N / BM; nwg = nM * nN; G = G_; c = c_; ktiles = K / BK; }
    __host__ __device__ bool next(int i, Unit& u) const {
        const long L = (long)i * G + c; if (L >= nwg) return false;
        int wgid = (int)L; { const int q = nwg / NXCD, r = nwg % NXCD, xcd = wgid % NXCD, off = wgid / NXCD; wgid = (xcd < r ? xcd * (q + 1) : r * (q + 1) + (xcd - r) * q) + off; }
        const int nig = WGM * nN, gid = wgid / nig, fm = gid * WGM, gsz = (nM - fm) < WGM ? (nM - fm) : WGM;
        u.pm = fm + ((wgid % nig) % gsz); u.pn = (wgid % nig) / gsz; u.kt0 = 0; u.nkt = ktiles; u.slab = -1; return true;
    }
    __device__ __forceinline__ void a_ready(const Unit&) const {}
    __device__ __forceinline__ void done(const Unit&) const {}
};

__device__ __forceinline__ unsigned cvt_pk_bf16(float lo, float hi) { unsigned r; asm volatile("v_cvt_pk_bf16_f32 %0, %1, %2" : "=v"(r) : "v"(lo), "v"(hi)); return r; }
typedef float f32x2 __attribute__((ext_vector_type(2)));
template <class Epi, class Sched, bool ALIGN_EPI = false, bool SP2 = false>
__device__ __forceinline__ void gemm_phase(PG8_LAS unsigned char* lds, const Gemm g, const Sched& S, const Epi& E) {
    int tid_ = threadIdx.x; asm volatile("" : "+v"(tid_));
    const int tid = tid_, wid = __builtin_amdgcn_readfirstlane(tid >> 6), lane = tid & 63, wr = wid >> 2, wc = wid & 3, fr = lane & 15, fq = lane >> 4;
    const int K = g.K;
    unsigned voffA[2], voffB[2];
#pragma unroll
    for (int i = 0; i < 2; ++i) { int R, C; stage_rc(tid * 16 + i * 8192, R, C); voffA[i] = (unsigned)(R * K + C) * 2u;
        const int Rl = (wid & 1) * 64 + lane, Rb = Epi::PERM ? ((Rl & ~31) + perm32(Rl & 31)) : Rl; voffB[i] = (unsigned)(((wid >> 1) + 4 * i) * 256 + Rb) * 16u; }
    const size_t kstep = (size_t)(BK * 2);
    const size_t hstep = (size_t)HALF * K * 2;
    const size_t tstep = 2 * hstep;
    const size_t kstepB = 32768, hstepB = 2048, tstepB = (size_t)K * 512;
    const unsigned ldsw = (unsigned)wid * 1024u;
    const int aoff = lds_byte(wr * 64 + fr, fq * 8), boff = fq * 2048 + wc * 512 + fr * 16;
#define PG8_SA(b, h) (((b) * 2 + (h)) * HTB)
#define PG8_SB(b, h) ((4 + (b) * 2 + (h)) * HTB)
#define PG8_STAGE(bufoff, gbase, voff) do { _Pragma("unroll") for (int _i = 0; _i < 2; ++_i) \
        __builtin_amdgcn_global_load_lds((const unsigned*)((const char*)(gbase) + (voff)[_i]), (PG8_LAS unsigned*)(lds + (bufoff) + ldsw + _i * 8192), 16, 0, 0); } while (0)
#define PG8_LDA(dst, b, h) do { _Pragma("unroll") for (int m = 0; m < 4; ++m) _Pragma("unroll") for (int k = 0; k < 2; ++k) dst[m][k] = *(const PG8_LAS bf16x8*)(lds + PG8_SA(b, h) + aoff + m * 2048 + k * 1024); } while (0)
#define PG8_LDB(dst, b, h) do { _Pragma("unroll") for (int n = 0; n < 2; ++n) _Pragma("unroll") for (int k = 0; k < 2; ++k) dst[n][k] = *(const PG8_LAS bf16x8*)(lds + PG8_SB(b, h) + boff + n * 256 + k * 8192); } while (0)
#define PG8_MMA(ai, bj, At, Bt) do { __builtin_amdgcn_s_setprio(1); _Pragma("unroll") for (int m = 0; m < 4; ++m) _Pragma("unroll") for (int n = 0; n < 2; ++n) _Pragma("unroll") for (int k = 0; k < 2; ++k) \
        acc[ai][bj][m][n] = __builtin_amdgcn_mfma_f32_16x16x32_bf16(Bt[n][k], At[m][k], acc[ai][bj][m][n], 0, 0, 0); __builtin_amdgcn_s_setprio(0); } while (0)
#define PG8_WAIT_V(n) asm volatile("s_waitcnt vmcnt(" #n ")" ::: "memory")
#define PG8_WAIT_L(n) asm volatile("s_waitcnt lgkmcnt(" #n ")" ::: "memory")
#define PG8_BAR __builtin_amdgcn_s_barrier()
#define PG8_SCHED __builtin_amdgcn_sched_barrier(0)
    Unit cur, nxt; int ui = 0;
    if (!S.next(0, cur)) return;
    f32x4 acc[2][2][4][2];
#pragma unroll
    for (int a = 0; a < 2; ++a)
#pragma unroll
        for (int b = 0; b < 2; ++b)
#pragma unroll
            for (int m = 0; m < 4; ++m)
#pragma unroll
                for (int n = 0; n < 2; ++n) acc[a][b][m][n] = (f32x4){0.f, 0.f, 0.f, 0.f};
    bf16x8 At[4][2], B0[2][2], B1[2][2];
    float rs8[8];
    const char* cA = (const char*)g.A + (size_t)cur.pm * tstep + (size_t)cur.kt0 * kstep; const char* cB = (const char*)g.Bt + (size_t)cur.pn * tstepB + (size_t)cur.kt0 * kstepB; int nt = cur.nkt;
    S.a_ready(cur); E.load_rs(cur, wr, fr, rs8);
    if constexpr (SP2) {
        PG8_STAGE(PG8_SB(0, 0), cB, voffB); PG8_STAGE(PG8_SB(0, 1), cB + hstepB, voffB); PG8_STAGE(PG8_SA(0, 0), cA, voffA); PG8_STAGE(PG8_SA(0, 1), cA + hstep, voffA);
        if (wr == 1) PG8_BAR;
        PG8_WAIT_V(2); PG8_BAR;
        PG8_STAGE(PG8_SB(1, 0), cB + kstepB, voffB); PG8_STAGE(PG8_SA(1, 0), cA + kstep, voffA); PG8_STAGE(PG8_SB(1, 1), cB + hstepB + kstepB, voffB);
        PG8_WAIT_V(6); PG8_BAR;
    } else {
        PG8_STAGE(PG8_SB(0, 0), cB, voffB); PG8_STAGE(PG8_SA(0, 0), cA, voffA); PG8_STAGE(PG8_SB(0, 1), cB + hstepB, voffB); PG8_STAGE(PG8_SA(0, 1), cA + hstep, voffA);
        if (wr == 1) PG8_BAR;
        PG8_WAIT_V(4); PG8_BAR;
        PG8_STAGE(PG8_SB(1, 0), cB + kstepB, voffB); PG8_STAGE(PG8_SA(1, 0), cA + kstep, voffA); PG8_STAGE(PG8_SB(1, 1), cB + hstepB + kstepB, voffB);
        PG8_WAIT_V(6); PG8_BAR;
    }
    for (;;) {
        const bool has_next = S.next(ui + 1, nxt);
        const char* nA = has_next ? (const char*)g.A + (size_t)nxt.pm * tstep + (size_t)nxt.kt0 * kstep : cA; const char* nB = has_next ? (const char*)g.Bt + (size_t)nxt.pn * tstepB + (size_t)nxt.kt0 * kstepB : cB;
        if constexpr (SP2) {
        if (cur.slab >= 0) {
        for (int t = 0; t < nt; t += 2) {
            const bool last = (t == nt - 2);
            const char* a1 = cA + (size_t)(t + 1) * kstep;
            const char* a2 = last ? nA : cA + (size_t)(t + 2) * kstep; const char* b2 = last ? nB : cB + (size_t)(t + 2) * kstepB;
            const char* a3 = a2 + kstep; const char* b3 = b2 + kstepB;
            if (last && has_next) S.a_ready(nxt);
            PG8_LDB(B0, 0, 0); PG8_LDB(B1, 0, 1); PG8_SCHED; PG8_LDA(At, 0, 0); PG8_STAGE(PG8_SA(1, 1), a1 + hstep, voffA);
            PG8_WAIT_V(8); PG8_WAIT_L(0); PG8_BAR; PG8_MMA(0, 0, At, B0); PG8_MMA(0, 1, At, B1); PG8_BAR; PG8_SCHED;
            PG8_STAGE(PG8_SB(0, 0), b2, voffB); PG8_STAGE(PG8_SB(0, 1), b2 + hstepB, voffB); PG8_STAGE(PG8_SA(0, 0), a2, voffA);
            PG8_WAIT_V(8); PG8_WAIT_L(0); PG8_BAR; PG8_BAR; PG8_SCHED;
            PG8_LDB(B0, 1, 0); PG8_LDB(B1, 1, 1); PG8_SCHED; PG8_LDA(At, 1, 0); PG8_STAGE(PG8_SA(0, 1), a2 + hstep, voffA);
            PG8_WAIT_V(8); PG8_WAIT_L(0); PG8_BAR; PG8_MMA(0, 0, At, B0); PG8_MMA(0, 1, At, B1); PG8_BAR; PG8_SCHED;
            PG8_STAGE(PG8_SB(1, 0), b3, voffB); PG8_STAGE(PG8_SB(1, 1), b3 + hstepB, voffB); PG8_STAGE(PG8_SA(1, 0), a3, voffA);
            PG8_WAIT_V(8); PG8_WAIT_L(0); PG8_BAR; PG8_BAR; PG8_SCHED;
        }
        } else {
        for (int t = 0; t < nt; t += 2) {
            const bool last = (t == nt - 2);
            const char* a1 = cA + (size_t)(t + 1) * kstep;
            const char* a2 = last ? nA : cA + (size_t)(t + 2) * kstep; const char* b2 = last ? nB : cB + (size_t)(t + 2) * kstepB;
            const char* a3 = a2 + kstep; const char* b3 = b2 + kstepB;
            if (last && has_next) S.a_ready(nxt);
            PG8_LDB(B0, 0, 0); PG8_LDB(B1, 0, 1); PG8_SCHED; PG8_LDA(At, 0, 0); PG8_STAGE(PG8_SA(1, 1), a1 + hstep, voffA);
            PG8_WAIT_V(8); PG8_WAIT_L(0); PG8_BAR; PG8_MMA(0, 0, At, B0); PG8_MMA(0, 1, At, B1); PG8_BAR; PG8_SCHED;
            PG8_LDA(At, 0, 1); PG8_STAGE(PG8_SB(0, 0), b2, voffB); PG8_STAGE(PG8_SB(0, 1), b2 + hstepB, voffB); PG8_STAGE(PG8_SA(0, 0), a2, voffA);
            PG8_WAIT_V(8); PG8_WAIT_L(0); PG8_BAR; PG8_MMA(1, 0, At, B0); PG8_MMA(1, 1, At, B1); PG8_BAR; PG8_SCHED;
            PG8_LDB(B0, 1, 0); PG8_LDB(B1, 1, 1); PG8_SCHED; PG8_LDA(At, 1, 0); PG8_STAGE(PG8_SA(0, 1), a2 + hstep, voffA);
            PG8_WAIT_V(8); PG8_WAIT_L(0); PG8_BAR; PG8_MMA(0, 0, At, B0); PG8_MMA(0, 1, At, B1); PG8_BAR; PG8_SCHED;
            PG8_LDA(At, 1, 1); PG8_STAGE(PG8_SB(1, 0), b3, voffB); PG8_STAGE(PG8_SB(1, 1), b3 + hstepB, voffB); PG8_STAGE(PG8_SA(1, 0), a3, voffA);
            PG8_WAIT_V(8); PG8_WAIT_L(0); PG8_BAR; PG8_MMA(1, 0, At, B0); PG8_MMA(1, 1, At, B1); PG8_BAR; PG8_SCHED;
        }
        }
        } else {
        for (int t = 0; t < nt; t += 2) {
            const bool last = (t == nt - 2);
            const char* a1 = cA + (size_t)(t + 1) * kstep;
            const char* a2 = last ? nA : cA + (size_t)(t + 2) * kstep; const char* b2 = last ? nB : cB + (size_t)(t + 2) * kstepB;
            const char* a3 = a2 + kstep; const char* b3 = b2 + kstepB;
            if (last && has_next) S.a_ready(nxt);
            PG8_LDB(B0, 0, 0); PG8_SCHED; PG8_LDA(At, 0, 0); PG8_STAGE(PG8_SA(1, 1), a1 + hstep, voffA);
            PG8_WAIT_L(8); PG8_BAR; PG8_WAIT_L(0); PG8_MMA(0, 0, At, B0); PG8_BAR; PG8_SCHED;
            PG8_LDB(B1, 0, 1); PG8_STAGE(PG8_SB(0, 0), b2, voffB);
            PG8_BAR; PG8_WAIT_L(0); PG8_MMA(0, 1, At, B1); PG8_BAR;
            PG8_LDA(At, 0, 1); PG8_STAGE(PG8_SA(0, 0), a2, voffA);
            PG8_BAR; PG8_WAIT_L(0); PG8_MMA(1, 0, At, B0); PG8_BAR; PG8_SCHED;
            PG8_STAGE(PG8_SB(0, 1), b2 + hstepB, voffB);
            PG8_WAIT_V(6); PG8_BAR; PG8_MMA(1, 1, At, B1); PG8_BAR;
            PG8_LDB(B0, 1, 0); PG8_SCHED; PG8_LDA(At, 1, 0); PG8_STAGE(PG8_SA(0, 1), a2 + hstep, voffA);
            PG8_WAIT_L(8); PG8_BAR; PG8_WAIT_L(0); PG8_MMA(0, 0, At, B0); PG8_BAR; PG8_SCHED;
            PG8_LDB(B1, 1, 1); PG8_STAGE(PG8_SB(1, 0), b3, voffB);
            PG8_BAR; PG8_WAIT_L(0); PG8_MMA(0, 1, At, B1); PG8_BAR;
            PG8_LDA(At, 1, 1); PG8_STAGE(PG8_SA(1, 0), a3, voffA);
            PG8_BAR; PG8_WAIT_L(0); PG8_MMA(1, 0, At, B0); PG8_BAR; PG8_SCHED;
            PG8_STAGE(PG8_SB(1, 1), b3 + hstepB, voffB);
            PG8_WAIT_V(6); PG8_BAR; PG8_MMA(1, 1, At, B1); PG8_BAR;
        }
        }
        if constexpr (ALIGN_EPI) { if (wr == 0) PG8_BAR; }
        if constexpr (!Epi::AFTER_DRAIN) { E(acc, cur, wr, wc, fr, fq, rs8); S.done(cur); }
        if (!has_next) break;
#pragma unroll
        for (int a = 0; a < 2; ++a)
#pragma unroll
            for (int b = 0; b < 2; ++b)
#pragma unroll
                for (int m = 0; m < 4; ++m)
#pragma unroll
                    for (int n = 0; n < 2; ++n) acc[a][b][m][n] = (f32x4){0.f, 0.f, 0.f, 0.f};
        cur = nxt; cA = nA; cB = nB; nt = cur.nkt; ++ui; E.load_rs(cur, wr, fr, rs8);
        if constexpr (ALIGN_EPI) { if (wr == 1) PG8_BAR; }
    }
    PG8_WAIT_V(0);
    if constexpr (!ALIGN_EPI) { if (wr == 0) PG8_BAR; }
    PG8_BAR;
    if constexpr (Epi::AFTER_DRAIN) { E.fused(acc, cur, wr, wc, fr, fq, lds, wid, lane); S.done(cur); }
#undef PG8_SA
#undef PG8_SB
#undef PG8_STAGE
#undef PG8_LDA
#undef PG8_LDB
#undef PG8_MMA
#undef PG8_WAIT_V
#undef PG8_WAIT_L
#undef PG8_BAR
#undef PG8_SCHED
}
}
#define LAS __attribute__((address_space(3)))
#define XB_TMO      128
#define XB_XCNT(j)  (256  + 64 * (j))
#define XB_XSUB(j)  (1280 + 64 * (j))
#define XB_XGEN(j)  (2304 + 64 * (j))
#define XB_TOP      3328
#define XB_TOPGEN   3392
#define XCD_BAR_WORDS 3456
#define XB_SPIN_CAP (1u << 21)

__device__ __forceinline__ unsigned xb_ld(unsigned* p)              { return __hip_atomic_load(p, __ATOMIC_RELAXED, __HIP_MEMORY_SCOPE_AGENT); }
__device__ __forceinline__ unsigned xb_add(unsigned* p, unsigned v) { return __hip_atomic_fetch_add(p, v, __ATOMIC_RELAXED, __HIP_MEMORY_SCOPE_AGENT); }
__device__ __forceinline__ unsigned xb_xcc_id() { return (unsigned)__builtin_amdgcn_s_getreg((3 << 11) | 20) & 0xFu; }
#define XB_SPIN(cond, bar) do { unsigned _sp = 0; while (cond) { __builtin_amdgcn_s_sleep(1); \
    if ((++_sp & 255u) == 0u) { if (xb_ld(&(bar)[XB_TMO])) break; if (_sp > XB_SPIN_CAP) { atomicAdd(&(bar)[XB_TMO], 1u); break; } } } } while (0)

struct XcdBarrier {
    unsigned* bar; unsigned x;
    volatile LAS unsigned* st;
};

__device__ __forceinline__ XcdBarrier xcd_barrier_post(unsigned* bar, volatile LAS unsigned* st) {
    XcdBarrier b; b.bar = bar; b.x = xb_xcc_id(); b.st = st;
    if (threadIdx.x == 0) (void)xb_add(&bar[XB_XCNT(b.x)], 1u);
    return b;
}
__device__ __forceinline__ void xcd_barrier_complete(unsigned* bar, unsigned x, unsigned& nloc, unsigned& nx) {
    const unsigned G = gridDim.x * gridDim.y * gridDim.z;
    unsigned sum, cnt, mine, sp = 0u;
    for (;;) {
        sum = 0u; cnt = 0u; mine = 0u;
#pragma unroll
        for (unsigned j = 0; j < 16; ++j) { const unsigned c = xb_ld(&bar[XB_XCNT(j)]); sum += c; cnt += (c > 0u) ? 1u : 0u; mine = (j == x) ? c : mine; }
        if (sum == G) break;
        __builtin_amdgcn_s_sleep(1);
        if ((++sp & 255u) == 0u) { if (xb_ld(&bar[XB_TMO])) break; if (sp > XB_SPIN_CAP) { atomicAdd(&bar[XB_TMO], 1u); break; } }
    }
    nloc = mine > 0u ? mine : 1u; nx = cnt > 0u ? cnt : 1u;
}

__device__ __forceinline__ void xcd_barrier(const XcdBarrier& b) {
    asm volatile("s_waitcnt vmcnt(0)" ::: "memory");
    __syncthreads();
    if (threadIdx.x == 0) {
        unsigned* bar = b.bar;
        __builtin_amdgcn_s_waitcnt(0);
        unsigned nloc = b.st[0], nx = b.st[1];
        if (nloc == 0u) { xcd_barrier_complete(bar, b.x, nloc, nx); b.st[0] = nloc; b.st[1] = nx; }
        const unsigned old = xb_add(&bar[XB_XSUB(b.x)], 1u);
        const unsigned gen = old / nloc;
        if (old + 1u == (gen + 1u) * nloc) {
            __builtin_amdgcn_fence(__ATOMIC_RELEASE, "agent");
            asm volatile("s_waitcnt vmcnt(0)" ::: "memory");
            const unsigned og = xb_add(&bar[XB_TOP], 1u);
            const unsigned tg = og / nx;
            if (og + 1u == (tg + 1u) * nx) xb_add(&bar[XB_TOPGEN], 1u);
            else XB_SPIN(xb_ld(&bar[XB_TOPGEN]) == tg, bar);
            __builtin_amdgcn_fence(__ATOMIC_ACQUIRE, "agent");
            xb_add(&bar[XB_XGEN(b.x)], 1u);
            asm volatile("s_waitcnt vmcnt(0)" ::: "memory");
        } else {
            XB_SPIN(xb_ld(&bar[XB_XGEN(b.x)]) == gen, bar);
            __builtin_amdgcn_fence(__ATOMIC_ACQUIRE, "agent");
            asm volatile("s_waitcnt vmcnt(0)" ::: "memory");
        }
    }
    __syncthreads();
}

namespace P {
constexpr int D = 4096, SEQ = 4096, BATCH = 2, DEC_B = 8, DEC_S = 16, PAST = 1024;
constexpr int NP = BATCH * SEQ;
constexpr int NS = DEC_B * DEC_S;
constexpr int M = NP + NS;
constexpr int MP = 8448;
constexpr int DA = 2048, DB = 2048, HB = 16, DHB = 128;
constexpr int AB_LD = 10256, AB_N = 10240;
constexpr int HC = 8, DKC = 256, DVC = 512;
constexpr int C_LD = 12304, C_N = 12288;
constexpr int DFF = 11008;
constexpr float EPS = 1e-6f;
constexpr size_t O_YP = 0;
constexpr size_t O_YS = O_YP + (size_t)NP * D;
constexpr size_t O_PK = O_YS + (size_t)NS * D;
constexpr size_t O_PV = O_PK + (size_t)NP * DB;
constexpr size_t O_PLF = O_PV + (size_t)NP * DB;
constexpr size_t O_PC = O_PLF + (size_t)NP * HB;
constexpr size_t O_PN = O_PC + (size_t)BATCH * HC * DKC * DVC;
constexpr size_t O_PM = O_PN + (size_t)BATCH * HC * DKC;
constexpr size_t O_SK = O_PM + (size_t)BATCH * HC;
constexpr size_t O_SV = O_SK + (size_t)NS * DB;
constexpr size_t O_SLF = O_SV + (size_t)NS * DB;
constexpr size_t O_SGV = O_SLF + (size_t)NS * HB;
constexpr size_t O_SC = O_SGV + (size_t)NS * DA;
constexpr size_t O_SN = O_SC + (size_t)DEC_B * HC * DKC * DVC;
constexpr size_t O_SM = O_SN + (size_t)DEC_B * HC * DKC;
constexpr size_t O_END = O_SM + (size_t)DEC_B * HC;
enum { I_XP = 0, I_XS, I_CK, I_CV, I_CLF, I_SC, I_SN, I_SM, I_NMIX, I_NFFN, I_NFIN, I_ABWIN, I_ABWOUT, I_GWS, I_GB, I_FBF, I_CWIN, I_CBI, I_CBF, I_CHN, I_CWOUT, I_FG, I_FU, I_FD, N_IN };
constexpr size_t MiB = 1u << 20;
constexpr size_t WS_CTL = 0, CTL_ZERO_BYTES = 1 * MiB;
constexpr size_t WS_WABIN = 1 * MiB;
constexpr size_t WS_WABF = 81 * MiB;
constexpr size_t WS_WABOUT = 82 * MiB;
constexpr size_t WS_WCIN = 114 * MiB;
constexpr size_t WS_WCIF = 210 * MiB;
constexpr size_t WS_WCOUT = 211 * MiB;
constexpr size_t WS_WGU0 = 243 * MiB;
constexpr size_t WS_WGU1 = 415 * MiB;
constexpr size_t WS_WDN0 = 587 * MiB;
constexpr size_t WS_WDN1 = 673 * MiB;
constexpr size_t WS_H = 759 * MiB;
constexpr size_t WS_Y = 825 * MiB;
constexpr size_t WS_PROJ = 957 * MiB;
constexpr size_t WS_MIX = 1155 * MiB;
constexpr size_t WS_G = 1221 * MiB;
constexpr size_t WS_GATES = 1400 * MiB;
constexpr size_t WS_SLAB = 1401 * MiB;
constexpr size_t WS_GS = 1435 * MiB;
constexpr size_t WS_PB = 1436 * MiB;
constexpr size_t WS_END = 1444 * MiB;
static_assert(WS_WABIN + (size_t)AB_N * D * 2 <= WS_WABF && WS_WCIN + (size_t)C_N * D * 2 <= WS_WCIF && WS_WGU0 + (size_t)2 * DFF * D * 2 <= WS_WGU1 && WS_WGU1 + (size_t)2 * DFF * D * 2 <= WS_WDN0, "ws map 1");
static_assert(WS_WDN0 + (size_t)DFF * D * 2 <= WS_WDN1 && WS_WDN1 + (size_t)DFF * D * 2 <= WS_H && WS_H + (size_t)MP * D * 2 <= WS_Y && WS_Y + (size_t)MP * D * 4 <= WS_PROJ, "ws map 2");
static_assert(WS_PROJ + (size_t)MP * C_N * 2 <= WS_MIX && WS_MIX + (size_t)MP * D * 2 <= WS_G && WS_G + (size_t)MP * DFF * 2 <= WS_END, "ws map 3");
constexpr int CW_BAR = 4096;
constexpr size_t CTL_SSQ = 524288;
constexpr int RING_BYTES = 131072, MISC_OFF = RING_BYTES, LDS_BYTES = 147456;
}

typedef unsigned short bf16_t;
typedef float f32x4 __attribute__((ext_vector_type(4)));
typedef short bf16x8 __attribute__((ext_vector_type(8)));
typedef unsigned u32x4 __attribute__((ext_vector_type(4)));
typedef unsigned u32x2 __attribute__((ext_vector_type(2)));
#define LDS_WAIT() asm volatile("s_waitcnt lgkmcnt(0)" ::: "memory")
#define VM_WAIT() asm volatile("s_waitcnt vmcnt(0)" ::: "memory")
using pg8::cvt_pk_bf16;

__device__ __forceinline__ float wave_sum(float v) {
#pragma unroll
    for (int o = 1; o < 64; o <<= 1) v += __shfl_xor(v, o);
    return v;
}
__device__ __forceinline__ float log_sigmoid_f(float z) { return fminf(z, 0.f) - log1pf(__expf(-fabsf(z))); }

__device__ __forceinline__ void transpose_item(const float* __restrict__ W, int ld, int K, int k0, int n0, int nvalid, bf16_t* __restrict__ WT, int drow0, LAS float* scr, int lane, const float* __restrict__ gain = nullptr) {
    const int nn = lane & 31, ncl = nn < nvalid ? nn : nvalid - 1;
    float wv[32];
#pragma unroll
    for (int i = 0; i < 32; ++i) wv[i] = W[(size_t)(k0 + 2 * i + (lane >> 5)) * ld + n0 + ncl];
#pragma unroll
    for (int i = 0; i < 32; ++i) scr[(2 * i + (lane >> 5)) * 33 + nn] = wv[i];
    LDS_WAIT();
    const int c = lane & 7;
    f32x4 g0 = {1.f, 1.f, 1.f, 1.f}, g1 = {1.f, 1.f, 1.f, 1.f};
    if (gain) { g0 = *(const f32x4*)(gain + k0 + 8 * c); g1 = *(const f32x4*)(gain + k0 + 8 * c + 4); }
#pragma unroll
    for (int j = 0; j < 4; ++j) { const int n = (lane >> 3) + 8 * j; const LAS float* s = scr + (8 * c) * 33 + n;
        u32x4 o; o.x = cvt_pk_bf16(s[0 * 33] * g0[0], s[1 * 33] * g0[1]); o.y = cvt_pk_bf16(s[2 * 33] * g0[2], s[3 * 33] * g0[3]); o.z = cvt_pk_bf16(s[4 * 33] * g1[0], s[5 * 33] * g1[1]); o.w = cvt_pk_bf16(s[6 * 33] * g1[2], s[7 * 33] * g1[3]);
        if (n < nvalid) *(u32x4*)(WT + (size_t)(drow0 + n) * K + k0 + 8 * c) = o; }
    LDS_WAIT();
}

struct Ctx {
    const float* const* in; float* out; unsigned char* ws;
    int tid, lane, wave, gw, ngw, G;
};


struct SplitOrder {
    pg8::StaticOrder Pm; int nfull, nmini, S, G, c, b, e;
    __device__ void init(int N, int K, int S_, int G_, int c_) { Pm.init(P::NP, N, K, G_, c_); nfull = Pm.nwg; S = S_; nmini = (N / 256) * S_; G = G_; c = c_;
        const int kt = K / 64; b = (kt / S_) & ~1; e = (kt - S_ * b) / 2; }
    __device__ bool next(int i, pg8::Unit& u) const {
        const int L = i * G + c;
        if (L < nfull) return Pm.next(i, u);
        const int j = L - nfull; if (j >= nmini) return false;
        const int pn = j / S, s = j - pn * S;
        u.pm = P::NP / 256; u.pn = pn; u.kt0 = s * b + 2 * (s < e ? s : e); u.nkt = b + (s < e ? 2 : 0); u.slab = j; return true;
    }
    __device__ __forceinline__ void a_ready(const pg8::Unit&) const {}
    __device__ __forceinline__ void done(const pg8::Unit&) const {}
};

template <int CW> struct CvVec;
template <> struct CvVec<4> { typedef f32x4 T; };
template <> struct CvVec<2> { typedef float T __attribute__((ext_vector_type(2))); };
template <> struct CvVec<1> { typedef float T; };
__device__ __forceinline__ float cv_el(const f32x4& v, int e) { return v[e]; }
__device__ __forceinline__ float cv_el(const CvVec<2>::T& v, int e) { return v[e]; }
__device__ __forceinline__ float cv_el(const float& v, int) { return v; }
template <int CW, int NBLK, int LD>
__device__ __forceinline__ void cv_load(const float* __restrict__ src, int r, int lane, typename CvVec<CW>::T (&v)[8]) {
    const int o = r / NBLK, nb = r - o * NBLK;
    const float* p = src + (size_t)(8 * o) * LD + 64 * CW * nb + CW * lane;
#pragma unroll
    for (int j = 0; j < 8; ++j) v[j] = *(const typename CvVec<CW>::T*)(p + (size_t)j * LD);
}
template <int CW, int NBLK, int KOCT, int MODE>
__device__ __forceinline__ void cv_store(bf16_t* __restrict__ dst, const float* __restrict__ gain, int r, int lane, const typename CvVec<CW>::T (&v)[8]) {
    const int o = r / NBLK, nb = r - o * NBLK;
    float g[8];
#pragma unroll
    for (int j = 0; j < 8; ++j) g[j] = gain ? gain[8 * o + j] : 1.0f;
    const int n = 64 * CW * nb + CW * lane, np = MODE == 0 ? n : 256 * (n >> 7) + (n & 127) + (MODE == 2 ? 128 : 0);
    u32x4* q = (u32x4*)(dst + (((size_t)(np >> 8) * KOCT + o) * 256 + (np & 255)) * 8);
#pragma unroll
    for (int e = 0; e < CW; ++e) { u32x4 w; w.x = cvt_pk_bf16(cv_el(v[0], e) * g[0], cv_el(v[1], e) * g[1]); w.y = cvt_pk_bf16(cv_el(v[2], e) * g[2], cv_el(v[3], e) * g[3]); w.z = cvt_pk_bf16(cv_el(v[4], e) * g[4], cv_el(v[5], e) * g[5]); w.w = cvt_pk_bf16(cv_el(v[6], e) * g[6], cv_el(v[7], e) * g[7]); q[e] = w; }
}
template <int CW, int JOB> struct CvJob {
    static constexpr int CB = 64 * CW;
    static constexpr int COUNT = JOB == 0 ? (P::D / 8) * (P::AB_N / CB) : JOB == 1 ? (P::D / 8) * (P::C_N / CB) : (JOB == 2 || JOB == 6) ? (P::D / 8) * (P::D / CB) : (JOB == 5 || JOB == 9) ? (P::DFF / 8) * (P::D / CB) : (P::D / 8) * (P::DFF / CB);
    static __device__ __forceinline__ void load(const Ctx& C, int r, typename CvVec<CW>::T (&v)[8]) {
        using namespace P;
        if (JOB == 0) cv_load<CW, AB_N / CB, AB_LD>(C.in[I_ABWIN], r, C.lane, v);
        else if (JOB == 1) cv_load<CW, C_N / CB, C_LD>(C.in[I_CWIN], r, C.lane, v);
        else if (JOB == 2) cv_load<CW, D / CB, D>(C.in[I_ABWOUT], r, C.lane, v);
        else if (JOB == 6) cv_load<CW, D / CB, D>(C.in[I_CWOUT], r, C.lane, v);
        else if (JOB == 3 || JOB == 7) cv_load<CW, DFF / CB, DFF>(C.in[I_FG] + (size_t)(JOB == 7) * D * DFF, r, C.lane, v);
        else if (JOB == 4 || JOB == 8) cv_load<CW, DFF / CB, DFF>(C.in[I_FU] + (size_t)(JOB == 8) * D * DFF, r, C.lane, v);
        else cv_load<CW, D / CB, D>(C.in[I_FD] + (size_t)(JOB == 9) * DFF * D, r, C.lane, v);
    }
    static __device__ __forceinline__ void store(const Ctx& C, int r, const typename CvVec<CW>::T (&v)[8]) {
        using namespace P; unsigned char* ws = C.ws;
        if (JOB == 0) cv_store<CW, AB_N / CB, D / 8, 0>((bf16_t*)(ws + WS_WABIN), C.in[I_NMIX], r, C.lane, v);
        else if (JOB == 1) cv_store<CW, C_N / CB, D / 8, 0>((bf16_t*)(ws + WS_WCIN), C.in[I_NMIX] + D, r, C.lane, v);
        else if (JOB == 2) cv_store<CW, D / CB, D / 8, 0>((bf16_t*)(ws + WS_WABOUT), nullptr, r, C.lane, v);
        else if (JOB == 6) cv_store<CW, D / CB, D / 8, 0>((bf16_t*)(ws + WS_WCOUT), nullptr, r, C.lane, v);
        else if (JOB == 3 || JOB == 7) cv_store<CW, DFF / CB, D / 8, 1>((bf16_t*)(ws + (JOB == 7 ? WS_WGU1 : WS_WGU0)), C.in[I_NFFN] + (size_t)(JOB == 7) * D, r, C.lane, v);
        else if (JOB == 4 || JOB == 8) cv_store<CW, DFF / CB, D / 8, 2>((bf16_t*)(ws + (JOB == 8 ? WS_WGU1 : WS_WGU0)), C.in[I_NFFN] + (size_t)(JOB == 8) * D, r, C.lane, v);
        else cv_store<CW, D / CB, DFF / 8, 0>((bf16_t*)(ws + (JOB == 9 ? WS_WDN1 : WS_WDN0)), nullptr, r, C.lane, v);
    }
};
template <int CW_, int... JOBS> struct CvList;
template <int CW_> struct CvList<CW_> { static constexpr int CW = CW_, COUNT = 0;
    static __device__ __forceinline__ void load(const Ctx&, int, typename CvVec<CW_>::T (&)[8]) {}
    static __device__ __forceinline__ void store(const Ctx&, int, const typename CvVec<CW_>::T (&)[8]) {} };
template <int CW_, int J, int... REST> struct CvList<CW_, J, REST...> { static constexpr int CW = CW_, COUNT = CvJob<CW_, J>::COUNT + CvList<CW_, REST...>::COUNT;
    static __device__ __forceinline__ void load(const Ctx& C, int r, typename CvVec<CW_>::T (&v)[8]) { if (r < CvJob<CW_, J>::COUNT) CvJob<CW_, J>::load(C, r, v); else CvList<CW_, REST...>::load(C, r - CvJob<CW_, J>::COUNT, v); }
    static __device__ __forceinline__ void store(const Ctx& C, int r, const typename CvVec<CW_>::T (&v)[8]) { if (r < CvJob<CW_, J>::COUNT) CvJob<CW_, J>::store(C, r, v); else CvList<CW_, REST...>::store(C, r - CvJob<CW_, J>::COUNT, v); } };
template <class L> struct Bg { int next, cur; typename CvVec<L::CW>::T v[8]; };
template <class L> __device__ __forceinline__ void bg_issue(const Ctx& C, Bg<L>& b) { if (b.cur < 0 && b.next < L::COUNT) { L::load(C, b.next, b.v); b.cur = b.next; b.next += C.ngw; } }
template <class L> __device__ __forceinline__ void bg_commit(const Ctx& C, Bg<L>& b) { if (b.cur >= 0) { L::store(C, b.cur, b.v); b.cur = -1; } }
template <class L> __device__ __forceinline__ void bg_drain(const Ctx& C, Bg<L>& b) { bg_commit(C, b); while (b.next < L::COUNT) { bg_issue(C, b); bg_commit(C, b); } }
typedef CvList<4, 0, 1, 2, 3, 4, 5, 6, 7, 8, 9> CvL0;

__device__ __forceinline__ float rstd_of(float ssq) { return __builtin_amdgcn_rsqf(ssq * (1.0f / P::D) + P::EPS); }
__device__ __forceinline__ void xrow_to_bf16(const float* __restrict__ xrow, bf16_t* __restrict__ yrow, float* __restrict__ ssq, int lane) {
    const f32x4* xr = (const f32x4*)xrow + lane; u32x2* o = (u32x2*)yrow + lane; float s = 0.f;
#pragma unroll
    for (int j = 0; j < 16; ++j) { const f32x4 v = xr[64 * j]; s += (v.x * v.x + v.y * v.y) + (v.z * v.z + v.w * v.w); u32x2 w; w.x = cvt_pk_bf16(v.x, v.y); w.y = cvt_pk_bf16(v.z, v.w); o[64 * j] = w; }
    s = wave_sum(s); if (lane == 0) *ssq = s;
}
__device__ __forceinline__ void final_row(const bf16_t* __restrict__ yrow, float rstd, const float* __restrict__ gain, float* __restrict__ orow, int lane) {
    const u32x2* yr = (const u32x2*)yrow + lane; const f32x4* gr = (const f32x4*)gain + lane; f32x4* o = (f32x4*)orow + lane;
#pragma unroll
    for (int j = 0; j < 16; ++j) { const u32x2 w = yr[64 * j]; const f32x4 g = gr[64 * j];
        f32x4 v; v.x = __uint_as_float(w.x << 16) * rstd * g.x; v.y = __uint_as_float(w.x & 0xffff0000u) * rstd * g.y; v.z = __uint_as_float(w.y << 16) * rstd * g.z; v.w = __uint_as_float(w.y & 0xffff0000u) * rstd * g.w; __builtin_nontemporal_store(v, &o[64 * j]); }
}

__device__ __forceinline__ f32x4 gate_tile_part(const bf16_t* __restrict__ H, const bf16_t* __restrict__ Wg, int row0, int k0, int lane) {
    const bf16x8* a = (const bf16x8*)(H + (size_t)(row0 + (lane & 15)) * P::D + k0 + 8 * (lane >> 4));
    const bf16x8* b = (const bf16x8*)(Wg + (size_t)(lane & 15) * P::D + k0 + 8 * (lane >> 4));
    f32x4 acc = {0.f, 0.f, 0.f, 0.f};
#pragma unroll
    for (int kk = 0; kk < 16; ++kk) acc = __builtin_amdgcn_mfma_f32_16x16x32_bf16(a[4 * kk], b[4 * kk], acc, 0, 0, 0);
    return acc;
}
__device__ __forceinline__ f32x4 gate_tile(const bf16_t* __restrict__ H, const bf16_t* __restrict__ Wg, int row0, int lane) {
    const bf16x8* a = (const bf16x8*)(H + (size_t)(row0 + (lane & 15)) * P::D + 8 * (lane >> 4));
    const bf16x8* b = (const bf16x8*)(Wg + (size_t)(lane & 15) * P::D + 8 * (lane >> 4));
    f32x4 acc = {0.f, 0.f, 0.f, 0.f};
#pragma unroll 8
    for (int kk = 0; kk < P::D / 32; ++kk) acc = __builtin_amdgcn_mfma_f32_16x16x32_bf16(a[4 * kk], b[4 * kk], acc, 0, 0, 0);
    return acc;
}

struct EpiAbIn {
    static constexpr bool PERM = true, AFTER_DRAIN = false;
    bf16_t* proj; float* out; float* slab; const float* ssq;
    __device__ __forceinline__ void load_rs(const pg8::Unit& u, int wr, int fr, float (&q)[8]) const {
        if (u.slab >= 0) return;
        const float* sp = ssq + u.pm * 256 + wr * 64 + fr;
#pragma unroll
        for (int ai = 0; ai < 2; ++ai)
#pragma unroll
            for (int m = 0; m < 4; ++m) asm volatile("global_load_dword %0, %1, off offset:%2" : "=v"(q[4 * ai + m]) : "v"(sp), "i"((ai * 128 + m * 16) * 4) : "memory");
    }
    __device__ __forceinline__ void operator()(const f32x4 (&acc)[2][2][4][2], const pg8::Unit& u, int wr, int wc, int fr, int fq, const float (&q)[8]) const {
        using namespace P;
        if (u.slab >= 0) {
            float* sp = slab + (size_t)u.slab * 32768 + (size_t)(wr * 64 + fr) * 256 + wc * 32 + 8 * fq;
#pragma unroll
            for (int m = 0; m < 4; ++m)
#pragma unroll
                for (int bj = 0; bj < 2; ++bj) { *(f32x4*)(sp + m * 16 * 256 + bj * 128) = acc[0][bj][m][0]; *(f32x4*)(sp + m * 16 * 256 + bj * 128 + 4) = acc[0][bj][m][1]; }
            return;
        }
        const int seg = u.pn >> 3;
        const int row0 = u.pm * 256 + wr * 64 + fr, col0 = u.pn * 256 + wc * 32 + 8 * fq, cseg = col0 - seg * 2048;
#pragma unroll
        for (int ai = 0; ai < 2; ++ai)
#pragma unroll
            for (int m = 0; m < 4; ++m) { const int row = row0 + ai * 128 + m * 16; bf16_t* rp = proj + (size_t)row * AB_N + col0;
                float* fo = nullptr;
                if (seg == 3) fo = out + O_PK + (size_t)row * DB + cseg; else if (seg == 4) fo = out + O_PV + (size_t)row * DB + cseg;
                const float rs = rstd_of(q[4 * ai + m]);
#pragma unroll
                for (int bj = 0; bj < 2; ++bj) { const f32x4 v0 = acc[ai][bj][m][0] * rs, v1 = acc[ai][bj][m][1] * rs;
                    u32x4 w; w.x = cvt_pk_bf16(v0[0], v0[1]); w.y = cvt_pk_bf16(v0[2], v0[3]); w.z = cvt_pk_bf16(v1[0], v1[1]); w.w = cvt_pk_bf16(v1[2], v1[3]);
                    *(u32x4*)(rp + bj * 128) = w;
                    if (fo) { __builtin_nontemporal_store(v0, (f32x4*)(fo + bj * 128)); __builtin_nontemporal_store(v1, (f32x4*)(fo + bj * 128 + 4)); } } }
    }
};

struct EpiResid {
    static constexpr bool PERM = true, AFTER_DRAIN = false;
    bf16_t* Yb; float* slab; float* ssq;
    __device__ __forceinline__ void load_rs(const pg8::Unit&, int, int, float (&)[8]) const {}
    __device__ __forceinline__ void operator()(const f32x4 (&acc)[2][2][4][2], const pg8::Unit& u, int wr, int wc, int fr, int fq, const float (&)[8]) const {
        using namespace P;
        if (u.slab >= 0) {
            float* sp = slab + (size_t)u.slab * 32768 + (size_t)(wr * 64 + fr) * 256 + wc * 32 + 8 * fq;
#pragma unroll
            for (int m = 0; m < 4; ++m)
#pragma unroll
                for (int bj = 0; bj < 2; ++bj) { *(f32x4*)(sp + m * 16 * 256 + bj * 128) = acc[0][bj][m][0]; *(f32x4*)(sp + m * 16 * 256 + bj * 128 + 4) = acc[0][bj][m][1]; }
            return;
        }
        const int row0 = u.pm * 256 + wr * 64 + fr, col0 = u.pn * 256 + wc * 32 + 8 * fq;
#pragma unroll
        for (int ai = 0; ai < 2; ++ai)
#pragma unroll
            for (int m = 0; m < 4; ++m) { const int row = row0 + ai * 128 + m * 16; bf16_t* __restrict__ yp = Yb + (size_t)row * D + col0;
                u32x4 b[2];
#pragma unroll
                for (int bj = 0; bj < 2; ++bj) b[bj] = *(const u32x4*)(yp + bj * 128);
                float ss = 0.f;
#pragma unroll
                for (int bj = 0; bj < 2; ++bj) { f32x4 y0 = acc[ai][bj][m][0], y1 = acc[ai][bj][m][1];
                    y0[0] += __uint_as_float(b[bj].x << 16); y0[1] += __uint_as_float(b[bj].x & 0xffff0000u); y0[2] += __uint_as_float(b[bj].y << 16); y0[3] += __uint_as_float(b[bj].y & 0xffff0000u);
                    y1[0] += __uint_as_float(b[bj].z << 16); y1[1] += __uint_as_float(b[bj].z & 0xffff0000u); y1[2] += __uint_as_float(b[bj].w << 16); y1[3] += __uint_as_float(b[bj].w & 0xffff0000u);
                    ss += (y0[0] * y0[0] + y0[1] * y0[1]) + (y0[2] * y0[2] + y0[3] * y0[3]) + (y1[0] * y1[0] + y1[1] * y1[1]) + (y1[2] * y1[2] + y1[3] * y1[3]);
                    u32x4 w; w.x = cvt_pk_bf16(y0[0], y0[1]); w.y = cvt_pk_bf16(y0[2], y0[3]); w.z = cvt_pk_bf16(y1[0], y1[1]); w.w = cvt_pk_bf16(y1[2], y1[3]);
                    *(u32x4*)(yp + bj * 128) = w; }
                ss += __shfl_xor(ss, 16); ss += __shfl_xor(ss, 32);
                if (fq == 0) atomicAdd(ssq + row, ss); }
    }
};
struct EpiSwiGLU {
    static constexpr bool PERM = true, AFTER_DRAIN = false;
    bf16_t* G; float* slab; const float* ssq;
    __device__ __forceinline__ void load_rs(const pg8::Unit& u, int wr, int fr, float (&q)[8]) const {
        if (u.slab >= 0) return;
        const float* sp = ssq + u.pm * 256 + wr * 64 + fr;
#pragma unroll
        for (int ai = 0; ai < 2; ++ai)
#pragma unroll
            for (int m = 0; m < 4; ++m) asm volatile("global_load_dword %0, %1, off offset:%2" : "=v"(q[4 * ai + m]) : "v"(sp), "i"((ai * 128 + m * 16) * 4) : "memory");
    }
    __device__ __forceinline__ void operator()(const f32x4 (&acc)[2][2][4][2], const pg8::Unit& u, int wr, int wc, int fr, int fq, const float (&q)[8]) const {
        using namespace P;
        if (u.slab >= 0) {
            float* sp = slab + (size_t)u.slab * 32768 + (size_t)(wr * 64 + fr) * 256 + wc * 32 + 8 * fq;
#pragma unroll
            for (int m = 0; m < 4; ++m)
#pragma unroll
                for (int bj = 0; bj < 2; ++bj) { *(f32x4*)(sp + m * 16 * 256 + bj * 128) = acc[0][bj][m][0]; *(f32x4*)(sp + m * 16 * 256 + bj * 128 + 4) = acc[0][bj][m][1]; }
            return;
        }
        const int row0 = u.pm * 256 + wr * 64 + fr, col0 = u.pn * 128 + wc * 32 + 8 * fq;
#pragma unroll
        for (int ai = 0; ai < 2; ++ai)
#pragma unroll
            for (int m = 0; m < 4; ++m) { const int row = row0 + ai * 128 + m * 16; float o[8]; const float rs = rstd_of(q[4 * ai + m]);
#pragma unroll
                for (int n = 0; n < 2; ++n)
#pragma unroll
                    for (int j = 0; j < 4; ++j) { const float gt = acc[ai][0][m][n][j] * rs, up = acc[ai][1][m][n][j] * rs;
                        o[4 * n + j] = gt * __builtin_amdgcn_rcpf(1.0f + __builtin_amdgcn_exp2f(-1.4426950408889634f * gt)) * up; }
                u32x4 w; w.x = cvt_pk_bf16(o[0], o[1]); w.y = cvt_pk_bf16(o[2], o[3]); w.z = cvt_pk_bf16(o[4], o[5]); w.w = cvt_pk_bf16(o[6], o[7]);
                *(u32x4*)(G + (size_t)row * DFF + col0) = w; }
    }
};
struct EpiBf16Plain {
    static constexpr bool PERM = true, AFTER_DRAIN = false;
    bf16_t* O; int ldc; float* slab; const float* ssq;
    __device__ __forceinline__ void load_rs(const pg8::Unit& u, int wr, int fr, float (&q)[8]) const {
        if (u.slab >= 0) return;
        const float* sp = ssq + u.pm * 256 + wr * 64 + fr;
#pragma unroll
        for (int ai = 0; ai < 2; ++ai)
#pragma unroll
            for (int m = 0; m < 4; ++m) asm volatile("global_load_dword %0, %1, off offset:%2" : "=v"(q[4 * ai + m]) : "v"(sp), "i"((ai * 128 + m * 16) * 4) : "memory");
    }
    __device__ __forceinline__ void operator()(const f32x4 (&acc)[2][2][4][2], const pg8::Unit& u, int wr, int wc, int fr, int fq, const float (&q)[8]) const {
        if (u.slab >= 0) {
            float* sp = slab + (size_t)u.slab * 32768 + (size_t)(wr * 64 + fr) * 256 + wc * 32 + 8 * fq;
#pragma unroll
            for (int m = 0; m < 4; ++m)
#pragma unroll
                for (int bj = 0; bj < 2; ++bj) { *(f32x4*)(sp + m * 16 * 256 + bj * 128) = acc[0][bj][m][0]; *(f32x4*)(sp + m * 16 * 256 + bj * 128 + 4) = acc[0][bj][m][1]; }
            return;
        }
        const int row0 = u.pm * 256 + wr * 64 + fr, col0 = u.pn * 256 + wc * 32 + 8 * fq;
#pragma unroll
        for (int ai = 0; ai < 2; ++ai)
#pragma unroll
            for (int m = 0; m < 4; ++m) { bf16_t* rp = O + (size_t)(row0 + ai * 128 + m * 16) * ldc + col0; const float rs = rstd_of(q[4 * ai + m]);
#pragma unroll
                for (int bj = 0; bj < 2; ++bj) { const f32x4 v0 = acc[ai][bj][m][0] * rs, v1 = acc[ai][bj][m][1] * rs;
                    u32x4 w; w.x = cvt_pk_bf16(v0[0], v0[1]); w.y = cvt_pk_bf16(v0[2], v0[3]); w.z = cvt_pk_bf16(v1[0], v1[1]); w.w = cvt_pk_bf16(v1[2], v1[3]);
                    *(u32x4*)(rp + bj * 128) = w; } }
    }
};

template <bool FINAL>
__device__ __forceinline__ void sample_row_wg(const Ctx& C, LAS unsigned char* lds, const float* __restrict__ slab, int r, const float* xs, bf16_t* yrow, float* ssq_out, const float* __restrict__ gain, float* orow) {
    f32x4 v[2]; float ss = 0.f; LAS float* red = (LAS float*)lds;
#pragma unroll
    for (int jj = 0; jj < 2; ++jj) { const int j = 2 * C.wave + jj; f32x4 a;
        if (xs) a = ((const f32x4*)xs)[64 * j + C.lane];
        else { const u32x2 w = ((const u32x2*)yrow)[64 * j + C.lane]; a.x = __uint_as_float(w.x << 16); a.y = __uint_as_float(w.x & 0xffff0000u); a.z = __uint_as_float(w.y << 16); a.w = __uint_as_float(w.y & 0xffff0000u); }
        const float* sp = slab + (size_t)(j * 16) * 32768 + (size_t)r * 256 + 4 * C.lane; f32x4 p[16];
#pragma unroll
        for (int s = 0; s < 16; ++s) p[s] = *(const f32x4*)(sp + (size_t)s * 32768);
#pragma unroll
        for (int s = 0; s < 16; ++s) a = a + p[s];
        v[jj] = a; ss += (a.x * a.x + a.y * a.y) + (a.z * a.z + a.w * a.w);
        if (!FINAL) { u32x2 w; w.x = cvt_pk_bf16(a.x, a.y); w.y = cvt_pk_bf16(a.z, a.w); ((u32x2*)yrow)[64 * j + C.lane] = w; } }
    ss = wave_sum(ss);
    __syncthreads();
    if (C.lane == 0) red[C.wave] = ss;
    __syncthreads();
    float tot = 0.f;
#pragma unroll
    for (int w = 0; w < 8; ++w) tot += red[w];
    if (!FINAL) { if (C.tid == 0) *ssq_out = tot; }
    else { const float rr = rstd_of(tot);
#pragma unroll
        for (int jj = 0; jj < 2; ++jj) { const int j = 2 * C.wave + jj; const f32x4 g = ((const f32x4*)gain)[64 * j + C.lane]; ((f32x4*)orow)[64 * j + C.lane] = v[jj] * rr * g; } }
}
template <bool LAYER0>
__device__ __forceinline__ void combine_inproj(const Ctx& C, const float* __restrict__ slab, bf16_t* __restrict__ PROJ, const float* __restrict__ ssq) {
    using namespace P;
    constexpr int NT = LAYER0 ? AB_N / 256 : C_N / 256, S = LAYER0 ? 6 : 5, LD = LAYER0 ? AB_N : C_N;
    for (int it = C.gw; it < 128 * NT; it += C.ngw) { const int r = it / NT, pn = it - r * NT;
        f32x4 a = {0.f, 0.f, 0.f, 0.f};
#pragma unroll
        for (int s = 0; s < S; ++s) a = a + *(const f32x4*)(slab + (size_t)(pn * S + s) * 32768 + (size_t)r * 256 + 4 * C.lane);
        a = a * rstd_of(ssq[NP + r]);
        const int col = pn * 256 + 4 * C.lane; u32x2 w; w.x = cvt_pk_bf16(a[0], a[1]); w.y = cvt_pk_bf16(a[2], a[3]);
        *(u32x2*)(PROJ + (size_t)(NP + r) * LD + col) = w;
        if (LAYER0) { const int seg = pn >> 3, cseg = col - seg * 2048;
            if (seg == 1) *(f32x4*)(C.out + O_SGV + (size_t)r * DA + cseg) = a;
            else if (seg == 3) *(f32x4*)(C.out + O_SK + (size_t)r * DB + cseg) = a;
            else if (seg == 4) *(f32x4*)(C.out + O_SV + (size_t)r * DB + cseg) = a; }
    }
}
__device__ __forceinline__ void combine_swiglu(const Ctx& C, const float* __restrict__ slab, bf16_t* __restrict__ G, const float* __restrict__ ssq) {
    using namespace P;
    typedef float f32x2 __attribute__((ext_vector_type(2)));
    constexpr int NT = DFF / 128, S = 3;
    for (int it = C.gw; it < 128 * NT; it += C.ngw) { const int r = it / NT, pn = it - r * NT;
        f32x2 g = {0.f, 0.f}, u = {0.f, 0.f};
#pragma unroll
        for (int s = 0; s < S; ++s) { const float* sp = slab + (size_t)(pn * S + s) * 32768 + (size_t)r * 256 + 2 * C.lane; g = g + *(const f32x2*)sp; u = u + *(const f32x2*)(sp + 128); }
        { const float rs = rstd_of(ssq[NP + r]); g = g * rs; u = u * rs; }
        const float o0 = g.x * __builtin_amdgcn_rcpf(1.0f + __builtin_amdgcn_exp2f(-1.4426950408889634f * g.x)) * u.x, o1 = g.y * __builtin_amdgcn_rcpf(1.0f + __builtin_amdgcn_exp2f(-1.4426950408889634f * g.y)) * u.y;
        *(unsigned*)(G + (size_t)(NP + r) * DFF + pn * 128 + 2 * C.lane) = cvt_pk_bf16(o0, o1);
    }
}

typedef short v4i16 __attribute__((ext_vector_type(4)));
__device__ __forceinline__ v4i16 tr16(LAS unsigned char* p) { return __builtin_amdgcn_ds_read_tr16_b64_v4i16((LAS v4i16*)p); }
__device__ __forceinline__ bf16x8 cat44(v4i16 lo, v4i16 hi) { bf16x8 r; r[0] = lo[0]; r[1] = lo[1]; r[2] = lo[2]; r[3] = lo[3]; r[4] = hi[0]; r[5] = hi[1]; r[6] = hi[2]; r[7] = hi[3]; return r; }
__device__ __forceinline__ bf16x8 pack8f(f32x4 a, f32x4 b) { u32x4 w; w.x = cvt_pk_bf16(a[0], a[1]); w.y = cvt_pk_bf16(a[2], a[3]); w.z = cvt_pk_bf16(b[0], b[1]); w.w = cvt_pk_bf16(b[2], b[3]); return __builtin_bit_cast(bf16x8, w); }

namespace AT {
constexpr int KT = 0, VT = 17408, TBUF = 34816, CK = 69632, SCAN = 86272, TSTR = 272;
constexpr float C2 = 0.12751743f;
constexpr float LOG2E = 1.4426950408889634f;
}

template <bool SAMPLE>
__device__ __forceinline__ void attn_prepare_ck(const Ctx& C, LAS unsigned char* lds, int b, int h) {
    using namespace P;
    LAS float* ck = (LAS float*)(lds + AT::CK); LAS float* scan = (LAS float*)(lds + AT::SCAN);
    constexpr int n = SAMPLE ? PAST + DEC_S : SEQ;
    float v[8]; const int t0 = 8 * C.tid;
#pragma unroll
    for (int j = 0; j < 8; ++j) { const int t = t0 + j; float x = 0.f;
        if (t < n) { if (!SAMPLE) x = C.out[O_PLF + ((size_t)b * SEQ + t) * HB + h];
                     else x = t < PAST ? C.in[I_CLF][((size_t)b * PAST + t) * HB + h] : C.out[O_SLF + ((size_t)b * DEC_S + (t - PAST)) * HB + h]; }
        v[j] = x; }
#pragma unroll
    for (int j = 1; j < 8; ++j) v[j] += v[j - 1];
    const float tot = v[7]; float x = tot;
#pragma unroll
    for (int o = 1; o < 64; o <<= 1) { const float y = __shfl_up(x, o); if (C.lane >= o) x += y; }
    if (C.lane == 63) scan[C.wave] = x;
    __syncthreads();
    float base = 0.f;
    for (int w = 0; w < C.wave; ++w) base += scan[w];
    const float excl = base + x - tot;
#pragma unroll
    for (int j = 0; j < 8; ++j) if (t0 + j < n + 64) ck[t0 + j] = (excl + v[j]) * AT::LOG2E;
    __syncthreads();
}

template <bool SAMPLE>
__device__ __forceinline__ void attn_load_tile(const Ctx& C, const bf16_t* __restrict__ PROJ, int b, int h, int j, bf16x8 (&kreg)[2], bf16x8 (&vreg)[2]) {
    using namespace P;
#pragma unroll
    for (int i = 0; i < 2; ++i) { const int id = C.tid + 512 * i, r = id >> 4, ch = id & 15;
        if (!SAMPLE) { const bf16_t* p = PROJ + (size_t)(b * SEQ + 64 * j + r) * AB_N + h * DHB + 8 * ch;
            kreg[i] = *(const bf16x8*)(p + 3 * 2048); vreg[i] = *(const bf16x8*)(p + 4 * 2048); }
        else { const int kidx = 64 * j + r;
            if (kidx < PAST) { const size_t o = (((size_t)b * PAST + kidx) * HB + h) * DHB + 8 * ch; const float* kp = C.in[I_CK] + o; const float* vp = C.in[I_CV] + o;
                kreg[i] = pack8f(*(const f32x4*)kp, *(const f32x4*)(kp + 4)); vreg[i] = pack8f(*(const f32x4*)vp, *(const f32x4*)(vp + 4)); }
            else if (kidx < PAST + DEC_S) { const bf16_t* p = PROJ + (size_t)(NP + b * DEC_S + (kidx - PAST)) * AB_N + h * DHB + 8 * ch;
                kreg[i] = *(const bf16x8*)(p + 3 * 2048); vreg[i] = *(const bf16x8*)(p + 4 * 2048); }
            else { kreg[i] = (bf16x8){0, 0, 0, 0, 0, 0, 0, 0}; vreg[i] = (bf16x8){0, 0, 0, 0, 0, 0, 0, 0}; } }
    }
}

template <bool SAMPLE>
__device__ __forceinline__ void attn_qblock(const Ctx& C, LAS unsigned char* lds, const bf16_t* __restrict__ PROJ, bf16_t* __restrict__ MIX, int b, int h, int qb) {
    using namespace P;
    const int fr = C.lane & 15, fq = C.lane >> 4;
    const bool active = SAMPLE ? (C.wave == 0) : true;
    const int qpos0 = SAMPLE ? PAST : 256 * qb + 32 * C.wave;
    const int qrow0 = SAMPLE ? NP + b * DEC_S : b * SEQ + qpos0;
    const int ntiles = SAMPLE ? (PAST + DEC_S + 63) / 64 : 4 * qb + 4;
    LAS float* ck = (LAS float*)(lds + AT::CK);
    bf16x8 qf[2][4]; float cq2[2], mrow[2], lrow[2]; int qpos[2];
    f32x4 oacc[2][8];
#pragma unroll
    for (int qt = 0; qt < 2; ++qt) {
#pragma unroll
        for (int kk = 0; kk < 4; ++kk) qf[qt][kk] = *(const bf16x8*)(PROJ + (size_t)(qrow0 + 16 * qt + fr) * AB_N + 2 * 2048 + h * DHB + 32 * kk + 8 * fq);
        qpos[qt] = qpos0 + 16 * qt + fr; cq2[qt] = ck[qpos[qt]]; mrow[qt] = -1e30f; lrow[qt] = 0.f;
#pragma unroll
        for (int c = 0; c < 8; ++c) oacc[qt][c] = (f32x4){0.f, 0.f, 0.f, 0.f};
    }
    bf16x8 kreg[2], vreg[2];
    attn_load_tile<SAMPLE>(C, PROJ, b, h, ntiles - 1, kreg, vreg);
#define ATTN_STEP(IT, TBOFF) do { const int j = ntiles - 1 - (IT); LAS unsigned char* tb = lds + (TBOFF); \
_Pragma("unroll") \
        for (int i = 0; i < 2; ++i) { const int id = C.tid + 512 * i, r = id >> 4, ch = id & 15; \
            *(LAS bf16x8*)(tb + AT::KT + r * AT::TSTR + ch * 16) = kreg[i]; *(LAS bf16x8*)(tb + AT::VT + r * AT::TSTR + ch * 16) = vreg[i]; } \
        __syncthreads(); \
        if (j > 0) attn_load_tile<SAMPLE>(C, PROJ, b, h, j - 1, kreg, vreg); \
        const int key0 = 64 * j; \
        if (active && key0 <= qpos0 + 31) { \
        const bool need_mask = key0 + 63 > qpos0; \
        f32x4 s[2][4]; \
_Pragma("unroll") \
        for (int qt = 0; qt < 2; ++qt) \
_Pragma("unroll") \
            for (int kt = 0; kt < 4; ++kt) s[qt][kt] = (f32x4){0.f, 0.f, 0.f, 0.f}; \
_Pragma("unroll") \
        for (int kt = 0; kt < 4; ++kt) { \
_Pragma("unroll") \
            for (int kk = 0; kk < 4; ++kk) { const bf16x8 kf = *(const LAS bf16x8*)(tb + AT::KT + (16 * kt + fr) * AT::TSTR + (32 * kk + 8 * fq) * 2); \
_Pragma("unroll") \
                for (int qt = 0; qt < 2; ++qt) s[qt][kt] = __builtin_amdgcn_mfma_f32_16x16x32_bf16(kf, qf[qt][kk], s[qt][kt], 0, 0, 0); } \
            __builtin_amdgcn_sched_barrier(0); } \
_Pragma("unroll") \
        for (int kt = 0; kt < 4; ++kt) { const f32x4 cb = *(const LAS f32x4*)(ck + key0 + 16 * kt + 4 * fq); \
_Pragma("unroll") \
            for (int qt = 0; qt < 2; ++qt) \
_Pragma("unroll") \
                for (int r = 0; r < 4; ++r) s[qt][kt][r] = s[qt][kt][r] * AT::C2 + (cq2[qt] - cb[r]); } \
        if (need_mask) { \
_Pragma("unroll") \
            for (int kt = 0; kt < 4; ++kt) \
_Pragma("unroll") \
                for (int qt = 0; qt < 2; ++qt) \
_Pragma("unroll") \
                    for (int r = 0; r < 4; ++r) if (key0 + 16 * kt + 4 * fq + r > qpos[qt]) s[qt][kt][r] = -__builtin_inff(); } \
        bf16x8 pf[2][2]; \
_Pragma("unroll") \
        for (int qt = 0; qt < 2; ++qt) { \
            float tmax = s[qt][0][0]; \
_Pragma("unroll") \
            for (int kt = 0; kt < 4; ++kt) \
_Pragma("unroll") \
                for (int r = 0; r < 4; ++r) tmax = fmaxf(tmax, s[qt][kt][r]); \
            tmax = fmaxf(tmax, __shfl_xor(tmax, 16)); tmax = fmaxf(tmax, __shfl_xor(tmax, 32)); \
            if (__any(tmax > mrow[qt])) { \
                const float mn = fmaxf(mrow[qt], tmax), alpha = __builtin_amdgcn_exp2f(mrow[qt] - mn); mrow[qt] = mn; lrow[qt] *= alpha; \
_Pragma("unroll") \
                for (int c = 0; c < 8; ++c) oacc[qt][c] = oacc[qt][c] * alpha; } \
            const float mn = mrow[qt]; float psum = 0.f; \
_Pragma("unroll") \
            for (int kt = 0; kt < 4; ++kt) \
_Pragma("unroll") \
                for (int r = 0; r < 4; ++r) { const float p = __builtin_amdgcn_exp2f(s[qt][kt][r] - mn); psum += p; s[qt][kt][r] = p; } \
            lrow[qt] += psum; \
            pf[qt][0] = pack8f(s[qt][0], s[qt][1]); pf[qt][1] = pack8f(s[qt][2], s[qt][3]); \
        } \
_Pragma("unroll") \
        for (int ks = 0; ks < 2; ++ks) \
_Pragma("unroll") \
            for (int c = 0; c < 8; ++c) { LAS unsigned char* vb = tb + AT::VT + (32 * ks + 4 * fq + ((C.lane & 15) >> 2)) * AT::TSTR + (16 * c + 4 * (C.lane & 3)) * 2; \
                const bf16x8 vf = cat44(tr16(vb), tr16(vb + 16 * AT::TSTR)); \
_Pragma("unroll") \
                for (int qt = 0; qt < 2; ++qt) oacc[qt][c] = __builtin_amdgcn_mfma_f32_16x16x32_bf16(vf, pf[qt][ks], oacc[qt][c], 0, 0, 0); \
                if (c & 1) __builtin_amdgcn_sched_barrier(0); } \
            } \
    } while (0)
    for (int it = 0; it < ntiles; it += 2) { ATTN_STEP(it, 0); if (it + 1 < ntiles) ATTN_STEP(it + 1, AT::TBUF); }
#undef ATTN_STEP
    __syncthreads();
    if (active) {
#pragma unroll
        for (int qt = 0; qt < (SAMPLE ? 1 : 2); ++qt) { float lt = lrow[qt]; lt += __shfl_xor(lt, 16); lt += __shfl_xor(lt, 32); const float inv = 1.0f / lt;
            bf16_t* op = MIX + (size_t)(qrow0 + 16 * qt + fr) * D + DA + h * DHB + 4 * fq;
#pragma unroll
            for (int c = 0; c < 8; ++c) { const f32x4 o = oacc[qt][c] * inv; u32x2 w; w.x = cvt_pk_bf16(o[0], o[1]); w.y = cvt_pk_bf16(o[2], o[3]); *(u32x2*)(op + 16 * c) = w; } }
    }
}

__device__ __forceinline__ void attn_sample_unit(const Ctx& C, LAS unsigned char* lds, const bf16_t* __restrict__ PROJ, bf16_t* __restrict__ MIX, int b, int h) {
    using namespace P;
    const int fr = C.lane & 15, fq = C.lane >> 4;
    const bool active = C.wave == 0;
    const int qrow0 = NP + b * DEC_S;
    LAS float* ck = (LAS float*)(lds + AT::CK);
    bf16x8 qf[4]; f32x4 oacc[8];
#pragma unroll
    for (int kk = 0; kk < 4; ++kk) qf[kk] = *(const bf16x8*)(PROJ + (size_t)(qrow0 + fr) * AB_N + 2 * 2048 + h * DHB + 32 * kk + 8 * fq);
    const int qpos = PAST + fr; const float cq2 = ck[qpos]; float mrow = -1e30f, lrow = 0.f;
#pragma unroll
    for (int c = 0; c < 8; ++c) oacc[c] = (f32x4){0.f, 0.f, 0.f, 0.f};
    f32x4 rk[3][2][2], rv[3][2][2];
#define AS_LOAD(slot, j) do { \
_Pragma("unroll") \
        for (int i = 0; i < 2; ++i) { const int id = C.tid + 512 * i, r = id >> 4, ch = id & 15; const size_t o = (((size_t)b * PAST + 64 * (j) + r) * HB + h) * DHB + 8 * ch; \
            const float* kp = C.in[I_CK] + o; const float* vp = C.in[I_CV] + o; \
            rk[slot][i][0] = *(const f32x4*)kp; rk[slot][i][1] = *(const f32x4*)(kp + 4); rv[slot][i][0] = *(const f32x4*)vp; rv[slot][i][1] = *(const f32x4*)(vp + 4); } } while (0)
#define AS_COMPUTE(tb, key0, MASK) do { if (active) { \
        f32x4 s[4]; \
_Pragma("unroll") \
        for (int kt = 0; kt < 4; ++kt) { s[kt] = (f32x4){0.f, 0.f, 0.f, 0.f}; \
_Pragma("unroll") \
            for (int kk = 0; kk < 4; ++kk) { const bf16x8 kf = *(const LAS bf16x8*)((tb) + AT::KT + (16 * kt + fr) * AT::TSTR + (32 * kk + 8 * fq) * 2); \
                s[kt] = __builtin_amdgcn_mfma_f32_16x16x32_bf16(kf, qf[kk], s[kt], 0, 0, 0); } } \
_Pragma("unroll") \
        for (int kt = 0; kt < 4; ++kt) { const f32x4 cb = *(const LAS f32x4*)(ck + (key0) + 16 * kt + 4 * fq); \
_Pragma("unroll") \
            for (int r = 0; r < 4; ++r) { s[kt][r] = s[kt][r] * AT::C2 + (cq2 - cb[r]); if (MASK) { if ((key0) + 16 * kt + 4 * fq + r > qpos) s[kt][r] = -__builtin_inff(); } } } \
        float tmax = s[0][0]; \
_Pragma("unroll") \
        for (int kt = 0; kt < 4; ++kt) \
_Pragma("unroll") \
            for (int r = 0; r < 4; ++r) tmax = fmaxf(tmax, s[kt][r]); \
        tmax = fmaxf(tmax, __shfl_xor(tmax, 16)); tmax = fmaxf(tmax, __shfl_xor(tmax, 32)); \
        if (__any(tmax > mrow)) { const float mn_ = fmaxf(mrow, tmax), alpha = __builtin_amdgcn_exp2f(mrow - mn_); mrow = mn_; lrow *= alpha; \
_Pragma("unroll") \
            for (int c = 0; c < 8; ++c) oacc[c] = oacc[c] * alpha; } \
        float psum = 0.f; \
_Pragma("unroll") \
        for (int kt = 0; kt < 4; ++kt) \
_Pragma("unroll") \
            for (int r = 0; r < 4; ++r) { const float p = __builtin_amdgcn_exp2f(s[kt][r] - mrow); psum += p; s[kt][r] = p; } \
        lrow += psum; \
        const bf16x8 pf0 = pack8f(s[0], s[1]), pf1 = pack8f(s[2], s[3]); \
_Pragma("unroll") \
        for (int ks = 0; ks < 2; ++ks) \
_Pragma("unroll") \
            for (int c = 0; c < 8; ++c) { LAS unsigned char* vb = (tb) + AT::VT + (32 * ks + 4 * fq + ((C.lane & 15) >> 2)) * AT::TSTR + (16 * c + 4 * (C.lane & 3)) * 2; \
                const bf16x8 vf = cat44(tr16(vb), tr16(vb + 16 * AT::TSTR)); \
                oacc[c] = __builtin_amdgcn_mfma_f32_16x16x32_bf16(vf, ks ? pf1 : pf0, oacc[c], 0, 0, 0); } } } while (0)
#define AS_STEP(it, slot) do { const int j = 16 - (it); LAS unsigned char* tb = lds + ((it) & 1) * AT::TBUF; \
_Pragma("unroll") \
        for (int i = 0; i < 2; ++i) { const int id = C.tid + 512 * i, r = id >> 4, ch = id & 15; \
            *(LAS bf16x8*)(tb + AT::KT + r * AT::TSTR + ch * 16) = pack8f(rk[slot][i][0], rk[slot][i][1]); *(LAS bf16x8*)(tb + AT::VT + r * AT::TSTR + ch * 16) = pack8f(rv[slot][i][0], rv[slot][i][1]); } \
        __syncthreads(); \
        if (j >= 3) AS_LOAD(slot, j - 3); \
        AS_COMPUTE(tb, 64 * j, false); } while (0)
    AS_LOAD(0, 15); AS_LOAD(1, 14); AS_LOAD(2, 13);
    {
        LAS unsigned char* tb = lds;
#pragma unroll
        for (int i = 0; i < 2; ++i) { const int id = C.tid + 512 * i, r = id >> 4, ch = id & 15; bf16x8 kv = (bf16x8){0, 0, 0, 0, 0, 0, 0, 0}, vv = kv;
            if (r < DEC_S) { const bf16_t* p = PROJ + (size_t)(NP + b * DEC_S + r) * AB_N + h * DHB + 8 * ch; kv = *(const bf16x8*)(p + 3 * 2048); vv = *(const bf16x8*)(p + 4 * 2048); }
            *(LAS bf16x8*)(tb + AT::KT + r * AT::TSTR + ch * 16) = kv; *(LAS bf16x8*)(tb + AT::VT + r * AT::TSTR + ch * 16) = vv; }
        __syncthreads();
        AS_COMPUTE(tb, 64 * 16, true);
    }
    for (int base = 1; base <= 16; base += 3) { AS_STEP(base, 0); if (base + 1 <= 16) AS_STEP(base + 1, 1); if (base + 2 <= 16) AS_STEP(base + 2, 2); }
#undef AS_LOAD
#undef AS_COMPUTE
#undef AS_STEP
    __syncthreads();
    if (active) { float lt = lrow; lt += __shfl_xor(lt, 16); lt += __shfl_xor(lt, 32); const float inv = 1.0f / lt;
        bf16_t* op = MIX + (size_t)(qrow0 + fr) * D + DA + h * DHB + 4 * fq;
#pragma unroll
        for (int c = 0; c < 8; ++c) { const f32x4 o = oacc[c] * inv; u32x2 w; w.x = cvt_pk_bf16(o[0], o[1]); w.y = cvt_pk_bf16(o[2], o[3]); *(u32x2*)(op + 16 * c) = w; } }
}

namespace GM { constexpr int WT = 0, WSTR = 272, VA = 34816, VSTR = 544; }
__device__ __forceinline__ void gmlp_unit(const Ctx& C, LAS unsigned char* lds, const bf16_t* __restrict__ PROJ, bf16_t* __restrict__ MIX, int rowbase, int nrows, int g) {
    using namespace P;
    __syncthreads();
    { const float* Wg = C.in[I_GWS] + (size_t)g * 128 * 128; const int r = C.tid >> 2, c0 = (C.tid & 3) * 32;
#pragma unroll
        for (int q = 0; q < 4; ++q) { const int c = c0 + 8 * q; f32x4 a = *(const f32x4*)(Wg + r * 128 + c), bb = *(const f32x4*)(Wg + r * 128 + c + 4);
#pragma unroll
            for (int e = 0; e < 4; ++e) { if (c + e > r) a[e] = 0.f; if (c + 4 + e > r) bb[e] = 0.f; }
            *(LAS bf16x8*)(lds + GM::WT + r * GM::WSTR + c * 2) = pack8f(a, bb); } }
#pragma unroll
    for (int i = 0; i < 8; ++i) { const int id = C.tid + 512 * i, s = id >> 5, ch = id & 31; bf16x8 v = (bf16x8){0, 0, 0, 0, 0, 0, 0, 0};
        if (s < nrows) v = *(const bf16x8*)(PROJ + (size_t)(rowbase + s) * AB_N + DA + g * 256 + 8 * ch);
        *(LAS bf16x8*)(lds + GM::VA + s * GM::VSTR + ch * 16) = v; }
    __syncthreads();
    if (16 * C.wave < nrows) {
        const int fr = C.lane & 15, fq = C.lane >> 4, w = C.wave; const int nk = (16 * w + 15) / 32 + 1;
        f32x4 acc[16];
#pragma unroll
        for (int nt = 0; nt < 16; ++nt) acc[nt] = (f32x4){0.f, 0.f, 0.f, 0.f};
        for (int kk = 0; kk < nk; ++kk) { const bf16x8 wf = *(const LAS bf16x8*)(lds + GM::WT + (16 * w + fr) * GM::WSTR + (32 * kk + 8 * fq) * 2);
            LAS unsigned char* vb = lds + GM::VA + (32 * kk + 8 * fq + ((C.lane & 15) >> 2)) * GM::VSTR + 4 * (C.lane & 3) * 2;
#pragma unroll
            for (int nt = 0; nt < 16; ++nt) { const bf16x8 af = cat44(tr16(vb + nt * 32), tr16(vb + nt * 32 + 4 * GM::VSTR)); acc[nt] = __builtin_amdgcn_mfma_f32_16x16x32_bf16(af, wf, acc[nt], 0, 0, 0); } }
        const int row = rowbase + 16 * w + fr; const float bias = C.in[I_GB][g * 128 + 16 * w + fr];
        const bf16_t* up = PROJ + (size_t)row * AB_N + g * 256 + 4 * fq; bf16_t* op = MIX + (size_t)row * D + g * 256 + 4 * fq;
#pragma unroll
        for (int nt = 0; nt < 16; ++nt) { const u32x2 uu = *(const u32x2*)(up + 16 * nt);
            const float u0 = __uint_as_float(uu.x << 16), u1 = __uint_as_float(uu.x & 0xffff0000u), u2 = __uint_as_float(uu.y << 16), u3 = __uint_as_float(uu.y & 0xffff0000u);
            u32x2 wv; wv.x = cvt_pk_bf16(u0 * (acc[nt][0] + bias), u1 * (acc[nt][1] + bias)); wv.y = cvt_pk_bf16(u2 * (acc[nt][2] + bias), u3 * (acc[nt][3] + bias));
            *(u32x2*)(op + 16 * nt) = wv; }
    }
}

__device__ __forceinline__ void gmlp_units(const Ctx& C, LAS unsigned char* lds, const bf16_t* __restrict__ PROJ, bf16_t* __restrict__ MIX, int u0, int n) {
    using namespace P;
    const int fr = C.lane & 15, fq = C.lane >> 4, w = C.wave, nk = (16 * w + 15) / 32 + 1, wr_ = C.tid >> 2, wc0 = (C.tid & 3) * 32;
    f32x4 wa[4], wb[4]; bf16x8 va[8];
#define GM_LOAD(u) do { const int g_ = (u) & 7, rb_ = ((u) >> 3) * 128; const float* Wg = C.in[I_GWS] + (size_t)g_ * 128 * 128 + wr_ * 128 + wc0; \
_Pragma("unroll") \
        for (int q = 0; q < 4; ++q) { wa[q] = *(const f32x4*)(Wg + 8 * q); wb[q] = *(const f32x4*)(Wg + 8 * q + 4); } \
_Pragma("unroll") \
        for (int i = 0; i < 8; ++i) { const int id = C.tid + 512 * i, s_ = id >> 5, ch = id & 31; va[i] = *(const bf16x8*)(PROJ + (size_t)(rb_ + s_) * AB_N + DA + g_ * 256 + 8 * ch); } } while (0)
    GM_LOAD(u0);
    for (int k = 0; k < n; ++k) {
        const int u = u0 + k, g = u & 7, rowbase = (u >> 3) * 128;
        __syncthreads();
#pragma unroll
        for (int q = 0; q < 4; ++q) { const int c = wc0 + 8 * q; f32x4 a = wa[q], bb = wb[q];
#pragma unroll
            for (int e = 0; e < 4; ++e) { if (c + e > wr_) a[e] = 0.f; if (c + 4 + e > wr_) bb[e] = 0.f; }
            *(LAS bf16x8*)(lds + GM::WT + wr_ * GM::WSTR + c * 2) = pack8f(a, bb); }
#pragma unroll
        for (int i = 0; i < 8; ++i) { const int id = C.tid + 512 * i, s_ = id >> 5, ch = id & 31; *(LAS bf16x8*)(lds + GM::VA + s_ * GM::VSTR + ch * 16) = va[i]; }
        __syncthreads();
        if (k + 1 < n) GM_LOAD(u + 1);
        const int row = rowbase + 16 * w + fr; const float bias = C.in[I_GB][g * 128 + 16 * w + fr];
        const bf16_t* up = PROJ + (size_t)row * AB_N + g * 256 + 4 * fq; bf16_t* op = MIX + (size_t)row * D + g * 256 + 4 * fq;
        u32x2 uu[16];
#pragma unroll
        for (int nt = 0; nt < 16; ++nt) uu[nt] = *(const u32x2*)(up + 16 * nt);
        f32x4 acc[16];
#pragma unroll
        for (int nt = 0; nt < 16; ++nt) acc[nt] = (f32x4){0.f, 0.f, 0.f, 0.f};
        for (int kk = 0; kk < nk; ++kk) { const bf16x8 wf = *(const LAS bf16x8*)(lds + GM::WT + (16 * w + fr) * GM::WSTR + (32 * kk + 8 * fq) * 2);
            LAS unsigned char* vb = lds + GM::VA + (32 * kk + 8 * fq + ((C.lane & 15) >> 2)) * GM::VSTR + 4 * (C.lane & 3) * 2;
#pragma unroll
            for (int nt = 0; nt < 16; ++nt) { const bf16x8 af = cat44(tr16(vb + nt * 32), tr16(vb + nt * 32 + 4 * GM::VSTR)); acc[nt] = __builtin_amdgcn_mfma_f32_16x16x32_bf16(af, wf, acc[nt], 0, 0, 0); } }
#pragma unroll
        for (int nt = 0; nt < 16; ++nt) { const u32x2 q_ = uu[nt];
            const float u0_ = __uint_as_float(q_.x << 16), u1 = __uint_as_float(q_.x & 0xffff0000u), u2 = __uint_as_float(q_.y << 16), u3 = __uint_as_float(q_.y & 0xffff0000u);
            u32x2 wv; wv.x = cvt_pk_bf16(u0_ * (acc[nt][0] + bias), u1 * (acc[nt][1] + bias)); wv.y = cvt_pk_bf16(u2 * (acc[nt][2] + bias), u3 * (acc[nt][3] + bias));
            *(u32x2*)(op + 16 * nt) = wv; }
    }
#undef GM_LOAD
}

__device__ __forceinline__ unsigned cvt_pk_bf16_cv(float lo, float hi) { typedef __bf16 bf2_t __attribute__((ext_vector_type(2))); typedef float f2_t __attribute__((ext_vector_type(2))); const f2_t v = {lo, hi}; return __builtin_bit_cast(unsigned, __builtin_convertvector(v, bf2_t)); }
__device__ __forceinline__ bf16_t f2bf_rne(float f) { const unsigned u = __float_as_uint(f); return (bf16_t)((u + 0x7fffu + ((u >> 16) & 1u)) >> 16); }
#ifndef ML_T
#define ML_T(k)
#endif
namespace ML {
constexpr int QT = 0, QSTR = 528, KT = 33792, VT = 67584, VSTR = 112, VW = 74752, CIT = 81920, GA = 107264;
constexpr float KSCALE = 0.0625f, LOG2E = 1.4426950408889634f;
}
template <bool SAMPLE>
__device__ __forceinline__ void mlstm_unit(const Ctx& C, LAS unsigned char* lds, const bf16_t* __restrict__ PROJ, const float* __restrict__ GATES, bf16_t* __restrict__ HS, int b, int h, int sl, const f32x4* __restrict__ GS, const bf16x8* __restrict__ PB) {
    using namespace P;
    const int fr = C.lane & 15, fq = C.lane >> 4, w = C.wave, tt = w & 3, vt = w >> 2, qsub = (C.lane & 15) >> 2, psub = C.lane & 3;
    constexpr int NCH = SAMPLE ? 1 : SEQ / 64, LV = SAMPLE ? DEC_S : 64;
    const int rowbase = SAMPLE ? NP + b * DEC_S : b * SEQ;
    const int bh = b * HC + h;
    LAS float* ga = (LAS float*)(lds + ML::GA);
    f32x4 Cacc[2][3]; float mprev = 0.f;
#pragma unroll
    for (int dt = 0; dt < 2; ++dt)
#pragma unroll
        for (int v2 = 0; v2 < 3; ++v2) Cacc[dt][v2] = (f32x4){0.f, 0.f, 0.f, 0.f};
    if (SAMPLE) {
        const float* c0 = C.in[I_SC] + (size_t)bh * DKC * DVC; const float* n0 = C.in[I_SN] + (size_t)bh * DKC;
#pragma unroll
        for (int dt = 0; dt < 2; ++dt) {
#pragma unroll
            for (int v2 = 0; v2 < 2; ++v2)
#pragma unroll
                for (int r = 0; r < 4; ++r) Cacc[dt][v2][r] = c0[(size_t)(32 * w + 16 * dt + 4 * fq + r) * DVC + sl * 32 + 16 * v2 + fr];
#pragma unroll
            for (int r = 0; r < 4; ++r) Cacc[dt][2][r] = fr == 0 ? n0[32 * w + 16 * dt + 4 * fq + r] : 0.f; }
        mprev = C.in[I_SM][bh];
    }
    __syncthreads();
#define ML_WRITE_CIT() do { _Pragma("unroll") for (int dt = 0; dt < 2; ++dt) _Pragma("unroll") for (int v2 = 0; v2 < 3; ++v2) { \
        u32x2 w_; w_.x = cvt_pk_bf16_cv(Cacc[dt][v2][0], Cacc[dt][v2][1]); w_.y = cvt_pk_bf16_cv(Cacc[dt][v2][2], Cacc[dt][v2][3]); \
        *(LAS u32x2*)(lds + ML::CIT + (16 * v2 + fr) * ML::QSTR + (32 * w + 16 * dt + 4 * fq) * 2) = w_; } } while (0)
    ML_WRITE_CIT();
    bf16x8 qreg[4], kreg[4], vreg, pSn[2]; float lfv, igv; f32x4 gsn;
#define ML_LOAD_CHUNK(c) do { \
_Pragma("unroll") \
        for (int i = 0; i < 4; ++i) { const int id = C.tid + 512 * i, r = id >> 5, ch = id & 31; \
            if (r < LV) { const bf16_t* p = PROJ + (size_t)(rowbase + 64 * (c) + r) * C_N + h * DKC + 8 * ch; qreg[i] = *(const bf16x8*)p; kreg[i] = *(const bf16x8*)(p + 2048); } \
            else { qreg[i] = (bf16x8){0, 0, 0, 0, 0, 0, 0, 0}; kreg[i] = (bf16x8){0, 0, 0, 0, 0, 0, 0, 0}; } } \
        { const int r = (C.tid & 255) >> 2, ch = C.tid & 3; \
            if (r < LV) vreg = *(const bf16x8*)(PROJ + (size_t)(rowbase + 64 * (c) + r) * C_N + 4096 + h * DVC + sl * 32 + 8 * ch); else vreg = (bf16x8){0, 0, 0, 0, 0, 0, 0, 0}; } \
        if constexpr (SAMPLE) { if (C.lane < LV) { const float* gp = GATES + (size_t)(rowbase + 64 * (c) + C.lane) * 16; igv = gp[h]; lfv = gp[8 + h]; } else { igv = -__builtin_inff(); lfv = 0.f; } } \
        else { gsn = GS[(size_t)bh * SEQ + 64 * (c) + C.lane]; const bf16x8* pp = PB + ((size_t)(bh * 64 + (c)) * 4 + tt) * 128 + C.lane; pSn[0] = pp[0]; pSn[1] = pp[64]; } \
    } while (0)
    ML_LOAD_CHUNK(0);
    for (int c = 0; c < NCH; ++c) {
        ML_T(0);
        float bcs, av, cm; bf16x8 pS0, pS1;
        if constexpr (SAMPLE) {
            bcs = lfv;
#pragma unroll
            for (int o = 1; o < 64; o <<= 1) { const float y = __shfl_up(bcs, o); if (C.lane >= o) bcs += y; }
            av = igv - bcs; cm = av;
#pragma unroll
            for (int o = 1; o < 64; o <<= 1) { const float y = __shfl_up(cm, o); if (C.lane >= o) cm = fmaxf(cm, y); }
        } else { bcs = gsn[0]; av = gsn[1]; cm = gsn[2]; pS0 = pSn[0]; pS1 = pSn[1]; }
        const float Mt = fmaxf(mprev, cm), Mend = __shfl(Mt, 63), bend = __shfl(bcs, 63);
        const float wsv = __builtin_amdgcn_exp2f((av - Mend) * ML::LOG2E), wc = __builtin_amdgcn_exp2f((mprev - Mend) * ML::LOG2E);
#pragma unroll
        for (int i = 0; i < 4; ++i) { const int id = C.tid + 512 * i, r = id >> 5, ch = id & 31;
            *(LAS bf16x8*)(lds + ML::QT + r * ML::QSTR + ch * 16) = qreg[i]; *(LAS bf16x8*)(lds + ML::KT + r * ML::QSTR + ch * 16) = kreg[i]; }
        { const int r = C.tid < 256 ? (C.tid >> 2) : ((C.tid - 256) >> 1) & 63; const float sc = __shfl(wsv, r) * ML::KSCALE;
            if (C.tid < 256) { const int ch = C.tid & 3; *(LAS bf16x8*)(lds + ML::VT + r * ML::VSTR + ch * 16) = vreg;
                const u32x4 vv = __builtin_bit_cast(u32x4, vreg); u32x4 o;
#pragma unroll
                for (int e = 0; e < 4; ++e) o[e] = cvt_pk_bf16(__uint_as_float(vv[e] << 16) * sc, __uint_as_float(vv[e] & 0xffff0000u) * sc);
                *(LAS u32x4*)(lds + ML::VW + r * ML::VSTR + ch * 16) = o; }
            else if (C.tid < 384) { const int hf = C.tid & 1;
                u32x4 o1 = {0u, 0u, 0u, 0u}, o2 = {0u, 0u, 0u, 0u}; if (hf == 0) { o1.x = 0x3F80u; o2.x = cvt_pk_bf16(sc, 0.f); }
                *(LAS u32x4*)(lds + ML::VT + r * ML::VSTR + 64 + hf * 16) = o1; *(LAS u32x4*)(lds + ML::VW + r * ML::VSTR + 64 + hf * 16) = o2; } }
        if (SAMPLE && w == 0) { ga[C.lane] = av; ga[64 + C.lane] = wsv; }
        __syncthreads();
        ML_T(1);
        if (c + 1 < NCH) ML_LOAD_CHUNK(c + 1);
        {
            const float Mrow = __shfl(Mt, 16 * tt + fr), brow = __shfl(bcs, 16 * tt + fr);
            const float winter = __builtin_amdgcn_exp2f((mprev - Mrow) * ML::LOG2E);
            bf16x8 qfr[8];
#pragma unroll
            for (int kk = 0; kk < 8; ++kk) qfr[kk] = *(const LAS bf16x8*)(lds + ML::QT + (16 * tt + fr) * ML::QSTR + (32 * kk + 8 * fq) * 2);
            const int tpos = 16 * tt + fr; float rrow = 1.0f;
            if constexpr (SAMPLE) {
                f32x4 sT[4];
#pragma unroll
                for (int st = 0; st < 4; ++st) { sT[st] = (f32x4){0.f, 0.f, 0.f, 0.f};
#pragma unroll
                    for (int kk = 0; kk < 8; ++kk) { const bf16x8 kf = *(const LAS bf16x8*)(lds + ML::KT + (16 * st + fr) * ML::QSTR + (32 * kk + 8 * fq) * 2);
                        sT[st] = __builtin_amdgcn_mfma_f32_16x16x32_bf16(kf, qfr[kk], sT[st], 0, 0, 0); }
                    __builtin_amdgcn_sched_barrier(0); }
#pragma unroll
                for (int st = 0; st < 4; ++st) { const f32x4 a4 = *(const LAS f32x4*)(ga + 16 * st + 4 * fq);
#pragma unroll
                    for (int r = 0; r < 4; ++r) { const int spos = 16 * st + 4 * fq + r;
                        float wgt = __builtin_amdgcn_exp2f((a4[r] - Mrow) * ML::LOG2E); if (spos > tpos) wgt = 0.f;
                        sT[st][r] = sT[st][r] * ML::KSCALE * wgt; } }
                pS0 = pack8f(sT[0], sT[1]); pS1 = pack8f(sT[2], sT[3]);
            } else rrow = __builtin_amdgcn_exp2f((__shfl(cm, tpos) - Mrow) * ML::LOG2E);
            f32x4 acc = (f32x4){0.f, 0.f, 0.f, 0.f}, acc3 = (f32x4){0.f, 0.f, 0.f, 0.f}, accP = (f32x4){0.f, 0.f, 0.f, 0.f}, acc3P = (f32x4){0.f, 0.f, 0.f, 0.f};
#pragma unroll
            for (int kk = 0; kk < 8; ++kk) { const bf16x8 cf = *(const LAS bf16x8*)(lds + ML::CIT + (16 * vt + fr) * ML::QSTR + (32 * kk + 8 * fq) * 2);
                const bf16x8 nf = *(const LAS bf16x8*)(lds + ML::CIT + (32 + fr) * ML::QSTR + (32 * kk + 8 * fq) * 2);
                acc = __builtin_amdgcn_mfma_f32_16x16x32_bf16(cf, qfr[kk], acc, 0, 0, 0); acc3 = __builtin_amdgcn_mfma_f32_16x16x32_bf16(nf, qfr[kk], acc3, 0, 0, 0); }
            { LAS unsigned char* vb = lds + ML::VT + (4 * fq + qsub) * ML::VSTR + (16 * vt + 4 * psub) * 2; LAS unsigned char* ob = lds + ML::VT + (4 * fq + qsub) * ML::VSTR + (32 + 4 * psub) * 2;
                const bf16x8 vf0 = cat44(tr16(vb), tr16(vb + 16 * ML::VSTR)), of0 = cat44(tr16(ob), tr16(ob + 16 * ML::VSTR));
                accP = __builtin_amdgcn_mfma_f32_16x16x32_bf16(vf0, pS0, accP, 0, 0, 0); acc3P = __builtin_amdgcn_mfma_f32_16x16x32_bf16(of0, pS0, acc3P, 0, 0, 0);
                const bf16x8 vf1 = cat44(tr16(vb + 32 * ML::VSTR), tr16(vb + 48 * ML::VSTR)), of1 = cat44(tr16(ob + 32 * ML::VSTR), tr16(ob + 48 * ML::VSTR));
                accP = __builtin_amdgcn_mfma_f32_16x16x32_bf16(vf1, pS1, accP, 0, 0, 0); acc3P = __builtin_amdgcn_mfma_f32_16x16x32_bf16(of1, pS1, acc3P, 0, 0, 0); }
            acc = acc * winter + accP * rrow; acc3 = acc3 * winter + acc3P * rrow;
            const float den = __shfl(acc3[0], fr);
            const float lim = __builtin_amdgcn_exp2f(-(brow + Mrow) * ML::LOG2E);
            const float inv = 1.0f / fmaxf(fabsf(den), lim);
            if (tpos < LV) { const f32x4 hv = acc * inv; u32x2 hw; hw.x = cvt_pk_bf16(hv[0], hv[1]); hw.y = cvt_pk_bf16(hv[2], hv[3]); *(u32x2*)(HS + (size_t)(rowbase + 64 * c + tpos) * D + h * DVC + sl * 32 + 16 * vt + 4 * fq) = hw; }
        }
        __syncthreads();
        ML_T(2);
        {
#pragma unroll
            for (int dt = 0; dt < 2; ++dt)
#pragma unroll
                for (int v2 = 0; v2 < 3; ++v2) Cacc[dt][v2] = Cacc[dt][v2] * wc;
#pragma unroll
            for (int ks = 0; ks < 2; ++ks) { bf16x8 vw[3];
#pragma unroll
                for (int v2 = 0; v2 < 3; ++v2) { LAS unsigned char* vb = lds + ML::VW + (32 * ks + 8 * fq + qsub) * ML::VSTR + (16 * v2 + 4 * psub) * 2; vw[v2] = cat44(tr16(vb), tr16(vb + 4 * ML::VSTR)); }
#pragma unroll
                for (int dt = 0; dt < 2; ++dt) { LAS unsigned char* kb = lds + ML::KT + (32 * ks + 8 * fq + qsub) * ML::QSTR + (32 * w + 16 * dt + 4 * psub) * 2;
                    const bf16x8 kf = cat44(tr16(kb), tr16(kb + 4 * ML::QSTR));
#pragma unroll
                    for (int v2 = 0; v2 < 3; ++v2) Cacc[dt][v2] = __builtin_amdgcn_mfma_f32_16x16x32_bf16(kf, vw[v2], Cacc[dt][v2], 0, 0, 0); } }
            ML_WRITE_CIT();
            mprev = bend + Mend;
        }
        __syncthreads();
        ML_T(3);
    }
    { float* co = C.out + (SAMPLE ? O_SC : O_PC) + (size_t)bh * DKC * DVC;
#pragma unroll
        for (int dt = 0; dt < 2; ++dt)
#pragma unroll
            for (int v2 = 0; v2 < 2; ++v2)
#pragma unroll
                for (int r = 0; r < 4; ++r) co[(size_t)(32 * w + 16 * dt + 4 * fq + r) * DVC + sl * 32 + 16 * v2 + fr] = Cacc[dt][v2][r];
        if (sl == 0) { float* no = C.out + (SAMPLE ? O_SN : O_PN) + (size_t)bh * DKC;
            if (fr == 0) {
#pragma unroll
                for (int dt = 0; dt < 2; ++dt)
#pragma unroll
                    for (int r = 0; r < 4; ++r) no[32 * w + 16 * dt + 4 * fq + r] = Cacc[dt][2][r]; }
            if (C.tid == 0) C.out[(SAMPLE ? O_SM : O_PM) + bh] = mprev; } }
}
#undef ML_WRITE_CIT
#undef ML_LOAD_CHUNK
__device__ __forceinline__ void mlstm_prepass(const Ctx& C, const bf16_t* __restrict__ PROJ, const float* __restrict__ GATES, f32x4* __restrict__ GS, bf16x8* __restrict__ PB, int bh, int c) {
    using namespace P;
    const int fr = C.lane & 15, fq = C.lane >> 4, w = C.wave, tt = w & 3, sh = w >> 2, b = bh >> 3, h = bh & 7;
    const size_t rowc = (size_t)b * SEQ + 64 * c;
    const float* gp = GATES + (rowc + C.lane) * 16; const float igv = gp[h], lfv = gp[8 + h];
    bf16x8 qfr[8];
#pragma unroll
    for (int kk = 0; kk < 8; ++kk) qfr[kk] = *(const bf16x8*)(PROJ + (rowc + 16 * tt + fr) * C_N + h * DKC + 32 * kk + 8 * fq);
    float bcs = lfv;
#pragma unroll
    for (int o = 1; o < 64; o <<= 1) { const float y = __shfl_up(bcs, o); if (C.lane >= o) bcs += y; }
    const float av = igv - bcs; float cm = av;
#pragma unroll
    for (int o = 1; o < 64; o <<= 1) { const float y = __shfl_up(cm, o); if (C.lane >= o) cm = fmaxf(cm, y); }
    if (w == 0) GS[(size_t)bh * SEQ + 64 * c + C.lane] = (f32x4){bcs, av, cm, 0.f};
    const int tpos = 16 * tt + fr; const float cmrow = __shfl(cm, tpos);
    f32x4 sT[2];
#pragma unroll
    for (int i = 0; i < 2; ++i) { const int st = 2 * sh + i; sT[i] = (f32x4){0.f, 0.f, 0.f, 0.f};
        if (st <= tt) {
#pragma unroll
            for (int kk = 0; kk < 8; ++kk) { const bf16x8 kf = *(const bf16x8*)(PROJ + (rowc + 16 * st + fr) * C_N + 2048 + h * DKC + 32 * kk + 8 * fq);
                sT[i] = __builtin_amdgcn_mfma_f32_16x16x32_bf16(kf, qfr[kk], sT[i], 0, 0, 0); } }
#pragma unroll
        for (int r = 0; r < 4; ++r) { const int spos = 16 * st + 4 * fq + r; const float as = __shfl(av, spos);
            float wgt = __builtin_amdgcn_exp2f((as - cmrow) * ML::LOG2E); if (spos > tpos) wgt = 0.f;
            sT[i][r] = sT[i][r] * ML::KSCALE * wgt; } }
    PB[((size_t)(bh * 64 + c) * 4 + tt) * 128 + sh * 64 + C.lane] = pack8f(sT[0], sT[1]);
}
__device__ __forceinline__ void mlstm_headnorm_row(const bf16_t* __restrict__ hs, const bf16_t* __restrict__ opre, const float* __restrict__ gn, bf16_t* __restrict__ mix, int lane) {
    const u32x4* hr = (const u32x4*)hs + lane; const f32x4* gr = (const f32x4*)gn + 2 * lane; const u32x4* orr = (const u32x4*)opre + lane; u32x4* mo = (u32x4*)mix + lane;
#pragma unroll
    for (int hh = 0; hh < 8; ++hh) { const u32x4 hw = hr[64 * hh], ow = orr[64 * hh]; const f32x4 g0 = gr[128 * hh], g1 = gr[128 * hh + 1];
        float v[8], o[8];
#pragma unroll
        for (int e = 0; e < 4; ++e) { v[2 * e] = __uint_as_float(hw[e] << 16); v[2 * e + 1] = __uint_as_float(hw[e] & 0xffff0000u); o[2 * e] = __uint_as_float(ow[e] << 16); o[2 * e + 1] = __uint_as_float(ow[e] & 0xffff0000u); }
        float ss = 0.f;
#pragma unroll
        for (int e = 0; e < 8; ++e) ss += v[e] * v[e];
        ss = wave_sum(ss);
        const float r = 1.0f / sqrtf(ss * (1.0f / 512.0f) + P::EPS);
        float y[8];
#pragma unroll
        for (int e = 0; e < 8; ++e) { const float sg = __builtin_amdgcn_rcpf(1.0f + __builtin_amdgcn_exp2f(-1.4426950408889634f * o[e])); y[e] = sg * v[e] * r * (e < 4 ? g0[e] : g1[e - 4]); }
        u32x4 w; w.x = cvt_pk_bf16(y[0], y[1]); w.y = cvt_pk_bf16(y[2], y[3]); w.z = cvt_pk_bf16(y[4], y[5]); w.w = cvt_pk_bf16(y[6], y[7]); mo[64 * hh] = w; }
}

struct Args { const float* in[P::N_IN]; float* out; unsigned char* ws; };

__global__ void __launch_bounds__(512, 2) fwd(Args args) {
    using namespace P;
    extern __shared__ __attribute__((aligned(16))) unsigned char lds_raw[];
    LAS unsigned char* lds = (LAS unsigned char*)lds_raw;
    Ctx C;
    C.in = args.in;
    C.out = args.out; C.ws = args.ws;
    C.tid = threadIdx.x; C.lane = C.tid & 63; C.wave = __builtin_amdgcn_readfirstlane(C.tid >> 6);
    C.G = gridDim.x; C.gw = blockIdx.x * 8 + C.wave; C.ngw = C.G * 8;
    volatile LAS unsigned* MISC = (volatile LAS unsigned*)(lds + MISC_OFF);
    for (int u = C.tid; u < (LDS_BYTES - MISC_OFF) / 4; u += 512) ((LAS unsigned*)(lds + MISC_OFF))[u] = 0u;
    __syncthreads();
    unsigned* ctl = (unsigned*)(C.ws + WS_CTL);
    XcdBarrier bar = xcd_barrier_post(ctl + CW_BAR, MISC + 8);

#define Yb ((bf16_t*)(args.ws + P::WS_H))
#define SSQ(i) ((float*)(args.ws + P::WS_CTL + P::CTL_SSQ) + (i) * P::MP)
#define PROJ ((bf16_t*)(args.ws + P::WS_PROJ))
#define MIX ((bf16_t*)(args.ws + P::WS_MIX))
#define Gb ((bf16_t*)(args.ws + P::WS_G))
#define HS ((bf16_t*)(args.ws + P::WS_G))
#define GATES ((float*)(args.ws + P::WS_GATES))
#define SLAB ((float*)(args.ws + P::WS_SLAB))
    const int bid = (int)blockIdx.x;
#define TS(n)
#define PHASE_BEGIN() do { int t_ = threadIdx.x; asm volatile("" : "+v"(t_)); C.tid = t_; C.lane = t_ & 63; } while (0)

    PHASE_BEGIN();
    {
        { Bg<CvL0> bg; bg.next = C.gw; bg.cur = -1; bg_drain(C, bg); }
        LAS float* scr = (LAS float*)(lds + C.wave * 16384);
        if ((C.gw & 15) == 0 && (C.gw >> 4) < 128) { const int it = C.gw >> 4;
            if (it < 64) transpose_item(C.in[I_ABWIN], AB_LD, D, 64 * it, AB_N, 16, (bf16_t*)(C.ws + WS_WABF), 0, scr, C.lane, C.in[I_NMIX]);
            else transpose_item(C.in[I_CWIN], C_LD, D, 64 * (it - 64), C_N, 16, (bf16_t*)(C.ws + WS_WCIF), 0, scr, C.lane, C.in[I_NMIX] + D); }
        for (int m = C.gw; m < M; m += C.ngw) {
            const float* xr = m < NP ? C.in[I_XP] + (size_t)m * D : C.in[I_XS] + (size_t)(m - NP) * D;
            xrow_to_bf16(xr, Yb + (size_t)m * D, SSQ(0) + m, C.lane);
        }
    }
    xcd_barrier(bar);

    PHASE_BEGIN();
    {
        const bf16_t* Wf = (const bf16_t*)(C.ws + WS_WABF);
        for (int t = bid; t < M / 16; t += C.G) {
            const int row0 = 16 * t; const f32x4 part = gate_tile_part(Yb, Wf, row0, 512 * C.wave, C.lane);
            ((LAS f32x4*)lds)[C.wave * 64 + C.lane] = part;
            __syncthreads();
            if (C.wave == 0) { f32x4 acc = ((LAS f32x4*)lds)[C.lane];
#pragma unroll
                for (int w = 1; w < 8; ++w) acc = acc + ((LAS f32x4*)lds)[w * 64 + C.lane];
                const int n = C.lane & 15, g4 = 4 * (C.lane >> 4); const float bf = C.in[I_FBF][n];
#pragma unroll
                for (int r = 0; r < 4; ++r) { const int row = row0 + g4 + r; const float lf = log_sigmoid_f(acc[r] * rstd_of(SSQ(0)[row]) + bf);
                    if (row < NP) C.out[O_PLF + (size_t)row * HB + n] = lf; else C.out[O_SLF + (size_t)(row - NP) * HB + n] = lf; } }
            __syncthreads();
        }
        pg8::Gemm g{Yb, (const bf16_t*)(C.ws + WS_WABIN), MP, AB_N, D}; SplitOrder S; S.init(AB_N, D, 6, C.G, bid);
        EpiAbIn E{PROJ, C.out, SLAB, SSQ(0)};
        pg8::gemm_phase<EpiAbIn, SplitOrder, true, true>(lds, g, S, E);
    }
    xcd_barrier(bar);
    PHASE_BEGIN();
    combine_inproj<true>(C, SLAB, PROJ, SSQ(0));
    xcd_barrier(bar);

    PHASE_BEGIN();
    {
        for (int u = bid; u < 256; u += C.G) {
            const int bh = u >> 3, s = u & 7, b = bh >> 4, h = bh & 15;
            float td[8];
            if (C.G == 256) {
#pragma unroll
                for (int q = 0; q < 8; ++q) { const char* tp = (const char*)C.in[(q & 4) ? I_CV : I_CK] + ((size_t)(C.gw * 4 + (q & 3)) * 64 + C.lane) * 128;
                    asm volatile("global_load_dword %0, %1, off" : "=v"(td[q]) : "v"(tp) : "memory"); } }
            attn_prepare_ck<false>(C, lds, b, h);
            if (C.G == 256) asm volatile("s_waitcnt vmcnt(0)" : "+v"(td[0]), "+v"(td[1]), "+v"(td[2]), "+v"(td[3]), "+v"(td[4]), "+v"(td[5]), "+v"(td[6]), "+v"(td[7]) :: "memory");
            attn_qblock<false>(C, lds, PROJ, MIX, b, h, s);
            attn_qblock<false>(C, lds, PROJ, MIX, b, h, 15 - s);
            __syncthreads();
        }
        TS(21);
        PHASE_BEGIN();
        for (int u = bid; u < DEC_B * HB; u += C.G) {
            const int b = u >> 4, h = u & 15;
            attn_prepare_ck<true>(C, lds, b, h);
            attn_sample_unit(C, lds, PROJ, MIX, b, h);
            __syncthreads();
        }
        TS(22);
        PHASE_BEGIN();
        if (C.G == 256) {
            if (bid >= 128) { gmlp_units(C, lds, PROJ, MIX, 4 * (bid - 128), 4);
                if (bid >= 192) { const int u = bid - 192; gmlp_unit(C, lds, PROJ, MIX, NP + (u >> 3) * DEC_S, DEC_S, u & 7); } }
        } else {
            for (int u = bid; u < 512 + 64; u += C.G) {
                if (u < 512) gmlp_unit(C, lds, PROJ, MIX, (u >> 3) * 128, 128, u & 7);
                else gmlp_unit(C, lds, PROJ, MIX, NP + ((u - 512) >> 3) * DEC_S, DEC_S, (u - 512) & 7);
            }
        }
    }
    xcd_barrier(bar);

    PHASE_BEGIN();
    {
        pg8::Gemm g{MIX, (const bf16_t*)(C.ws + WS_WABOUT), MP, D, D}; SplitOrder S; S.init(D, D, 16, C.G, bid);
        EpiResid E{Yb, SLAB, SSQ(1)};
        pg8::gemm_phase<EpiResid, SplitOrder, true, true>(lds, g, S, E);
    }
    xcd_barrier(bar);
    PHASE_BEGIN();
    for (int r = bid; r < NS; r += C.G) sample_row_wg<false>(C, lds, SLAB, r, C.in[I_XS] + (size_t)r * D, Yb + (size_t)(NP + r) * D, SSQ(1) + NP + r, nullptr, nullptr);
    xcd_barrier(bar);
    PHASE_BEGIN();
    {
        pg8::Gemm g{Yb, (const bf16_t*)(C.ws + WS_WGU0), MP, 2 * DFF, D}; SplitOrder S; S.init(2 * DFF, D, 3, C.G, bid);
        EpiSwiGLU E{Gb, SLAB, SSQ(1)};
        pg8::gemm_phase<EpiSwiGLU, SplitOrder, true, true>(lds, g, S, E);
    }
    xcd_barrier(bar);
    PHASE_BEGIN();
    combine_swiglu(C, SLAB, Gb, SSQ(1));
    xcd_barrier(bar);
    PHASE_BEGIN();
    {
        pg8::Gemm g{Gb, (const bf16_t*)(C.ws + WS_WDN0), MP, D, DFF}; SplitOrder S; S.init(D, DFF, 16, C.G, bid);
        EpiResid E{Yb, SLAB, SSQ(2)};
        pg8::gemm_phase<EpiResid, SplitOrder, true, true>(lds, g, S, E);
    }
    xcd_barrier(bar);
    PHASE_BEGIN();
    for (int r = bid; r < NS; r += C.G) sample_row_wg<false>(C, lds, SLAB, r, nullptr, Yb + (size_t)(NP + r) * D, SSQ(2) + NP + r, nullptr, nullptr);
    xcd_barrier(bar);
    PHASE_BEGIN();
    {
        const bf16_t* Wif = (const bf16_t*)(C.ws + WS_WCIF);
        for (int t = bid; t < M / 16; t += C.G) {
            const int row0 = 16 * t; const f32x4 part = gate_tile_part(Yb, Wif, row0, 512 * C.wave, C.lane);
            ((LAS f32x4*)lds)[C.wave * 64 + C.lane] = part;
            __syncthreads();
            if (C.wave == 0) { f32x4 acc = ((LAS f32x4*)lds)[C.lane];
#pragma unroll
                for (int w = 1; w < 8; ++w) acc = acc + ((LAS f32x4*)lds)[w * 64 + C.lane];
                const int n = C.lane & 15, g4 = 4 * (C.lane >> 4); const float bb = n < 8 ? C.in[I_CBI][n] : C.in[I_CBF][n - 8];
#pragma unroll
                for (int r = 0; r < 4; ++r) { const float z = acc[r] * rstd_of(SSQ(2)[row0 + g4 + r]) + bb; GATES[(size_t)(row0 + g4 + r) * 16 + n] = n < 8 ? z : log_sigmoid_f(z); } }
            __syncthreads();
        }
        pg8::Gemm g{Yb, (const bf16_t*)(C.ws + WS_WCIN), MP, C_N, D}; SplitOrder S; S.init(C_N, D, 5, C.G, bid);
        EpiBf16Plain E{PROJ, C_N, SLAB, SSQ(2)};
        pg8::gemm_phase<EpiBf16Plain, SplitOrder, true, true>(lds, g, S, E);
    }
    xcd_barrier(bar);
    PHASE_BEGIN();
    combine_inproj<false>(C, SLAB, PROJ, SSQ(2));
    for (int u = bid; u < BATCH * HC * 64; u += C.G) mlstm_prepass(C, PROJ, GATES, (f32x4*)(C.ws + WS_GS), (bf16x8*)(C.ws + WS_PB), u >> 6, u & 63);
    xcd_barrier(bar);
    PHASE_BEGIN();
    {
        for (int u = bid; u < BATCH * HC * 16; u += C.G) mlstm_unit<false>(C, lds, PROJ, GATES, HS, u >> 7, (u >> 4) & 7, u & 15, (const f32x4*)(C.ws + WS_GS), (const bf16x8*)(C.ws + WS_PB));
        TS(23);
        PHASE_BEGIN();
        for (int u = bid; u < DEC_B * HC * 16; u += C.G) mlstm_unit<true>(C, lds, PROJ, GATES, HS, u >> 7, (u >> 4) & 7, u & 15, nullptr, nullptr);
    }
    xcd_barrier(bar);
    PHASE_BEGIN();
    for (int m = C.gw; m < M; m += C.ngw) mlstm_headnorm_row(HS + (size_t)m * D, PROJ + (size_t)m * C_N + 8192, C.in[I_CHN], MIX + (size_t)m * D, C.lane);
    xcd_barrier(bar);
    PHASE_BEGIN();
    {
        pg8::Gemm g{MIX, (const bf16_t*)(C.ws + WS_WCOUT), MP, D, D}; SplitOrder S; S.init(D, D, 16, C.G, bid);
        EpiResid E{Yb, SLAB, SSQ(3)};
        pg8::gemm_phase<EpiResid, SplitOrder, true, true>(lds, g, S, E);
    }
    xcd_barrier(bar);
    PHASE_BEGIN();
    for (int r = bid; r < NS; r += C.G) sample_row_wg<false>(C, lds, SLAB, r, nullptr, Yb + (size_t)(NP + r) * D, SSQ(3) + NP + r, nullptr, nullptr);
    xcd_barrier(bar);
    PHASE_BEGIN();
    {
        pg8::Gemm g{Yb, (const bf16_t*)(C.ws + WS_WGU1), MP, 2 * DFF, D}; SplitOrder S; S.init(2 * DFF, D, 3, C.G, bid);
        EpiSwiGLU E{Gb, SLAB, SSQ(3)};
        pg8::gemm_phase<EpiSwiGLU, SplitOrder, true, true>(lds, g, S, E);
    }
    xcd_barrier(bar);
    PHASE_BEGIN();
    combine_swiglu(C, SLAB, Gb, SSQ(3));
    xcd_barrier(bar);
    PHASE_BEGIN();
    {
        pg8::Gemm g{Gb, (const bf16_t*)(C.ws + WS_WDN1), MP, D, DFF}; SplitOrder S; S.init(D, DFF, 16, C.G, bid);
        EpiResid E{Yb, SLAB, SSQ(4)};
        pg8::gemm_phase<EpiResid, SplitOrder, true, true>(lds, g, S, E);
    }
    xcd_barrier(bar);
    PHASE_BEGIN();
    for (int m = C.gw; m < NP; m += C.ngw) final_row(Yb + (size_t)m * D, rstd_of(SSQ(4)[m]), C.in[I_NFIN], C.out + O_YP + (size_t)m * D, C.lane);
    for (int r = bid; r < NS; r += C.G) sample_row_wg<true>(C, lds, SLAB, r, nullptr, Yb + (size_t)(NP + r) * D, nullptr, C.in[I_NFIN], C.out + O_YS + (size_t)r * D);
}

#undef Yb
#undef SSQ
#undef PROJ
#undef MIX
#undef Gb
#undef HS
#undef GATES
#undef SLAB
extern "C" void kernel_launch(void* const* d_in, const int* in_sizes, int n_in, void* d_out, int out_size, void* d_ws, size_t ws_size, hipStream_t stream) {
    static int grid = 0;
    if (grid == 0) {
        if (n_in != P::N_IN || (size_t)out_size != P::O_END || ws_size < P::WS_END) { fprintf(stderr, "kernel_launch: unexpected shapes: n_in %d out %d ws %zu\n", n_in, out_size, ws_size); grid = -1; return; }
        int dev = 0, cus = 0, per_cu = 0;
        if (hipGetDevice(&dev) != hipSuccess || hipDeviceGetAttribute(&cus, hipDeviceAttributeMultiprocessorCount, dev) != hipSuccess) { grid = -1; return; }
        if (hipFuncSetAttribute((const void*)fwd, hipFuncAttributeMaxDynamicSharedMemorySize, P::LDS_BYTES) != hipSuccess) { fprintf(stderr, "kernel_launch: hipFuncSetAttribute failed\n"); grid = -1; return; }
        if (hipOccupancyMaxActiveBlocksPerMultiprocessor(&per_cu, (const void*)fwd, 512, P::LDS_BYTES) != hipSuccess || per_cu < 1) fprintf(stderr, "kernel_launch: occupancy query reports %d per CU\n", per_cu);
        (void)hipGetLastError();
        grid = cus;
    }
    if (grid < 0) return;
    if (hipMemsetAsync((char*)d_ws + P::WS_CTL, 0, P::CTL_ZERO_BYTES, stream) != hipSuccess) return;
    Args a{};
    for (int i = 0; i < P::N_IN; ++i) a.in[i] = (const float*)d_in[i];
    a.out = (float*)d_out; a.ws = (unsigned char*)d_ws;
    hipLaunchKernelGGL(fwd, dim3(grid), dim3(512), P::LDS_BYTES, stream, a);
}
```
